# Optimizing an MI355X kernel written in HIP

```python
import math
import jax, jax.numpy as jnp
from jax import lax
import numpy as np

D_MODEL = 2048
BATCH = 4
SEQ = 2048
DEPTH = 4

RET_HEADS = 4
RET_DIM = 128
FOX_HEADS = 4
FOX_DIM = 128
DSA_HEADS = 4
DSA_DIM = 128
DSA_Q_RANK = 512
IDX_HEADS = 16
IDX_DIM = 64
DSA_TOPK = 256
SSD_HEADS = 16
SSD_HEAD_DIM = 64
SSD_GROUPS = 2
SSD_STATE = 128
SSD_CONV = 4
SSD_INNER = SSD_HEADS * SSD_HEAD_DIM
SSD_XBC = SSD_INNER + 2 * SSD_GROUPS * SSD_STATE
D_FF = 4 * D_MODEL
N_BUCKETS = 32
MAX_DISTANCE = 128
Q_BLOCK = 128
CHUNK = 128
EPS = 1e-6
N_BRANCH = 4
BRANCH_WIDTHS = (RET_HEADS * RET_DIM, FOX_HEADS * FOX_DIM, DSA_HEADS * DSA_DIM, SSD_INNER)
IN_SIZES = (
    RET_HEADS * RET_DIM, RET_HEADS * RET_DIM, RET_HEADS * RET_DIM, RET_HEADS * RET_DIM,
    FOX_HEADS * FOX_DIM, FOX_HEADS * FOX_DIM, FOX_HEADS * FOX_DIM, FOX_HEADS,
    DSA_Q_RANK, DSA_DIM, DSA_DIM, IDX_DIM, IDX_HEADS,
    SSD_INNER, SSD_XBC, SSD_HEADS,
    N_BRANCH * D_MODEL,
)
IN_TOTAL = sum(IN_SIZES)
MIX_TOTAL = sum(BRANCH_WIDTHS)

kernel_name = "hybrid_gated_parallel_mixers"


def rms_norm(x, g):
    xf = x.astype(jnp.float32)
    y = xf * lax.rsqrt(jnp.mean(xf * xf, axis=-1, keepdims=True) + EPS)
    return (y * g.astype(jnp.float32)).astype(x.dtype)


def split_axis(t, sizes, axis):
    return jnp.split(t, np.cumsum(sizes)[:-1].tolist(), axis=axis)


def heads(t, n):
    return t.reshape(t.shape[0], t.shape[1], n, -1)


def rotary(x, pos):
    half = x.shape[-1] // 2
    inv = 1.0 / (10000.0 ** (jnp.arange(half, dtype=jnp.float32) / half))
    ang = pos.astype(jnp.float32)[:, None] * inv[None, :]
    cos, sin = jnp.cos(ang)[:, None, :], jnp.sin(ang)[:, None, :]
    x1, x2 = x[..., :half], x[..., half:]
    return jnp.concatenate([x1 * cos - x2 * sin, x1 * sin + x2 * cos], axis=-1)


def t5_bucket(dist):
    max_exact = N_BUCKETS // 2
    d = jnp.maximum(dist, 0)
    log_ratio = jnp.log(jnp.maximum(d, 1).astype(jnp.float32) / max_exact) / math.log(MAX_DISTANCE / max_exact)
    large = jnp.minimum(max_exact + (log_ratio * (N_BUCKETS - max_exact)).astype(jnp.int32), N_BUCKETS - 1)
    return jnp.where(d < max_exact, d, large)


def retention(q, k, v, g):
    B, S, H, Dh = q.shape
    n = S // CHUNK
    pos = jnp.arange(S)
    q = rotary(q.astype(jnp.float32), pos)
    k = rotary(k.astype(jnp.float32), pos) * (Dh ** -0.5)
    v = v.astype(jnp.float32)
    log_gamma = jnp.log1p(-jnp.exp2(-5.0 - jnp.arange(H, dtype=jnp.float32)))
    qc = q.reshape(B, n, CHUNK, H, Dh)
    kc = k.reshape(B, n, CHUNK, H, Dh)
    vc = v.reshape(B, n, CHUNK, H, Dh)
    i = jnp.arange(CHUNK, dtype=jnp.float32)
    rel = i[:, None] - i[None, :]
    decay = jnp.where(rel >= 0, jnp.exp(log_gamma[:, None, None] * jnp.maximum(rel, 0.0)), 0.0)
    scores = jnp.einsum('bnihd,bnjhd->bnhij', qc, kc) * decay
    y_inner = jnp.einsum('bnhij,bnjhd->bnihd', scores, vc)
    k_dec = jnp.exp(log_gamma[None, :] * (CHUNK - 1.0 - i)[:, None])
    q_dec = jnp.exp(log_gamma[None, :] * (i + 1.0)[:, None])
    chunk_kv = jnp.einsum('bnjhd,jh,bnjhe->bnhde', kc, k_dec, vc)
    chunk_decay = jnp.exp(log_gamma * CHUNK)[None, :, None, None]

    def step(state, kv):
        return chunk_decay * state + kv, state

    _, prev = lax.scan(step, jnp.zeros((B, H, Dh, Dh), jnp.float32), jnp.moveaxis(chunk_kv, 1, 0))
    prev = jnp.moveaxis(prev, 0, 1)
    y_cross = jnp.einsum('bnihd,ih,bnhde->bnihe', qc, q_dec, prev)
    y = (y_inner + y_cross).reshape(B, S, H, Dh)
    yc = y - jnp.mean(y, axis=-1, keepdims=True)
    y = yc * lax.rsqrt(jnp.mean(yc * yc, axis=-1, keepdims=True) + EPS)
    out = jax.nn.silu(g.astype(jnp.float32)) * y
    return out.reshape(B, S, H * Dh)


def forgetting_attention(q, k, v, f_logit, qn_g, kn_g):
    B, S, H, Dh = q.shape
    nb = S // Q_BLOCK
    q = rms_norm(q.astype(jnp.float32), qn_g) * (Dh ** -0.5)
    k = rms_norm(k.astype(jnp.float32), kn_g)
    v = v.astype(jnp.float32)
    F = jnp.cumsum(jax.nn.log_sigmoid(f_logit.astype(jnp.float32)), axis=1)
    FT = F.transpose(0, 2, 1)
    qb = q.reshape(B, nb, Q_BLOCK, H, Dh).transpose(1, 0, 2, 3, 4)
    Fb = F.reshape(B, nb, Q_BLOCK, H).transpose(1, 0, 3, 2)
    tb = jnp.arange(S).reshape(nb, Q_BLOCK)
    s_idx = jnp.arange(S)

    def block(args):
        qi, Fi, ti = args
        logits = jnp.einsum('bqhd,bshd->bhqs', qi, k) + (Fi[..., None] - FT[:, :, None, :])
        logits = jnp.where((s_idx[None, :] <= ti[:, None])[None, None], logits, -jnp.inf)
        p = jax.nn.softmax(logits, axis=-1)
        return jnp.einsum('bhqs,bshd->bqhd', p, v)

    out = lax.map(block, (qb, Fb, tb))
    return out.transpose(1, 0, 2, 3, 4).reshape(B, S, H * Dh)


def sparse_attention(c_q, k, v, idx_k, idx_w, cq_g, w_uq, w_qidx, qn_g, kn_g, rel_bias):
    B, S, _ = c_q.shape
    nb = S // Q_BLOCK
    topk = min(DSA_TOPK, S // 4)
    cq = rms_norm(c_q, cq_g)
    q = rms_norm((cq @ w_uq).reshape(B, S, DSA_HEADS, DSA_DIM).astype(jnp.float32), qn_g) * (DSA_DIM ** -0.5)
    q_idx = (cq @ w_qidx).reshape(B, S, IDX_HEADS, IDX_DIM).astype(jnp.float32) * (IDX_DIM ** -0.5)
    w_h = idx_w.astype(jnp.float32) * (IDX_HEADS ** -0.5)
    k_idx = idx_k.astype(jnp.float32)
    k = rms_norm(k.astype(jnp.float32), kn_g)
    v = v.astype(jnp.float32)
    bias_table = rel_bias.astype(jnp.float32)
    qb = q.reshape(B, nb, Q_BLOCK, DSA_HEADS, DSA_DIM).transpose(1, 0, 2, 3, 4)
    qib = q_idx.reshape(B, nb, Q_BLOCK, IDX_HEADS, IDX_DIM).transpose(1, 0, 2, 3, 4)
    wb = w_h.reshape(B, nb, Q_BLOCK, IDX_HEADS).transpose(1, 0, 2, 3)
    tb = jnp.arange(S).reshape(nb, Q_BLOCK)
    s_idx = jnp.arange(S)
    gather = jax.vmap(lambda kb, sb: kb[sb])

    def block(args):
        qi, qidx_i, wi, ti = args
        score = jax.nn.relu(jnp.einsum('bqhd,bsd->bqhs', qidx_i, k_idx))
        score = jnp.einsum('bqh,bqhs->bqs', wi, score)
        score = jnp.where((s_idx[None, :] <= ti[:, None])[None], score, -jnp.inf)
        _, sel = lax.top_k(score, topk)
        valid = sel <= ti[None, :, None]
        k_sel = gather(k, sel)
        v_sel = gather(v, sel)
        bias = bias_table[t5_bucket(ti[None, :, None] - sel)].transpose(0, 3, 1, 2)
        logits = jnp.einsum('bqhd,bqkd->bhqk', qi, k_sel) + bias
        logits = jnp.where(valid[:, None], logits, -jnp.inf)
        p = jax.nn.softmax(logits, axis=-1)
        return jnp.einsum('bhqk,bqkd->bqhd', p, v_sel)

    out = lax.map(block, (qb, qib, wb, tb))
    return out.transpose(1, 0, 2, 3, 4).reshape(B, S, DSA_HEADS * DSA_DIM)


def segsum_exp(a_cs):
    L = a_cs.shape[-1]
    mask = jnp.tril(jnp.ones((L, L), dtype=bool))
    diff = a_cs[..., :, None] - a_cs[..., None, :]
    return jnp.where(mask, jnp.exp(jnp.where(mask, diff, 0.0)), 0.0)


def ssd_mixer(z, xbc, dt_raw, conv_w, conv_b, dt_bias, a_log, d_skip, norm_g):
    B, S, _ = xbc.shape
    G, R, P, N = SSD_GROUPS, SSD_HEADS // SSD_GROUPS, SSD_HEAD_DIM, SSD_STATE
    n = S // CHUNK
    conv = lax.conv_general_dilated(
        xbc.astype(jnp.float32), conv_w.astype(jnp.float32)[:, None, :], window_strides=(1,),
        padding=[(SSD_CONV - 1, 0)], dimension_numbers=('NWC', 'WIO', 'NWC'),
        feature_group_count=SSD_XBC)
    xbc = jax.nn.silu(conv + conv_b.astype(jnp.float32))
    xs, Bm, Cm = split_axis(xbc, (SSD_INNER, G * N, G * N), axis=-1)
    xs = xs.reshape(B, S, G, R, P)
    dt = jax.nn.softplus(dt_raw.astype(jnp.float32) + dt_bias.astype(jnp.float32)).reshape(B, S, G, R)
    A = -jnp.exp(a_log.astype(jnp.float32)).reshape(G, R)
    xc = (xs * dt[..., None]).reshape(B, n, CHUNK, G, R, P)
    Bc = Bm.reshape(B, n, CHUNK, G, N)
    Cc = Cm.reshape(B, n, CHUNK, G, N)
    a = (dt * A).reshape(B, n, CHUNK, G, R).transpose(0, 3, 4, 1, 2)
    a_cs = jnp.cumsum(a, axis=-1)
    cb = jnp.einsum('bnlgk,bnsgk->bgnls', Cc, Bc)
    y_diag = jnp.einsum('bgnls,bgrnls,bnsgrp->bnlgrp', cb, segsum_exp(a_cs), xc)
    decay_states = jnp.exp(a_cs[..., -1:] - a_cs)
    states = jnp.einsum('bnlgk,bgrnl,bnlgrp->bngrpk', Bc, decay_states, xc)
    chunk_decay = jnp.exp(a_cs[..., -1])

    def step(state, inp):
        st, dec = inp
        return dec[..., None, None] * state + st, state

    _, prev = lax.scan(step, jnp.zeros((B, G, R, P, N), jnp.float32),
                       (jnp.moveaxis(states, 1, 0), jnp.moveaxis(chunk_decay, -1, 0)))
    prev = jnp.moveaxis(prev, 0, 1)
    y_off = jnp.einsum('bnlgk,bngrpk,bgrnl->bnlgrp', Cc, prev, jnp.exp(a_cs))
    y = (y_diag + y_off).reshape(B, S, G, R, P) + d_skip.astype(jnp.float32).reshape(G, R)[..., None] * xs
    gated = y.reshape(B, S, SSD_INNER) * jax.nn.silu(z.astype(jnp.float32))
    gated = rms_norm(gated.reshape(B, S, G, SSD_INNER // G), norm_g.reshape(G, SSD_INNER // G))
    return gated.reshape(B, S, SSD_INNER)


def setup_inputs(seed: int = 0) -> dict:
    key = jax.random.key(seed)
    ks = jax.random.split(key, 32)
    f32 = jnp.float32

    def nrm(k, shape, fan_in):
        return jax.random.normal(k, shape, f32) * (fan_in ** -0.5)

    def gain(k, shape):
        return 1.0 + 0.02 * jax.random.normal(k, shape, f32)

    dt0 = jnp.exp(jax.random.uniform(ks[16], (DEPTH, SSD_HEADS), f32, math.log(1e-3), math.log(1e-1)))
    br_keys = jax.random.split(ks[20], N_BRANCH)
    w_br = jnp.concatenate([nrm(br_keys[i], (DEPTH, w, D_MODEL), w) for i, w in enumerate(BRANCH_WIDTHS)], axis=1)
    return {
        "x": jax.random.normal(ks[0], (BATCH, SEQ, D_MODEL), f32),
        "norm1_g": gain(ks[1], (DEPTH, D_MODEL)),
        "w_in": nrm(ks[2], (DEPTH, D_MODEL, IN_TOTAL), D_MODEL),
        "gate_b": 0.02 * jax.random.normal(ks[3], (DEPTH, N_BRANCH * D_MODEL), f32),
        "fox_f_b": jax.random.uniform(ks[4], (DEPTH, FOX_HEADS), f32, 1.0, 5.0),
        "fox_qn_g": gain(ks[5], (DEPTH, FOX_DIM)),
        "fox_kn_g": gain(ks[6], (DEPTH, FOX_DIM)),
        "dsa_cq_g": gain(ks[7], (DEPTH, DSA_Q_RANK)),
        "dsa_w_uq": nrm(ks[8], (DEPTH, DSA_Q_RANK, DSA_HEADS * DSA_DIM), DSA_Q_RANK),
        "dsa_w_qidx": nrm(ks[9], (DEPTH, DSA_Q_RANK, IDX_HEADS * IDX_DIM), DSA_Q_RANK),
        "dsa_qn_g": gain(ks[10], (DEPTH, DSA_DIM)),
        "dsa_kn_g": gain(ks[11], (DEPTH, DSA_DIM)),
        "rel_bias": 0.5 * jax.random.normal(ks[12], (N_BUCKETS, DSA_HEADS), f32),
        "ssd_conv_w": jax.random.uniform(ks[13], (DEPTH, SSD_CONV, SSD_XBC), f32, -1.0, 1.0) * (SSD_CONV ** -0.5),
        "ssd_conv_b": 0.02 * jax.random.normal(ks[14], (DEPTH, SSD_XBC), f32),
        "ssd_dt_bias": dt0 + jnp.log(-jnp.expm1(-dt0)),
        "ssd_a_log": jnp.log(jax.random.uniform(ks[17], (DEPTH, SSD_HEADS), f32, 1.0, 16.0)),
        "ssd_d": 1.0 + 0.1 * jax.random.normal(ks[18], (DEPTH, SSD_HEADS), f32),
        "ssd_norm_g": gain(ks[19], (DEPTH, SSD_INNER)),
        "w_br": w_br,
        "w_out": nrm(ks[21], (DEPTH, D_MODEL, D_MODEL), D_MODEL),
        "norm2_g": gain(ks[22], (DEPTH, D_MODEL)),
        "w_ff1": nrm(ks[23], (DEPTH, D_MODEL, D_FF), D_MODEL),
        "w_ff2": nrm(ks[24], (DEPTH, D_FF, D_MODEL), D_FF),
    }


def reference(x, norm1_g, w_in, gate_b, fox_f_b, fox_qn_g, fox_kn_g, dsa_cq_g, dsa_w_uq, dsa_w_qidx,
              dsa_qn_g, dsa_kn_g, rel_bias, ssd_conv_w, ssd_conv_b, ssd_dt_bias, ssd_a_log, ssd_d,
              ssd_norm_g, w_br, w_out, norm2_g, w_ff1, w_ff2):
    B, S, _ = x.shape
    for l in range(DEPTH):
        h = rms_norm(x, norm1_g[l])
        (r_q, r_k, r_v, r_g, f_q, f_k, f_v, f_f, d_cq, d_k, d_v, i_k, i_w,
         s_z, s_xbc, s_dt, g_lin) = split_axis(h @ w_in[l], IN_SIZES, axis=-1)
        o_ret = retention(heads(r_q, RET_HEADS), heads(r_k, RET_HEADS), heads(r_v, RET_HEADS), heads(r_g, RET_HEADS))
        o_fox = forgetting_attention(heads(f_q, FOX_HEADS), heads(f_k, FOX_HEADS), heads(f_v, FOX_HEADS),
                                     f_f + fox_f_b[l], fox_qn_g[l], fox_kn_g[l])
        o_dsa = sparse_attention(d_cq, d_k, d_v, i_k, i_w, dsa_cq_g[l], dsa_w_uq[l], dsa_w_qidx[l],
                                 dsa_qn_g[l], dsa_kn_g[l], rel_bias)
        o_ssd = ssd_mixer(s_z, s_xbc, s_dt, ssd_conv_w[l], ssd_conv_b[l], ssd_dt_bias[l], ssd_a_log[l],
                          ssd_d[l], ssd_norm_g[l])
        gates = jax.nn.sigmoid((g_lin + gate_b[l]).astype(jnp.float32)).astype(x.dtype)
        gates = gates.reshape(B, S, N_BRANCH, D_MODEL)
        w_branch = split_axis(w_br[l], BRANCH_WIDTHS, axis=0)
        branch_out = (o_ret, o_fox, o_dsa, o_ssd)
        merged = sum(gates[:, :, i] * (branch_out[i].astype(x.dtype) @ w_branch[i]) for i in range(N_BRANCH))
        x = x + merged @ w_out[l]
        h2 = rms_norm(x, norm2_g[l])
        x = x + jnp.square(jax.nn.relu(h2 @ w_ff1[l])) @ w_ff2[l]
    return x
```

```cpp
#include <hip/hip_runtime.h>
#include <cstdio>
#include <cstdint>

#ifndef MK_PER_PHASE
#define MK_PER_PHASE 0
#endif
#ifndef REPEAT_PH
#define REPEAT_PH -1
#endif
#ifndef REP_UM
#define REP_UM 0xFF
#endif
#ifndef PHMASK
#define PHMASK 0xFFFFu
#endif
#define PH_ON(k) ((PHMASK >> (k)) & 1u)
#ifndef UM
#define UM 0xFF
#endif

#define DI __device__ __forceinline__
#define LAS __attribute__((address_space(3)))
#define GAS __attribute__((address_space(1)))
typedef unsigned short bf16_t;
typedef short bf16x8 __attribute__((ext_vector_type(8)));
typedef short s16x4 __attribute__((ext_vector_type(4)));
typedef float f32x2 __attribute__((ext_vector_type(2)));
typedef float f32x4 __attribute__((ext_vector_type(4)));
typedef float f32x16 __attribute__((ext_vector_type(16)));
typedef unsigned u32x2 __attribute__((ext_vector_type(2)));
typedef unsigned u32x4 __attribute__((ext_vector_type(4)));
typedef __bf16 bf16x2_t __attribute__((ext_vector_type(2)));
typedef GAS unsigned gu32;
typedef LAS unsigned char* ldsp;

constexpr int NB = 4, SEQ = 2048, DM = 2048, DEPTH = 4, MTOK = NB * SEQ;
constexpr int DFF = 8192, IN_TOTAL = 15204;
constexpr int NMIX = 7168, NGATE = 8192, NIN = NMIX + NGATE;
constexpr int NUP = 1536, KUP = 512, KBR = 2560;
constexpr float EPS = 1e-6f;
constexpr float LOG2E = 1.4426950408889634f;
constexpr int C_RQ = 0, C_RK = 512, C_RV = 1024, C_RG = 1536, C_FQ = 2048, C_FK = 2560, C_FV = 3072, C_DCQ = 3584, C_DK = 4096, C_DV = 4224,
              C_IK = 4352, C_SZ = 4416, C_SX = 5440, C_SB = 6464, C_SC = 6720, C_IW = 6976, C_SDT = 6992, C_FF = 7008, C_MIXEND = 7012;
constexpr int O_RET = 0, O_FOX = 512, O_DSA = 1024, O_SSD = 1536;

constexpr size_t MiB = 1u << 20;
constexpr size_t WS_CTL = 0, CTL_ZERO_BYTES = 1 * MiB;
constexpr size_t WL_IN = 0, WL_UP = WL_IN + (size_t)NIN * DM * 2, WL_BR = WL_UP + (size_t)NUP * KUP * 2, WL_OUT = WL_BR + (size_t)DM * KBR * 2,
                 WL_FF1 = WL_OUT + (size_t)DM * DM * 2, WL_FF2 = WL_FF1 + (size_t)DFF * DM * 2, WL_SIZE = WL_FF2 + (size_t)DM * DFF * 2;
constexpr size_t WS_W = 2 * MiB;
constexpr size_t WS_ACT = ((WS_W + DEPTH * WL_SIZE + MiB - 1) / MiB) * MiB;
constexpr size_t WS_XRES = WS_ACT, WS_X1 = WS_XRES + 64 * MiB, WS_HN = WS_X1 + 64 * MiB, WS_MIX = WS_HN + 32 * MiB, WS_GATES = WS_MIX + 112 * MiB,
                 WS_QUP = WS_GATES + 128 * MiB, WS_OALL = WS_QUP + 24 * MiB, WS_MERGED = WS_OALL + 40 * MiB, WS_FFH = WS_MERGED + 32 * MiB,
                 WS_SCORES = WS_FFH + 128 * MiB, WS_KVS = WS_SCORES + 64 * MiB, WS_PREVR = WS_KVS + 16 * MiB, WS_ST = WS_PREVR + 8 * MiB,
                 WS_PREVS = WS_ST + 32 * MiB, WS_XBCC = WS_PREVS + 16 * MiB, WS_ACS = WS_XBCC + 24 * MiB, WS_BS = WS_ACS + 1 * MiB, WS_SSQH = WS_BS + 1 * MiB, WS_SSP = WS_SSQH + 1 * MiB, WS_FOXKN = WS_SSP + 1 * MiB, WS_DSAKN = WS_FOXKN + 8 * MiB, WS_MSK = WS_DSAKN + 2 * MiB,
                 WS_ONES = WS_MSK + 2 * MiB, WS_ONESB = WS_ONES + 4096, WS_END = WS_ONES + 1 * MiB;
constexpr int CW_BAR = 4096;
constexpr int CW_QUEUE = 16384;
constexpr int NQUEUE = 16;

constexpr int LDS_BYTES = 147456;
constexpr int LDS_WORK = 143360;
constexpr int LDS_MISC = LDS_WORK;

DI float bf2f(unsigned short b) { return __uint_as_float(((unsigned)b) << 16); }
DI float bflo(unsigned u) { return __uint_as_float(u << 16); }
DI float bfhi(unsigned u) { return __uint_as_float(u & 0xffff0000u); }
DI unsigned pk2(float lo, float hi) { f32x2 v = {lo, hi}; bf16x2_t b = __builtin_convertvector(v, bf16x2_t); return __builtin_bit_cast(unsigned, b); }
DI unsigned short f2bf(float f) { return (unsigned short)(pk2(f, 0.f) & 0xffffu); }
DI bf16x8 pack8(float a0, float a1, float a2, float a3, float a4, float a5, float a6, float a7) {
    u32x4 p; p.x = pk2(a0, a1); p.y = pk2(a2, a3); p.z = pk2(a4, a5); p.w = pk2(a6, a7); return __builtin_bit_cast(bf16x8, p); }
DI void unpack8(const u32x4 v, float (&f)[8]) { f[0] = bflo(v.x); f[1] = bfhi(v.x); f[2] = bflo(v.y); f[3] = bfhi(v.y); f[4] = bflo(v.z); f[5] = bfhi(v.z); f[6] = bflo(v.w); f[7] = bfhi(v.w); }
DI float sigmoidf_(float x) { return __builtin_amdgcn_rcpf(1.f + __builtin_amdgcn_exp2f(-LOG2E * x)); }
DI float siluf_(float x) { return x * __builtin_amdgcn_rcpf(1.f + __builtin_amdgcn_exp2f(-LOG2E * x)); }
#define MFMA32(a, b, c) __builtin_amdgcn_mfma_f32_32x32x16_bf16((a), (b), (c), 0, 0, 0)
DI int crow(int i, int h) { return (i & 3) + 8 * (i >> 2) + 4 * h; }
DI s16x4 trrd(ldsp p) { return __builtin_bit_cast(s16x4, __builtin_amdgcn_ds_read_tr16_b64_v4i16((LAS s16x4*)p)); }
DI bf16x8 tr_pair(ldsp p, int off2) { s16x4 lo = trrd(p), hi = trrd(p + off2); return __builtin_shufflevector(lo, hi, 0, 1, 2, 3, 4, 5, 6, 7); }
DI float shidx(float v, int src) { return __int_as_float(__builtin_amdgcn_ds_bpermute(src << 2, __float_as_int(v))); }
DI float shx(float v, int m, int lane) { return shidx(v, lane ^ m); }
DI void store_pair_t21(bf16_t* rowp, int k, u32x2 a, u32x2 b, int h) {
    const auto rx = __builtin_amdgcn_permlane32_swap(a.x, b.x, false, false), ry = __builtin_amdgcn_permlane32_swap(a.y, b.y, false, false);
    u32x4 w; w.x = rx[0]; w.y = ry[0]; w.z = rx[1]; w.w = ry[1];
    *(u32x4*)(rowp + 8 * k + (h ? 8 : 0)) = w;
}
DI f32x16 zero16() { f32x16 z; for (int i = 0; i < 16; ++i) z[i] = 0.f; return z; }

#define XB_TMO      128
#define XB_XCNT(j)  (256  + 64 * (j))
#define XB_XSUB(j)  (1280 + 64 * (j))
#define XB_XGEN(j)  (2304 + 64 * (j))
#define XB_TOP      3328
#define XB_TOPGEN   3392
#define XCD_BAR_WORDS 3456
#define XB_SPIN_CAP (1u << 18)
DI unsigned xb_ld(unsigned* p)              { return __hip_atomic_load(p, __ATOMIC_RELAXED, __HIP_MEMORY_SCOPE_AGENT); }
DI unsigned xb_add(unsigned* p, unsigned v) { return __hip_atomic_fetch_add(p, v, __ATOMIC_RELAXED, __HIP_MEMORY_SCOPE_AGENT); }
DI unsigned xb_xcc_id() { return (unsigned)__builtin_amdgcn_s_getreg((3 << 11) | 20) & 0xFu; }
#define XB_SPIN(cond, bar) do { unsigned _sp = 0; while (cond) { __builtin_amdgcn_s_sleep(1); \
    if ((++_sp & 255u) == 0u) { if (xb_ld(&(bar)[XB_TMO])) break; if (_sp > XB_SPIN_CAP) { atomicAdd(&(bar)[XB_TMO], 1u); break; } } } } while (0)
struct XcdBarrier { unsigned* bar; unsigned x; volatile LAS unsigned* st; };
DI XcdBarrier xcd_barrier_post(unsigned* bar, volatile LAS unsigned* st) {
    XcdBarrier b; b.bar = bar; b.x = xb_xcc_id(); b.st = st;
    if (threadIdx.x == 0) (void)xb_add(&bar[XB_XCNT(b.x)], 1u);
    return b;
}
DI void xcd_barrier_complete(unsigned* bar, unsigned x, unsigned& nloc, unsigned& nx) {
    const unsigned G = gridDim.x * gridDim.y * gridDim.z;
    unsigned sum, cnt, mine, sp = 0u;
    for (;;) {
        sum = 0u; cnt = 0u; mine = 0u;
#pragma unroll
        for (unsigned j = 0; j < 16; ++j) { const unsigned c = xb_ld(&bar[XB_XCNT(j)]); sum += c; cnt += (c > 0u) ? 1u : 0u; mine = (j == x) ? c : mine; }
        if (sum == G) break;
        __builtin_amdgcn_s_sleep(1);
        if ((++sp & 255u) == 0u) { if (xb_ld(&bar[XB_TMO])) break; if (sp > XB_SPIN_CAP) { atomicAdd(&bar[XB_TMO], 1u); break; } }
    }
    nloc = mine > 0u ? mine : 1u; nx = cnt > 0u ? cnt : 1u;
}
DI void xcd_barrier(const XcdBarrier& b) {
    asm volatile("s_waitcnt vmcnt(0)" ::: "memory");
    __syncthreads();
    if (threadIdx.x == 0) {
        unsigned* bar = b.bar; { GAS unsigned* w = (GAS unsigned*)bar; asm volatile("" : "+s"(w)); bar = (unsigned*)w; }
        __builtin_amdgcn_s_waitcnt(0);
        unsigned nloc = b.st[0], nx = b.st[1];
        if (nloc == 0u) { xcd_barrier_complete(bar, b.x, nloc, nx); b.st[0] = nloc; b.st[1] = nx; }
        const unsigned old = xb_add(&bar[XB_XSUB(b.x)], 1u);
        const unsigned gen = old / nloc;
        if (old + 1u == (gen + 1u) * nloc) {
            __builtin_amdgcn_fence(__ATOMIC_RELEASE, "agent");
            asm volatile("s_waitcnt vmcnt(0)" ::: "memory");
            const unsigned og = xb_add(&bar[XB_TOP], 1u);
            const unsigned tg = og / nx;
            if (og + 1u == (tg + 1u) * nx) xb_add(&bar[XB_TOPGEN], 1u);
            else XB_SPIN(xb_ld(&bar[XB_TOPGEN]) == tg, bar);
            __builtin_amdgcn_fence(__ATOMIC_ACQUIRE, "agent");
            xb_add(&bar[XB_XGEN(b.x)], 1u);
            asm volatile("s_waitcnt vmcnt(0)" ::: "memory");
        } else {
            XB_SPIN(xb_ld(&bar[XB_XGEN(b.x)]) == gen, bar);
            __builtin_amdgcn_fence(__ATOMIC_ACQUIRE, "agent");
            asm volatile("s_waitcnt vmcnt(0)" ::: "memory");
        }
    }
    __syncthreads();
}

namespace pg8 {
constexpr int BM = 256, BK = 64, HALF = 128, HTB = HALF * BK * 2, STAGE_BYTES = 8 * HTB, NXCD = 8, WGM = 8;
__host__ __device__ __forceinline__ int lds_byte(int r, int c) { const int st = (r >> 4) * 2 + (c >> 5), rr = r & 15, cc = c & 31, ob = rr * 64 + cc * 2; return st * 1024 + (ob ^ (((ob >> 9) & 1) << 5)); }
__host__ __device__ __forceinline__ void stage_rc(int b, int& R, int& C) { const int st = b / 1024, sb = b % 1024, swz = sb ^ (((sb >> 9) & 1) << 5); R = (st >> 1) * 16 + swz / 64; C = (st & 1) * 32 + (swz % 64) / 2; }
__host__ __device__ __forceinline__ int perm32(int rho) { const int n = rho >> 4, i = rho & 15; return 8 * (i >> 2) + 4 * n + (i & 3); }
struct Unit { int pm, pn; };
struct Gemm { const bf16_t* A; const bf16_t* Bt; int M, N, K, lda, ldb; };
struct StaticOrder {
    int nM, nN, nwg, G, c;
    __host__ __device__ void init(int M, int N, int G_, int c_) { nM = M / BM; nN = N / BM; nwg = nM * nN; G = G_; c = c_; }
    __host__ __device__ bool next(int i, Unit& u) const {
        const long L = (long)i * G + c; if (L >= nwg) return false;
        int wgid = (int)L; { const int q = nwg / NXCD, r = nwg % NXCD, xcd = wgid % NXCD, off = wgid / NXCD; wgid = (xcd < r ? xcd * (q + 1) : r * (q + 1) + (xcd - r) * q) + off; }
        const int nig = WGM * nN, gid = wgid / nig, fm = gid * WGM, gsz = (nM - fm) < WGM ? (nM - fm) : WGM;
        u.pm = fm + ((wgid % nig) % gsz); u.pn = (wgid % nig) / gsz; return true;
    }
};
typedef f32x4 Acc[2][2][4][2];

template <class Epi>
DI void gemm_phase(ldsp lds, const Gemm g, const StaticOrder& S, const Epi& E) {
    int tid = threadIdx.x; asm volatile("" : "+v"(tid));
    const int wid = __builtin_amdgcn_readfirstlane(tid >> 6), lane = tid & 63, wr = wid >> 2, wc = wid & 3, fr = lane & 15, fq = lane >> 4;
    const int K = g.K, nt = K / BK;
    unsigned voffA[2], voffB[2];
#pragma unroll
    for (int i = 0; i < 2; ++i) { int R, C; stage_rc(tid * 16 + i * 8192, R, C); const int Rb = Epi::PERM ? ((R & ~31) + perm32(R & 31)) : R;
        voffA[i] = (unsigned)(R * g.lda + C) * 2u; voffB[i] = (unsigned)(Rb * g.ldb + C) * 2u; }
    const size_t kstep = (size_t)(BK * 2);
    const size_t hstepA = (size_t)HALF * g.lda * 2, hstepB = (size_t)HALF * g.ldb * 2;
    const size_t tstepA = 2 * hstepA, tstepB = 2 * hstepB;
    const unsigned ldsw = (unsigned)wid * 1024u;
    const int aoff = lds_byte(wr * 64 + fr, fq * 8), boff = lds_byte(wc * 32 + fr, fq * 8);
#define PG8_SA(b, h) (((b) * 2 + (h)) * HTB)
#define PG8_SB(b, h) ((4 + (b) * 2 + (h)) * HTB)
#define PG8_STAGE(bufoff, gbase, voff) do { _Pragma("unroll") for (int _i = 0; _i < 2; ++_i) \
        __builtin_amdgcn_global_load_lds((const unsigned*)((const char*)(gbase) + (voff)[_i]), (LAS unsigned*)(lds + (bufoff) + ldsw + _i * 8192), 16, 0, 0); } while (0)
#define PG8_LDA(dst, b, h) do { _Pragma("unroll") for (int m = 0; m < 4; ++m) _Pragma("unroll") for (int k = 0; k < 2; ++k) dst[m][k] = *(const LAS bf16x8*)(lds + PG8_SA(b, h) + aoff + m * 2048 + k * 1024); } while (0)
#define PG8_LDB(dst, b, h) do { _Pragma("unroll") for (int n = 0; n < 2; ++n) _Pragma("unroll") for (int k = 0; k < 2; ++k) dst[n][k] = *(const LAS bf16x8*)(lds + PG8_SB(b, h) + boff + n * 2048 + k * 1024); } while (0)
#define PG8_MMA(ai, bj, At, Bt) do { __builtin_amdgcn_s_setprio(1); _Pragma("unroll") for (int m = 0; m < 4; ++m) _Pragma("unroll") for (int n = 0; n < 2; ++n) _Pragma("unroll") for (int k = 0; k < 2; ++k) \
        acc[ai][bj][m][n] = __builtin_amdgcn_mfma_f32_16x16x32_bf16(Bt[n][k], At[m][k], acc[ai][bj][m][n], 0, 0, 0); __builtin_amdgcn_s_setprio(0); } while (0)
#define PG8_WAIT_V(n) asm volatile("s_waitcnt vmcnt(" #n ")" ::: "memory")
#define PG8_WAIT_L(n) asm volatile("s_waitcnt lgkmcnt(" #n ")" ::: "memory")
#define PG8_BAR __builtin_amdgcn_s_barrier()
#define PG8_SCHED __builtin_amdgcn_sched_barrier(0)
    Unit cur, nxt; int ui = 0;
    if (!S.next(0, cur)) return;
    if constexpr (Epi::HAS_MID) { E.prep(lds, cur, tid); __syncthreads(); }
    Acc acc;
#pragma unroll
    for (int a = 0; a < 2; ++a)
#pragma unroll
        for (int b = 0; b < 2; ++b)
#pragma unroll
            for (int m = 0; m < 4; ++m)
#pragma unroll
                for (int n = 0; n < 2; ++n) acc[a][b][m][n] = (f32x4){0.f, 0.f, 0.f, 0.f};
    bf16x8 At[4][2], B0[2][2], B1[2][2];
    f32x4 rsA = {0.f, 0.f, 0.f, 0.f}, rsB = rsA;
    const char* cA = (const char*)g.A + (size_t)cur.pm * tstepA; const char* cB = (const char*)g.Bt + (size_t)cur.pn * tstepB;
    PG8_STAGE(PG8_SB(0, 0), cB, voffB); PG8_STAGE(PG8_SB(0, 1), cB + hstepB, voffB); PG8_STAGE(PG8_SA(0, 0), cA, voffA); PG8_STAGE(PG8_SA(0, 1), cA + hstepA, voffA);
    if (wr == 1) PG8_BAR;
    PG8_WAIT_V(2); PG8_BAR;
    PG8_STAGE(PG8_SB(1, 0), cB + kstep, voffB); PG8_STAGE(PG8_SA(1, 0), cA + kstep, voffA); PG8_STAGE(PG8_SB(1, 1), cB + hstepB + kstep, voffB);
    PG8_WAIT_V(6); PG8_BAR;
    for (;;) {
        const bool has_next = S.next(ui + 1, nxt);
        const char* nA = has_next ? (const char*)g.A + (size_t)nxt.pm * tstepA : cA; const char* nB = has_next ? (const char*)g.Bt + (size_t)nxt.pn * tstepB : cB;
        for (int t = 0; t < nt; t += 2) {
            const bool last = (t == nt - 2);
            const char* a1 = cA + (size_t)(t + 1) * kstep;
            const char* a2 = last ? nA : cA + (size_t)(t + 2) * kstep; const char* b2 = last ? nB : cB + (size_t)(t + 2) * kstep;
            const char* a3 = a2 + kstep; const char* b3 = b2 + kstep;
            if constexpr (Epi::HAS_MID) { if (E.is_mid(t)) { E.mid(acc, cur, t, wr, wc, fr, fq, lds); PG8_SCHED; } }
            if constexpr (Epi::ROWSCALE) { if (last && tid < 256) { const f32x4* sp = (const f32x4*)(E.ssp + (size_t)(cur.pm * BM + tid) * 8); rsA = sp[0]; rsB = sp[1]; } }
            PG8_LDB(B0, 0, 0); PG8_LDB(B1, 0, 1); PG8_SCHED; PG8_LDA(At, 0, 0); PG8_STAGE(PG8_SA(1, 1), a1 + hstepA, voffA);
            PG8_WAIT_V(8); PG8_WAIT_L(0); PG8_BAR; PG8_MMA(0, 0, At, B0); PG8_MMA(0, 1, At, B1); PG8_BAR; PG8_SCHED;
            PG8_LDA(At, 0, 1); PG8_STAGE(PG8_SB(0, 0), b2, voffB); PG8_STAGE(PG8_SB(0, 1), b2 + hstepB, voffB); PG8_STAGE(PG8_SA(0, 0), a2, voffA);
            PG8_WAIT_V(8); PG8_WAIT_L(0); PG8_BAR; PG8_MMA(1, 0, At, B0); PG8_MMA(1, 1, At, B1); PG8_BAR; PG8_SCHED;
            PG8_LDB(B0, 1, 0); PG8_LDB(B1, 1, 1); PG8_SCHED; PG8_LDA(At, 1, 0); PG8_STAGE(PG8_SA(0, 1), a2 + hstepA, voffA);
            PG8_WAIT_V(8); PG8_WAIT_L(0); PG8_BAR; PG8_MMA(0, 0, At, B0); PG8_MMA(0, 1, At, B1); PG8_BAR; PG8_SCHED;
            PG8_LDA(At, 1, 1); PG8_STAGE(PG8_SB(1, 0), b3, voffB); PG8_STAGE(PG8_SB(1, 1), b3 + hstepB, voffB); PG8_STAGE(PG8_SA(1, 0), a3, voffA);
            PG8_WAIT_V(8); PG8_WAIT_L(0); PG8_BAR; PG8_MMA(1, 0, At, B0); PG8_MMA(1, 1, At, B1); PG8_BAR; PG8_SCHED;
        }
        if (wr == 0) PG8_BAR;
        if constexpr (Epi::ROWSCALE) {
            LAS float* tab = (LAS float*)(lds + STAGE_BYTES);
            if (tid < 256) { const float t = ((rsA[0] + rsA[1]) + (rsA[2] + rsA[3])) + ((rsB[0] + rsB[1]) + (rsB[2] + rsB[3])); tab[tid] = __builtin_amdgcn_rsqf(t * (1.f / (float)DM) + EPS); }
            PG8_WAIT_L(0); PG8_BAR; asm volatile("" ::: "memory");
        }
        E(acc, cur, wr, wc, fr, fq, lds);
        if (!has_next) break;
#pragma unroll
        for (int a = 0; a < 2; ++a)
#pragma unroll
            for (int b = 0; b < 2; ++b)
#pragma unroll
                for (int m = 0; m < 4; ++m)
#pragma unroll
                    for (int n = 0; n < 2; ++n) acc[a][b][m][n] = (f32x4){0.f, 0.f, 0.f, 0.f};
        cur = nxt; cA = nA; cB = nB; ++ui;
        if constexpr (Epi::HAS_MID) { PG8_BAR; E.prep(lds, cur, tid); PG8_WAIT_L(0); PG8_BAR; }
        if (wr == 1) PG8_BAR;
    }
    PG8_WAIT_V(0);
    PG8_BAR;
#undef PG8_SA
#undef PG8_SB
#undef PG8_STAGE
#undef PG8_LDA
#undef PG8_LDB
#undef PG8_MMA
#undef PG8_WAIT_V
#undef PG8_WAIT_L
#undef PG8_BAR
#undef PG8_SCHED
}

DI void store8(bf16_t* p, const f32x4 v0, const f32x4 v1) { u32x4 w; w.x = pk2(v0[0], v0[1]); w.y = pk2(v0[2], v0[3]); w.z = pk2(v1[0], v1[1]); w.w = pk2(v1[2], v1[3]); *(u32x4*)p = w; }
struct EpiIn {
    static constexpr bool PERM = true, HAS_MID = false, ROWSCALE = true;
    bf16_t* mix; bf16_t* gates; const float* gate_b; const float* ssp;
    DI void operator()(const Acc& acc, const Unit& u, int wr, int wc, int fr, int fq, ldsp lds) const {
        const int row0 = u.pm * BM + wr * 64 + fr; const LAS float* tab = (const LAS float*)(lds + STAGE_BYTES);
        if (u.pn < NMIX / BM) {
            const int col0 = u.pn * BM + wc * 32 + 8 * fq;
#pragma unroll
            for (int ai = 0; ai < 2; ++ai)
#pragma unroll
                for (int m = 0; m < 4; ++m) { const float rs = tab[wr * 64 + fr + ai * HALF + m * 16]; bf16_t* rowp = mix + (size_t)(row0 + ai * HALF + m * 16) * NMIX + col0;
#pragma unroll
                    for (int bj = 0; bj < 2; ++bj) store8(rowp + bj * HALF, acc[ai][bj][m][0] * rs, acc[ai][bj][m][1] * rs); }
        } else {
            const int ch0 = (u.pn - NMIX / BM) * 64 + wc * 16 + 4 * fq;
            f32x4 bv[4];
#pragma unroll
            for (int i = 0; i < 4; ++i) bv[i] = *(const f32x4*)(gate_b + i * DM + ch0);
#pragma unroll
            for (int ai = 0; ai < 2; ++ai)
#pragma unroll
                for (int m = 0; m < 4; ++m) { const float rs = tab[wr * 64 + fr + ai * HALF + m * 16]; bf16_t* rowp = gates + (size_t)(row0 + ai * HALF + m * 16) * NGATE + ch0;
                    f32x4 d[4], e[4];
#pragma unroll
                    for (int i = 0; i < 4; ++i) { const f32x4 x = acc[ai][i >> 1][m][i & 1] * rs + bv[i];
#pragma unroll
                        for (int j = 0; j < 4; ++j) { d[i][j] = fminf(1.f + __builtin_amdgcn_exp2f(-LOG2E * x[j]), 1e20f); e[i][j] = __builtin_amdgcn_rcpf(d[i][j]); } }
#pragma unroll
                    for (int k = 0; k < 4; ++k) { const f32x4 r = (k < 3) ? e[k] * d[k < 3 ? k + 1 : 3] : e[3]; u32x2 w; w.x = pk2(r[0], r[1]); w.y = pk2(r[2], r[3]); *(u32x2*)(rowp + k * DM) = w; } }
        }
    }
};
template <int ACT  > struct EpiBf16 {
    static constexpr bool PERM = true, HAS_MID = false, ROWSCALE = (ACT == 1);
    bf16_t* O; int ldc; const float* ssp;
    DI void operator()(const Acc& acc, const Unit& u, int wr, int wc, int fr, int fq, ldsp lds) const {
        const int row0 = u.pm * BM + wr * 64 + fr, col0 = u.pn * BM + wc * 32 + 8 * fq; const LAS float* tab = (const LAS float*)(lds + STAGE_BYTES);
#pragma unroll
        for (int ai = 0; ai < 2; ++ai)
#pragma unroll
            for (int m = 0; m < 4; ++m) { bf16_t* rowp = O + (size_t)(row0 + ai * HALF + m * 16) * ldc + col0;
                float rs2 = 1.f; if (ACT == 1) { const float rs = tab[wr * 64 + fr + ai * HALF + m * 16]; rs2 = rs * rs; }
#pragma unroll
                for (int bj = 0; bj < 2; ++bj) { f32x4 v0 = acc[ai][bj][m][0], v1 = acc[ai][bj][m][1];
                    if (ACT == 1) {
#pragma unroll
                        for (int j = 0; j < 4; ++j) { const float a = fmaxf(v0[j], 0.f), b = fmaxf(v1[j], 0.f); v0[j] = a * a * rs2; v1[j] = b * b * rs2; } }
                    store8(rowp + bj * HALF, v0, v1); } }
    }
};
template <int RES, int OUTF> struct EpiResid {
    static constexpr bool PERM = false, HAS_MID = false, ROWSCALE = false;
    const void* resid; float* out; bf16_t* xb; float* ssp; int ldc;
    DI void operator()(const Acc& acc, const Unit& u, int wr, int wc, int fr, int fq, ldsp lds) const {
        const int row0 = u.pm * BM + wr * 64 + fr, col0 = u.pn * BM + wc * 32 + 4 * fq;
#pragma unroll
        for (int ai = 0; ai < 2; ++ai) {
            f32x4 rf[RES == 0 ? 4 : 1][2][2]; u32x2 rw[RES == 1 ? 4 : 1][2][2];
#pragma unroll
            for (int m = 0; m < 4; ++m) { const size_t off = (size_t)(row0 + ai * HALF + m * 16) * ldc + col0;
#pragma unroll
                for (int bj = 0; bj < 2; ++bj)
#pragma unroll
                    for (int n = 0; n < 2; ++n) {
                        if (RES == 0) rf[RES == 0 ? m : 0][bj][n] = *(const f32x4*)((const float*)resid + off + bj * HALF + n * 16);
                        else rw[RES == 1 ? m : 0][bj][n] = *(const u32x2*)((const bf16_t*)resid + off + bj * HALF + n * 16); } }
#pragma unroll
            for (int m = 0; m < 4; ++m) { const int row = row0 + ai * HALF + m * 16; const size_t off = (size_t)row * ldc + col0; float ss = 0.f;
#pragma unroll
                for (int bj = 0; bj < 2; ++bj)
#pragma unroll
                    for (int n = 0; n < 2; ++n) { f32x4 r;
                        if (RES == 0) r = rf[RES == 0 ? m : 0][bj][n];
                        else { const u32x2 w = rw[RES == 1 ? m : 0][bj][n]; r = (f32x4){bflo(w.x), bfhi(w.x), bflo(w.y), bfhi(w.y)}; }
                        const f32x4 o = r + acc[ai][bj][m][n];
                        if (OUTF) *(f32x4*)(out + off + bj * HALF + n * 16) = o;
                        else { ss += (o[0] * o[0] + o[1] * o[1]) + (o[2] * o[2] + o[3] * o[3]); u32x2 w; w.x = pk2(o[0], o[1]); w.y = pk2(o[2], o[3]); *(u32x2*)(xb + off + bj * HALF + n * 16) = w; } }
                if (!OUTF) { ss += shx(ss, 16, fr + 16 * fq); ss += shx(ss, 32, fr + 16 * fq); if (fq == 0) ((LAS float*)(lds + STAGE_BYTES))[(wr * 64 + fr + ai * HALF + m * 16) * 4 + wc] = ss; } } }
        if (!OUTF) {
            asm volatile("s_waitcnt lgkmcnt(0)" ::: "memory"); __builtin_amdgcn_s_barrier(); asm volatile("" ::: "memory");
            const int t = 64 * (4 * wr + wc) + fr + 16 * fq;
            if (t < 256) { const f32x4 q = *(const LAS f32x4*)(lds + STAGE_BYTES + t * 16); ssp[(size_t)(u.pm * BM + t) * 8 + u.pn] = (q[0] + q[1]) + (q[2] + q[3]); }
        }
    }
};
struct EpiMerge {
    static constexpr bool PERM = true, HAS_MID = true, ROWSCALE = false;
    bf16_t* O; const bf16_t* gates; const float* ssqh; const bf16_t* ones;
    DI bool is_mid(int t) const { return t == 8 || t == 16 || t == 24 || t == 32; }
    DI void prep(ldsp lds, const Unit& u, int tid) const {
        if (tid < 256) { const f32x4* p = (const f32x4*)(ssqh + (size_t)(u.pm * BM + tid) * 16); const f32x4 a = p[0], b = p[1], c = p[2], d = p[3];
            const float s0 = ((a[0] + a[1]) + (a[2] + a[3])) + ((b[0] + b[1]) + (b[2] + b[3])), s1 = ((c[0] + c[1]) + (c[2] + c[3])) + ((d[0] + d[1]) + (d[2] + d[3]));
            LAS float* tab = (LAS float*)(lds + STAGE_BYTES) + 2 * tid; tab[0] = __builtin_amdgcn_rsqf(s0 * (1.f / 512.f) + EPS); tab[1] = __builtin_amdgcn_rsqf(s1 * (1.f / 512.f) + EPS); }
    }
    DI void ld8(const bf16_t* p, float (&f)[8]) const { unpack8(*(const u32x4*)p, f); }
    DI void ldb(u32x4 (&g)[2][2], const bf16_t* pl, size_t pitch, int row0, int b) const {
#pragma unroll
        for (int m2 = 0; m2 < 2; ++m2)
#pragma unroll
            for (int bj = 0; bj < 2; ++bj) g[m2][bj] = *(const u32x4*)(pl + (size_t)(row0 + (b >> 1) * HALF + (2 * (b & 1) + m2) * 16) * pitch + bj * HALF);
    }
    DI void mid(Acc& acc, const Unit& u, int t, int wr, int wc, int fr, int fq, ldsp lds) const {
        int row0 = u.pm * BM + wr * 64 + fr; asm volatile("" : "+v"(row0));
        const int col0 = u.pn * BM + wc * 32 + 8 * fq;
        const int seg = t >> 3;
        const bf16_t* pl = (seg < 4 ? gates + (seg - 1) * DM : ones) + col0; const size_t pitch = seg < 4 ? (size_t)NGATE : (size_t)0;
        const unsigned m3 = (seg == 3) ? 0xffffffffu : 0u, m4 = (seg == 4) ? 0xffffffffu : 0u, one = 0x3f800000u;
        const LAS f32x2* tab = (const LAS f32x2*)(lds + STAGE_BYTES);
        u32x4 gb[2][2][2];
        ldb(gb[0], pl, pitch, row0, 0);
#pragma unroll
        for (int b = 0; b < 4; ++b) { const int ai = b >> 1, mh = b & 1;
            if (b + 1 < 4) ldb(gb[(b + 1) & 1], pl, pitch, row0, b + 1);
#pragma unroll
            for (int m2 = 0; m2 < 2; ++m2) { const int m = 2 * mh + m2; const f32x2 r = tab[wr * 64 + fr + ai * HALF + m * 16];
                const unsigned u0 = __float_as_uint(r[0]), u1 = __float_as_uint(r[1]);
                const float sa = __uint_as_float((u0 & m4) | (one & ~m4)), sb = __uint_as_float((u0 & m3) | (u1 & m4) | (one & ~(m3 | m4)));
                const float rr = sa * __builtin_amdgcn_rcpf(sb);
#pragma unroll
                for (int bj = 0; bj < 2; ++bj) { float q[8]; unpack8(gb[b & 1][m2][bj], q);
#pragma unroll
                    for (int j = 0; j < 4; ++j) { acc[ai][bj][m][0][j] *= q[j] * rr; acc[ai][bj][m][1][j] *= q[4 + j] * rr; } } }
            asm volatile("" ::: "memory"); }
    }
    DI void operator()(const Acc& acc, const Unit& u, int wr, int wc, int fr, int fq, ldsp lds) const {
        const int row0 = u.pm * BM + wr * 64 + fr, col0 = u.pn * BM + wc * 32 + 8 * fq;
        const LAS f32x2* tab = (const LAS f32x2*)(lds + STAGE_BYTES);
#pragma unroll
        for (int ai = 0; ai < 2; ++ai) {
            u32x4 gg[4][2];
#pragma unroll
            for (int m = 0; m < 4; ++m)
#pragma unroll
                for (int bj = 0; bj < 2; ++bj) gg[m][bj] = *(const u32x4*)(gates + (size_t)(row0 + ai * HALF + m * 16) * NGATE + 3 * DM + col0 + bj * HALF);
#pragma unroll
            for (int m = 0; m < 4; ++m) { const int row = row0 + ai * HALF + m * 16; const float r1 = tab[wr * 64 + fr + ai * HALF + m * 16][1];
#pragma unroll
                for (int bj = 0; bj < 2; ++bj) { float g[8]; unpack8(gg[m][bj], g); f32x4 v0 = acc[ai][bj][m][0], v1 = acc[ai][bj][m][1];
#pragma unroll
                    for (int j = 0; j < 4; ++j) { v0[j] *= g[j] * r1; v1[j] *= g[4 + j] * r1; }
                    store8(O + (size_t)row * DM + col0 + bj * HALF, v0, v1); } }
            asm volatile("" ::: "memory"); }
    }
};
}

struct Params {
    const float* x; const float* norm1_g; const float* w_in; const float* gate_b; const float* fox_f_b; const float* fox_qn_g; const float* fox_kn_g;
    const float* dsa_cq_g; const float* dsa_w_uq; const float* dsa_w_qidx; const float* dsa_qn_g; const float* dsa_kn_g; const float* rel_bias;
    const float* ssd_conv_w; const float* ssd_conv_b; const float* ssd_dt_bias; const float* ssd_a_log; const float* ssd_d; const float* ssd_norm_g;
    const float* w_br; const float* w_out; const float* norm2_g; const float* w_ff1; const float* w_ff2;
    float* out; unsigned char* ws;
    int ph_lo, ph_hi, rep, pad;
};
struct Ctx {
    ldsp lds; int tid, lane, wave, G, bid;
    gu32* ctl;
};
DI Ctx fresh(const Ctx& c0) { Ctx c = c0; int t = c0.tid; asm volatile("" : "+v"(t)); c.tid = t; c.lane = t & 63; c.wave = __builtin_amdgcn_readfirstlane(t >> 6); return c; }
DI Params freshp(const Params& p0) { Params p = p0; GAS unsigned char* w = (GAS unsigned char*)p0.ws; asm volatile("" : "+s"(w)); p.ws = (unsigned char*)w; return p; }
typedef __attribute__((address_space(4))) const Params* kargp;
DI Params loadp() {
#if defined(__HIP_DEVICE_COMPILE__)
    kargp k = (kargp)__builtin_amdgcn_kernarg_segment_ptr(); asm volatile("" : "+s"(k)); Params p = *k;
    GAS unsigned char* w = (GAS unsigned char*)p.ws; asm volatile("" : "+s"(w)); p.ws = (unsigned char*)w; return p;
#else
    return Params{};
#endif
}
DI bf16_t* wsb(const Params& p, size_t off) { return (bf16_t*)(p.ws + off); }
DI float*  wsf(const Params& p, size_t off) { return (float*)(p.ws + off); }

DI int next_unit(const Ctx& c, int layer, int q) {
    volatile LAS int* slot = (volatile LAS int*)(c.lds + LDS_MISC);
    __syncthreads();
    int qi = (layer * NQUEUE + q) * 64; asm volatile("" : "+s"(qi));
    if (c.tid == 0) *slot = (int)__hip_atomic_fetch_add((unsigned*)(c.ctl + CW_QUEUE + qi), 1u, __ATOMIC_RELAXED, __HIP_MEMORY_SCOPE_AGENT);
    __syncthreads();
    return *slot;
}

DI int in_dest_row(int n) {
    int r = n;
    r = (n >= 3584) ? C_FF + (n - 3584) : r;
    r = (n >= 3588) ? n - 4 : r;
    r = (n >= 4420) ? C_IW + (n - 4420) : r;
    r = (n >= 4436) ? n - 20 : r;
    r = (n >= 6996) ? n - 4 : r;
    const int g = n - 7012, i = g >> 11, ch = g & 2047, tp = ch >> 6, cl = ch & 63;
    r = (n >= 7012) ? NMIX + 256 * tp + 128 * (i >> 1) + 32 * (cl >> 4) + 8 * ((cl >> 2) & 3) + 4 * (i & 1) + (cl & 3) : r;
    return r;
}
struct CvItem { const float* W; bf16_t* WT; const float* kscale; int N, ldk, row_off, r, map; };
DI void cv_load(const CvItem& I, int lane, f32x4 (&v)[16], f32x4& s0, f32x4& s1, const float* ones) {
    const int nblk = (I.N + 63) / 64, kb = I.r / nblk, nb = I.r % nblk, k0 = 64 * kb, n0 = 64 * nb;
    const int nq0 = n0 + 4 * (lane & 15), nq = nq0 < I.N ? nq0 : I.N - 4;
    const unsigned loff = (unsigned)((lane >> 4) * I.N + nq) * 4u;
    const float* ks = I.kscale ? I.kscale + k0 + 8 * (lane & 7) : ones;
    s0 = *(const f32x4*)ks; s1 = *(const f32x4*)(ks + 4);
#pragma unroll
    for (int i = 0; i < 16; ++i) { const char* rb = (const char*)(I.W + (size_t)(k0 + 4 * i) * I.N); v[i] = *(const f32x4*)(rb + loff); }
}
DI void cv_finish(const CvItem& I, int lane, const f32x4 (&v)[16], const f32x4 s0, const f32x4 s1, ldsp scrb) {
    const int nblk = (I.N + 63) / 64, kb = I.r / nblk, nb = I.r % nblk, k0 = 64 * kb, n0 = 64 * nb;
    const int c = lane & 7, kr = lane >> 4, n4 = lane & 15;
#pragma unroll
    for (int x = 0; x < 8; ++x) { ldsp wa = scrb + kr * 256 + 16 * (n4 ^ x);
        *(LAS f32x4*)(wa + (8 * x) * 256) = v[2 * x]; *(LAS f32x4*)(wa + (8 * x + 4) * 256) = v[2 * x + 1]; }
    asm volatile("s_waitcnt lgkmcnt(0)" ::: "memory");
#pragma unroll
    for (int j = 0; j < 8; ++j) { const int n = (lane >> 3) + 8 * j; ldsp ra = scrb + (8 * c) * 256 + 16 * ((n >> 2) ^ c) + 4 * (n & 3);
        float t[8];
#pragma unroll
        for (int e = 0; e < 8; ++e) t[e] = *(const LAS float*)(ra + e * 256);
        u32x4 o; o.x = pk2(t[0] * s0[0], t[1] * s0[1]); o.y = pk2(t[2] * s0[2], t[3] * s0[3]); o.z = pk2(t[4] * s1[0], t[5] * s1[1]); o.w = pk2(t[6] * s1[2], t[7] * s1[3]);
        if (n0 + n < I.N) { const int dr = I.map ? in_dest_row(n0 + n) : I.row_off + n0 + n; *(u32x4*)(I.WT + (size_t)dr * I.ldk + k0 + 8 * c) = o; } }
    asm volatile("s_waitcnt lgkmcnt(0)" ::: "memory");
}
constexpr int I_IN = (DM / 64) * ((IN_TOTAL + 63) / 64), I_UQ = (KUP / 64) * (512 / 64), I_QI = (KUP / 64) * (1024 / 64), I_BR = (KBR / 64) * (DM / 64),
              I_OUT = (DM / 64) * (DM / 64), I_F1 = (DM / 64) * (DFF / 64), I_F2 = (DFF / 64) * (DM / 64), PER_LAYER = I_IN + I_UQ + I_QI + I_BR + I_OUT + I_F1 + I_F2;
DI CvItem cv_decode(const Params& p, unsigned char* wl, int l, int it) {
    int r = it;
    if (r < I_IN) return CvItem{p.w_in + (size_t)l * DM * IN_TOTAL, (bf16_t*)(wl + WL_IN), p.norm1_g + l * DM, IN_TOTAL, DM, 0, r, 1}; r -= I_IN;
    if (r < I_UQ) return CvItem{p.dsa_w_uq + (size_t)l * KUP * 512, (bf16_t*)(wl + WL_UP), p.dsa_cq_g + l * KUP, 512, KUP, 0, r, 0}; r -= I_UQ;
    if (r < I_QI) return CvItem{p.dsa_w_qidx + (size_t)l * KUP * 1024, (bf16_t*)(wl + WL_UP), p.dsa_cq_g + l * KUP, 1024, KUP, 512, r, 0}; r -= I_QI;
    if (r < I_BR) return CvItem{p.w_br + (size_t)l * KBR * DM, (bf16_t*)(wl + WL_BR), nullptr, DM, KBR, 0, r, 0}; r -= I_BR;
    if (r < I_OUT) return CvItem{p.w_out + (size_t)l * DM * DM, (bf16_t*)(wl + WL_OUT), nullptr, DM, DM, 0, r, 0}; r -= I_OUT;
    if (r < I_F1) return CvItem{p.w_ff1 + (size_t)l * DM * DFF, (bf16_t*)(wl + WL_FF1), p.norm2_g + l * DM, DFF, DM, 0, r, 0}; r -= I_F1;
    return CvItem{p.w_ff2 + (size_t)l * DFF * DM, (bf16_t*)(wl + WL_FF2), nullptr, DM, DFF, 0, r, 0};
}
DI void convert_items(const Params& p0, const Ctx& c0, int l, int lo, int hi, int wv, int nw) {
    const Ctx c = fresh(c0); const Params p = freshp(p0);
    ldsp scr = c.lds + c.wave * 16384;
    unsigned char* wl = p.ws + WS_W + (size_t)l * WL_SIZE;
    const float* ones = wsf(p, WS_ONES);
#pragma unroll 1
    for (int it = lo + wv; it < hi; it += 2 * nw) {
        const bool hb = it + nw < hi;
        f32x4 va[16], vb[16], sa0, sa1, sb0, sb1;
        const CvItem A = cv_decode(p, wl, l, it), B = cv_decode(p, wl, l, hb ? it + nw : it);
        cv_load(A, c.lane, va, sa0, sa1, ones);
        cv_load(B, c.lane, vb, sb0, sb1, ones);
        cv_finish(A, c.lane, va, sa0, sa1, scr);
        if (hb) cv_finish(B, c.lane, vb, sb0, sb1, scr);
    }
}
constexpr int CV_B = 3072;
DI void convert_on_idle(const Params& p, const Ctx& c, int l, int lo, int hi, int nunits) {
    const int first_idle = nunits % c.G;
    if (first_idle == 0) convert_items(p, c, l, lo, hi, c.bid * 8 + c.wave, c.G * 8);
    else if (c.bid >= first_idle) convert_items(p, c, l, lo, hi, (c.bid - first_idle) * 8 + c.wave, (c.G - first_idle) * 8);
}
DI void p0_prologue(const Params& p0, const Ctx& c0) {
    const Ctx c = fresh(c0); const Params p = freshp(p0);
    convert_items(p, c, 0, 0, I_IN, c.bid * 8 + c.wave, c.G * 8);
    if (c.bid == 0 && c.tid < 8) wsf(p, WS_ONES)[c.tid] = 1.f;
    if (c.bid == 0 && c.tid < 256) *(u32x4*)(wsb(p, WS_ONESB) + 8 * c.tid) = (u32x4){0x3f803f80u, 0x3f803f80u, 0x3f803f80u, 0x3f803f80u};
    constexpr int PADROWS = NMIX - C_MIXEND, CH = DM / 8;
    for (int i = (c.bid * 512 + c.tid); i < DEPTH * PADROWS * CH; i += c.G * 512) { const int l = i / (PADROWS * CH), r = (i / CH) % PADROWS, ch = i % CH;
        *(u32x4*)((bf16_t*)(p.ws + WS_W + (size_t)l * WL_SIZE + WL_IN) + (size_t)(C_MIXEND + r) * DM + ch * 8) = (u32x4){0u, 0u, 0u, 0u}; }
}

DI float wave_sum(float v, int lane) {
#pragma unroll
    for (int o = 1; o < 64; o <<= 1) v += shx(v, o, lane);
    return v;
}
DI void xprep_phase(const Ctx& c0, const float* x, bf16_t* xb, float* ssp) {
    const Ctx c = fresh(c0);
    const int gw = c.bid * 8 + c.wave, NGW = c.G * 8;
    for (int m = gw; m < MTOK; m += NGW) {
        const f32x4* xr = (const f32x4*)(x + (size_t)m * DM) + c.lane;
        f32x4 v[8]; float s = 0.f;
#pragma unroll
        for (int j = 0; j < 8; ++j) { v[j] = xr[64 * j]; s += (v[j][0] * v[j][0] + v[j][1] * v[j][1]) + (v[j][2] * v[j][2] + v[j][3] * v[j][3]); }
        s = wave_sum(s, c.lane);
        u32x2* o = (u32x2*)(xb + (size_t)m * DM) + c.lane;
#pragma unroll
        for (int j = 0; j < 8; ++j) { u32x2 w; w.x = pk2(v[j][0], v[j][1]); w.y = pk2(v[j][2], v[j][3]); o[64 * j] = w; }
        if (c.lane < 8) ssp[(size_t)m * 8 + c.lane] = (c.lane == 0) ? s : 0.f;
    }
}

DI void scan_phase(const Params& p0, const Ctx& c0) {
    const Ctx c = fresh(c0); const Params p = freshp(p0);
    const float* kvs = wsf(p, WS_KVS); bf16_t* prevr = wsb(p, WS_PREVR); const float* st = wsf(p, WS_ST); bf16_t* prevs = wsb(p, WS_PREVS); const float* acs = wsf(p, WS_ACS);
    const int gt = c.bid * 512 + c.tid, NT = c.G * 512;
    for (int e = gt; e < 16 * 4096; e += NT) {
        const int bh = e / 4096, q = e % 4096, h = bh & 3;
        const float cd = __expf(128.f * log1pf(-exp2f(-5.f - (float)h)));
        f32x4 kv[16];
#pragma unroll
        for (int n = 0; n < 16; ++n) kv[n] = *(const f32x4*)(kvs + ((size_t)(bh * 16 + n) * 16384) + (size_t)q * 4);
        f32x4 s = {0.f, 0.f, 0.f, 0.f};
#pragma unroll
        for (int n = 0; n < 16; ++n) { const size_t o = ((size_t)(bh * 16 + n) * 16384) + (size_t)q * 4;
            u32x2 w; w.x = pk2(s[0], s[1]); w.y = pk2(s[2], s[3]); *(u32x2*)(prevr + o) = w; s = s * cd + kv[n]; }
    }
    for (int e = gt; e < 64 * 2048; e += NT) {
        const int bhd = e / 2048, q = e % 2048, b = bhd >> 4, hd = bhd & 15;
        f32x4 v[16]; float cd[16];
#pragma unroll
        for (int n = 0; n < 16; ++n) { v[n] = *(const f32x4*)(st + ((size_t)((b * 16 + n) * 16 + hd) * 8192) + (size_t)q * 4); cd[n] = acs[(size_t)(b * SEQ + 128 * n + 127) * 16 + hd]; }
        f32x4 s = {0.f, 0.f, 0.f, 0.f};
#pragma unroll
        for (int n = 0; n < 16; ++n) { const size_t o = ((size_t)((b * 16 + n) * 16 + hd) * 8192) + (size_t)q * 4;
            u32x2 w; w.x = pk2(s[0], s[1]); w.y = pk2(s[2], s[3]); *(u32x2*)(prevs + o) = w; s = s * __expf(cd[n]) + v[n]; }
    }
}

struct LaneIds { int r, h, blk, q, pp; };
DI LaneIds lane_ids(int lane) { LaneIds L; L.r = lane & 31; L.h = lane >> 5; L.blk = (lane >> 4) & 1; L.q = (lane & 15) >> 2; L.pp = lane & 3; return L; }
DI int tr_nat_off(const LaneIds& L, int st) { return (8 * L.h + L.q) * st + 32 * L.blk + 8 * L.pp; }
DI int tr_krow_off(const LaneIds& L, int st) { return (4 * L.h + L.q) * st + 32 * L.blk + 8 * L.pp; }
DI bf16x8 pack_half(const f32x16& x, int s) { return pack8(x[8 * s], x[8 * s + 1], x[8 * s + 2], x[8 * s + 3], x[8 * s + 4], x[8 * s + 5], x[8 * s + 6], x[8 * s + 7]); }
DI float softplusf_(float x) { return x > 20.f ? x : log1pf(__expf(x)); }

DI void ssdst_unit(const Params& p0, const Ctx& c0, int layer, int u) {
    const Ctx c = fresh(c0); const Params p = freshp(p0);
    const int b = u >> 6, n = (u >> 2) & 15, g = (u >> 1) & 1, half = u & 1, T0 = b * SEQ + 128 * n;
    const bf16_t* mix = wsb(p, WS_MIX); bf16_t* xbcc = wsb(p, WS_XBCC); float* acsg = wsf(p, WS_ACS); float* bsg = wsf(p, WS_BS); float* stg = wsf(p, WS_ST);
    ldsp Xt = c.lds, Bt = c.lds + 73728; LAS float* sdec = (LAS float*)(c.lds + 73728 + 40960);
    const LaneIds L = lane_ids(c.lane);
    if (c.wave < 4) {
        const int hd = g * 8 + half * 4 + c.wave; const float dtb = p.ssd_dt_bias[layer * 16 + hd], A = -__expf(p.ssd_a_log[layer * 16 + hd]);
        const int l0 = 2 * c.lane;
        const float dt0 = softplusf_(bf2f(mix[(size_t)(T0 + l0) * NMIX + C_SDT + hd]) + dtb), dt1 = softplusf_(bf2f(mix[(size_t)(T0 + l0 + 1) * NMIX + C_SDT + hd]) + dtb);
        const float a0 = dt0 * A, a1 = dt1 * A; float s = a0 + a1;
#pragma unroll
        for (int o = 1; o < 64; o <<= 1) { const float t = shidx(s, c.lane - o); if (c.lane >= o) s += t; }
        const float c1 = s, c0 = s - a1, last = shidx(s, 63);
        acsg[(size_t)(T0 + l0) * 16 + hd] = c0; acsg[(size_t)(T0 + l0 + 1) * 16 + hd] = c1;
        bsg[(size_t)(T0 + l0) * 16 + hd] = -c0 + __logf(dt0); bsg[(size_t)(T0 + l0 + 1) * 16 + hd] = -c1 + __logf(dt1);
        sdec[c.wave * 128 + l0] = dt0 * __expf(last - c0); sdec[c.wave * 128 + l0 + 1] = dt1 * __expf(last - c1);
    }
    __syncthreads();
    const int NCH = half ? 64 : 48;
    const float* cw = p.ssd_conv_w + (size_t)layer * 4 * 1536; const float* cb = p.ssd_conv_b + (size_t)layer * 1536;
    {
        const int cc = c.lane, l0 = 16 * c.wave;
        if (cc < NCH) {
            int ch; if (cc < 32) ch = g * 512 + half * 256 + 8 * cc; else if (cc < 48) ch = 1024 + g * 128 + 8 * (cc - 32); else ch = 1280 + g * 128 + 8 * (cc - 48);
            const int mcol = C_SX + ch;
            u32x4 xr[19];
#pragma unroll
            for (int i = 0; i < 19; ++i) { const int tl = 128 * n + l0 - 3 + i; xr[i] = (tl >= 0) ? *(const u32x4*)(mix + (size_t)(b * SEQ + tl) * NMIX + mcol) : (u32x4){0u, 0u, 0u, 0u}; }
            float w[4][8], bs8[8];
#pragma unroll
            for (int j = 0; j < 4; ++j) { const f32x4 w0 = *(const f32x4*)(cw + j * 1536 + ch), w1 = *(const f32x4*)(cw + j * 1536 + ch + 4);
                w[j][0] = w0[0]; w[j][1] = w0[1]; w[j][2] = w0[2]; w[j][3] = w0[3]; w[j][4] = w1[0]; w[j][5] = w1[1]; w[j][6] = w1[2]; w[j][7] = w1[3]; }
            { const f32x4 b0 = *(const f32x4*)(cb + ch), b1 = *(const f32x4*)(cb + ch + 4); bs8[0] = b0[0]; bs8[1] = b0[1]; bs8[2] = b0[2]; bs8[3] = b0[3]; bs8[4] = b1[0]; bs8[5] = b1[1]; bs8[6] = b1[2]; bs8[7] = b1[3]; }
#pragma unroll
            for (int i = 0; i < 16; ++i) { const int l = l0 + i; float a[8];
#pragma unroll
                for (int e = 0; e < 8; ++e) a[e] = bs8[e];
#pragma unroll
                for (int j = 0; j < 4; ++j) { float xv[8]; unpack8(xr[i + j], xv);
#pragma unroll
                    for (int e = 0; e < 8; ++e) a[e] += w[j][e] * xv[e]; }
#pragma unroll
                for (int e = 0; e < 8; ++e) a[e] = siluf_(a[e]);
                const bf16x8 v = pack8(a[0], a[1], a[2], a[3], a[4], a[5], a[6], a[7]);
                if (cc < 32) { *(bf16x8*)(xbcc + (size_t)(T0 + l) * 1536 + ch) = v; const float sc = sdec[(cc >> 3) * 128 + l];
                    *(LAS bf16x8*)(Xt + l * 576 + cc * 16) = pack8(a[0] * sc, a[1] * sc, a[2] * sc, a[3] * sc, a[4] * sc, a[5] * sc, a[6] * sc, a[7] * sc); }
                else if (cc < 48) { if (half == 0) *(bf16x8*)(xbcc + (size_t)(T0 + l) * 1536 + ch) = v; *(LAS bf16x8*)(Bt + l * 320 + (cc - 32) * 16) = v; }
                else *(bf16x8*)(xbcc + (size_t)(T0 + l) * 1536 + ch) = v;
            }
        }
    }
    __syncthreads();
    {
        const int hq = c.wave & 3, kh = c.wave >> 2, hd = g * 8 + half * 4 + hq;
        f32x16 acc[2][2]; for (int i = 0; i < 2; ++i) for (int j = 0; j < 2; ++j) acc[i][j] = zero16();
        ldsp xa = Xt + tr_nat_off(L, 576) + hq * 128, ba = Bt + tr_nat_off(L, 320) + kh * 128;
#pragma unroll
        for (int ks = 0; ks < 8; ++ks) {
            bf16x8 A[2], Bf[2];
#pragma unroll
            for (int t = 0; t < 2; ++t) { A[t] = tr_pair(xa + ks * 16 * 576 + t * 64, 4 * 576); Bf[t] = tr_pair(ba + ks * 16 * 320 + t * 64, 4 * 320); }
#pragma unroll
            for (int pt = 0; pt < 2; ++pt)
#pragma unroll
                for (int kt = 0; kt < 2; ++kt) acc[pt][kt] = MFMA32(A[pt], Bf[kt], acc[pt][kt]);
        }
        float* o = stg + (size_t)((b * 16 + n) * 16 + hd) * 8192;
#pragma unroll
        for (int pt = 0; pt < 2; ++pt)
#pragma unroll
            for (int kt = 0; kt < 2; ++kt)
#pragma unroll
                for (int i = 0; i < 16; ++i) o[(32 * pt + crow(i, L.h)) * 128 + kh * 64 + 32 * kt + L.r] = acc[pt][kt][i];
    }
}
DI void ssdo_unit(const Params& p0, const Ctx& c0, int layer, int u) {
    const Ctx c = fresh(c0); const Params p = freshp(p0);
    const int b = u >> 6, n = (u >> 2) & 15, g = (u >> 1) & 1, half = u & 1, T0 = b * SEQ + 128 * n;
    const bf16_t* mix = wsb(p, WS_MIX); const bf16_t* xbcc = wsb(p, WS_XBCC); const float* acsg = wsf(p, WS_ACS); const float* bsg = wsf(p, WS_BS);
    const bf16_t* prevs = wsb(p, WS_PREVS); bf16_t* oall = wsb(p, WS_OALL); float* ssqh = wsf(p, WS_SSQH);
    ldsp XS = c.lds, BC = c.lds + 73728; LAS float* tacs = (LAS float*)(c.lds + 73728 + 34816); LAS float* tbs = tacs + 512;
    const LaneIds L = lane_ids(c.lane);
    const int hq = c.wave & 3, pr = c.wave >> 2, hd = g * 8 + half * 4 + hq;
    const bf16_t* prv = prevs + (size_t)((b * 16 + n) * 16 + hd) * 8192;
    u32x4 xs8[8], bc4[4];
#pragma unroll
    for (int i = 0; i < 8; ++i) { const int it = c.tid + 512 * i, l = it >> 5, cc = it & 31; xs8[i] = *(const u32x4*)(xbcc + (size_t)(T0 + l) * 1536 + g * 512 + half * 256 + 8 * cc); }
#pragma unroll
    for (int i = 0; i < 4; ++i) { const int it = c.tid + 512 * i, l = it >> 4, cc = it & 15; bc4[i] = *(const u32x4*)(xbcc + (size_t)(T0 + l) * 1536 + 1024 + g * 128 + 8 * cc); }
    const float ta = acsg[(size_t)(T0 + (c.tid & 127)) * 16 + g * 8 + half * 4 + (c.tid >> 7)], tb = bsg[(size_t)(T0 + (c.tid & 127)) * 16 + g * 8 + half * 4 + (c.tid >> 7)];
    bf16x8 Ap[2][8];
#pragma unroll
    for (int pt = 0; pt < 2; ++pt)
#pragma unroll
        for (int ks = 0; ks < 8; ++ks) Ap[pt][ks] = *(const bf16x8*)(prv + (32 * pt + L.r) * 128 + 16 * ks + 8 * L.h);
#pragma unroll
    for (int i = 0; i < 8; ++i) { const int it = c.tid + 512 * i, l = it >> 5, cc = it & 31; *(LAS u32x4*)(XS + l * 576 + cc * 16) = xs8[i]; }
#pragma unroll
    for (int i = 0; i < 4; ++i) { const int it = c.tid + 512 * i, l = it >> 4, cc = it & 15; *(LAS u32x4*)(BC + l * 272 + cc * 16) = bc4[i]; }
    tacs[c.tid] = ta; tbs[c.tid] = tb;
    __syncthreads();
    const float Dsk = p.ssd_d[layer * 16 + hd];
    const float* ng = p.ssd_norm_g + (size_t)layer * 1024 + g * 512 + half * 256 + hq * 64;
#pragma unroll
    for (int li = 0; li < 2; ++li) {
        const int lt = pr == 0 ? (li == 0 ? 0 : 3) : (li == 0 ? 1 : 2);
        const int l = 32 * lt + L.r; const size_t tok = (size_t)(T0 + l);
        bf16x8 Cf[8];
#pragma unroll
        for (int ks = 0; ks < 8; ++ks) Cf[ks] = *(const bf16x8*)(xbcc + tok * 1536 + 1280 + g * 128 + 16 * ks + 8 * L.h);
        u32x2 zw8[2][4];
#pragma unroll
        for (int pt = 0; pt < 2; ++pt)
#pragma unroll
            for (int gq = 0; gq < 4; ++gq) zw8[pt][gq] = *(const u32x2*)(mix + tok * NMIX + C_SZ + g * 512 + half * 256 + hq * 64 + 32 * pt + 8 * gq + 4 * L.h);
        f32x16 O[2]; O[0] = zero16(); O[1] = zero16();
#pragma unroll
        for (int pt = 0; pt < 2; ++pt)
#pragma unroll
            for (int ks = 0; ks < 8; ++ks) { O[pt] = MFMA32(Ap[pt][ks], Cf[ks], O[pt]); }

        const float acl = tacs[hq * 128 + l], eA = __expf(acl);
#pragma unroll
        for (int pt = 0; pt < 2; ++pt)
#pragma unroll
            for (int i = 0; i < 16; ++i) O[pt][i] *= eA;
#pragma unroll 1
        for (int st = 0; st <= lt; ++st) {
            f32x16 mt = zero16();
#pragma unroll
            for (int ks = 0; ks < 8; ++ks) { const bf16x8 A = *(const LAS bf16x8*)(BC + (32 * st + L.r) * 272 + (16 * ks + 8 * L.h) * 2); mt = MFMA32(A, Cf[ks], mt); }
#pragma unroll
            for (int gq = 0; gq < 4; ++gq) { const f32x4 bv = *(const LAS f32x4*)(tbs + hq * 128 + 32 * st + 8 * gq + 4 * L.h);
#pragma unroll
                for (int e = 0; e < 4; ++e) { const int s = 32 * st + 8 * gq + 4 * L.h + e; const float w = __expf(acl + bv[e]); mt[4 * gq + e] = (l >= s) ? mt[4 * gq + e] * w : 0.f; } }
            const bf16x8 pk0 = pack_half(mt, 0), pk1 = pack_half(mt, 1);
            ldsp xa = XS + tr_krow_off(L, 576) + (32 * st) * 576 + hq * 128;
#pragma unroll
            for (int pt = 0; pt < 2; ++pt) { O[pt] = MFMA32(tr_pair(xa + pt * 64, 8 * 576), pk0, O[pt]); O[pt] = MFMA32(tr_pair(xa + 16 * 576 + pt * 64, 8 * 576), pk1, O[pt]); }
        }
        float ssq = 0.f;
#pragma unroll
        for (int pt = 0; pt < 2; ++pt) { u32x2 w4[4];
#pragma unroll
            for (int gq = 0; gq < 4; ++gq) { const int pch = 32 * pt + 8 * gq + 4 * L.h;
                const u32x2 xw = *(const LAS u32x2*)(XS + l * 576 + (hq * 64 + pch) * 2);
                const u32x2 zw = zw8[pt][gq];
                const f32x4 gn = *(const f32x4*)(ng + pch);
                const float xv[4] = {bflo(xw.x), bfhi(xw.x), bflo(xw.y), bfhi(xw.y)}, zv[4] = {bflo(zw.x), bfhi(zw.x), bflo(zw.y), bfhi(zw.y)};
                float o[4];
#pragma unroll
                for (int e = 0; e < 4; ++e) { const float y = O[pt][4 * gq + e] + Dsk * xv[e]; const float gt = y * siluf_(zv[e]); ssq += gt * gt; o[e] = gt * gn[e]; }
                w4[gq].x = pk2(o[0], o[1]); w4[gq].y = pk2(o[2], o[3]); }
            bf16_t* rowp = oall + tok * KBR + O_SSD + g * 512 + half * 256 + hq * 64 + 32 * pt;
            store_pair_t21(rowp, 0, w4[0], w4[1], L.h); store_pair_t21(rowp, 2, w4[2], w4[3], L.h); }
        ssq += shx(ssq, 32, c.lane);
        if (L.h == 0) ssqh[tok * 16 + hd] = ssq;
    }
}

DI float ret_loggamma(int h) { return log1pf(-exp2f(-5.f - (float)h)); }
struct RetKV { u32x4 ka[2], kb[2], v[4]; };
DI void ret_load_kv(RetKV& r, const Ctx& c, const bf16_t* mix, int T0, int h) {
#pragma unroll
    for (int i = 0; i < 2; ++i) { const int it = c.tid + 512 * i, j = it >> 3, cc = it & 7; const bf16_t* row = mix + (size_t)(T0 + j) * NMIX + C_RK + h * 128;
        r.ka[i] = *(const u32x4*)(row + 8 * cc); r.kb[i] = *(const u32x4*)(row + 64 + 8 * cc); }
#pragma unroll
    for (int i = 0; i < 4; ++i) { const int it = c.tid + 512 * i, j = it >> 4, cc = it & 15; r.v[i] = *(const u32x4*)(mix + (size_t)(T0 + j) * NMIX + C_RV + h * 128 + 8 * cc); }
}
DI void ret_write_kv(const RetKV& r, const Ctx& c, int n, int h, ldsp Kt, int st, bool with_decay, ldsp Vt) {
    const float lg = ret_loggamma(h);
#pragma unroll
    for (int i = 0; i < 2; ++i) {
        const int it = c.tid + 512 * i, j = it >> 3, cc = it & 7; float x1[8], x2[8]; unpack8(r.ka[i], x1); unpack8(r.kb[i], x2);
        const float sc = 0.08838834764831845f * (with_decay ? __expf(lg * (float)(127 - j)) : 1.f), pos = (float)(128 * n + j);
        float o1[8], o2[8];
#pragma unroll
        for (int e = 0; e < 8; ++e) { const float inv = __builtin_amdgcn_exp2f(-(float)(8 * cc + e) * 0.20762050593046014f); const float ang = __fmul_rn(pos, inv); float rev = ang * 0.15915494309189535f; rev = __builtin_amdgcn_fractf(rev);
            const float sn = __builtin_amdgcn_sinf(rev), cs = __builtin_amdgcn_cosf(rev); o1[e] = (x1[e] * cs - x2[e] * sn) * sc; o2[e] = (x1[e] * sn + x2[e] * cs) * sc; }
        *(LAS bf16x8*)(Kt + j * st + cc * 16) = pack8(o1[0], o1[1], o1[2], o1[3], o1[4], o1[5], o1[6], o1[7]);
        *(LAS bf16x8*)(Kt + j * st + 128 + cc * 16) = pack8(o2[0], o2[1], o2[2], o2[3], o2[4], o2[5], o2[6], o2[7]);
    }
#pragma unroll
    for (int i = 0; i < 4; ++i) { const int it = c.tid + 512 * i, j = it >> 4, cc = it & 15; *(LAS u32x4*)(Vt + j * 320 + cc * 16) = r.v[i]; }
}
DI void retkv_unit(const Params& p0, const Ctx& c0, int u) {
    const Ctx c = fresh(c0); const Params p = freshp(p0);
    const int b = u >> 6, h = (u >> 4) & 3, n = u & 15, T0 = b * SEQ + 128 * n;
    const bf16_t* mix = wsb(p, WS_MIX); float* kvs = wsf(p, WS_KVS) + (size_t)u * 16384;
    ldsp Kt = c.lds, Vt = c.lds + 40960; const LaneIds L = lane_ids(c.lane);
    { RetKV r; ret_load_kv(r, c, mix, T0, h); ret_write_kv(r, c, n, h, Kt, 320, true, Vt); }
    __syncthreads();
    const int rt = c.wave >> 1, chh = c.wave & 1;
    f32x16 acc[2]; acc[0] = zero16(); acc[1] = zero16();
    ldsp va = Vt + tr_nat_off(L, 320) + rt * 64, ka = Kt + tr_nat_off(L, 320) + chh * 128;
#pragma unroll
    for (int ks = 0; ks < 8; ++ks) { const bf16x8 A = tr_pair(va + ks * 16 * 320, 4 * 320);
#pragma unroll
        for (int t = 0; t < 2; ++t) acc[t] = MFMA32(A, tr_pair(ka + ks * 16 * 320 + t * 64, 4 * 320), acc[t]); }
#pragma unroll
    for (int t = 0; t < 2; ++t)
#pragma unroll
        for (int i = 0; i < 16; ++i) kvs[(32 * rt + crow(i, L.h)) * 128 + chh * 64 + 32 * t + L.r] = acc[t][i];
}
DI void reto_unit(const Params& p0, const Ctx& c0, int u) {
    const Ctx c = fresh(c0); const Params p = freshp(p0);
    const int b = u >> 6, h = (u >> 4) & 3, n = u & 15, T0 = b * SEQ + 128 * n;
    const bf16_t* mix = wsb(p, WS_MIX); const bf16_t* prv = wsb(p, WS_PREVR) + (size_t)u * 16384; bf16_t* oall = wsb(p, WS_OALL);
    ldsp Kt = c.lds, Vt = c.lds + 34816; LAS float* exch = (LAS float*)(c.lds + 34816 + 40960); const LaneIds L = lane_ids(c.lane);
    const int qg = c.wave & 3, dvh = c.wave >> 2, il = 32 * qg + L.r; const size_t tok = (size_t)(T0 + il);
    const float lg = ret_loggamma(h);
    RetKV rkv; ret_load_kv(rkv, c, mix, T0, h);
    u32x4 qraw[8]; { const bf16_t* row = mix + tok * NMIX + C_RQ + h * 128;
#pragma unroll
      for (int s = 0; s < 4; ++s) { qraw[s] = *(const u32x4*)(row + 16 * s + 8 * L.h); qraw[s + 4] = *(const u32x4*)(row + 64 + 16 * s + 8 * L.h); } }
    bf16x8 Ap[2][8];
#pragma unroll
    for (int dl = 0; dl < 2; ++dl)
#pragma unroll
        for (int s = 0; s < 8; ++s) Ap[dl][s] = *(const bf16x8*)(prv + (32 * (2 * dvh + dl) + L.r) * 128 + 16 * s + 8 * L.h);
    u32x2 gwv[2][4];
#pragma unroll
    for (int dl = 0; dl < 2; ++dl)
#pragma unroll
        for (int gq = 0; gq < 4; ++gq) gwv[dl][gq] = *(const u32x2*)(mix + tok * NMIX + C_RG + h * 128 + 32 * (2 * dvh + dl) + 8 * gq + 4 * L.h);
    ret_write_kv(rkv, c, n, h, Kt, 272, false, Vt);
    bf16x8 Qf[8];
    { const float pos = (float)(128 * n + il);
#pragma unroll
      for (int s = 0; s < 4; ++s) { float x1[8], x2[8], o1[8], o2[8]; unpack8(qraw[s], x1); unpack8(qraw[s + 4], x2);
#pragma unroll
          for (int e = 0; e < 8; ++e) { const float inv = __builtin_amdgcn_exp2f(-(float)(16 * s + 8 * L.h + e) * 0.20762050593046014f); const float ang = __fmul_rn(pos, inv); float rev = ang * 0.15915494309189535f; rev = __builtin_amdgcn_fractf(rev);
              const float sn = __builtin_amdgcn_sinf(rev), cs = __builtin_amdgcn_cosf(rev); o1[e] = x1[e] * cs - x2[e] * sn; o2[e] = x1[e] * sn + x2[e] * cs; }
          Qf[s] = pack8(o1[0], o1[1], o1[2], o1[3], o1[4], o1[5], o1[6], o1[7]); Qf[s + 4] = pack8(o2[0], o2[1], o2[2], o2[3], o2[4], o2[5], o2[6], o2[7]); } }
    f32x16 O[2]; O[0] = zero16(); O[1] = zero16();
#pragma unroll
    for (int dl = 0; dl < 2; ++dl)
#pragma unroll
        for (int s = 0; s < 8; ++s) { O[dl] = MFMA32(Ap[dl][s], Qf[s], O[dl]); }

    { const float qd = __expf(lg * (float)(il + 1));
#pragma unroll
      for (int dl = 0; dl < 2; ++dl)
#pragma unroll
          for (int i = 0; i < 16; ++i) O[dl][i] *= qd; }
    __syncthreads();
#pragma unroll 1
    for (int rt = 0; rt <= qg; ++rt) {
        f32x16 st = zero16();
#pragma unroll
        for (int s = 0; s < 8; ++s) { const bf16x8 A = *(const LAS bf16x8*)(Kt + (32 * rt + L.r) * 272 + (16 * s + 8 * L.h) * 2); st = MFMA32(A, Qf[s], st); }
#pragma unroll
        for (int i = 0; i < 16; ++i) { const int j = 32 * rt + crow(i, L.h); st[i] = (il >= j) ? st[i] * __expf(lg * (float)(il - j)) : 0.f; }
        const bf16x8 pk0 = pack_half(st, 0), pk1 = pack_half(st, 1);
        ldsp va = Vt + tr_krow_off(L, 320) + (32 * rt) * 320 + dvh * 128;
#pragma unroll
        for (int dl = 0; dl < 2; ++dl) { O[dl] = MFMA32(tr_pair(va + dl * 64, 8 * 320), pk0, O[dl]); O[dl] = MFMA32(tr_pair(va + 16 * 320 + dl * 64, 8 * 320), pk1, O[dl]); }
    }
    float s1 = 0.f, s2 = 0.f;
#pragma unroll
    for (int dl = 0; dl < 2; ++dl)
#pragma unroll
        for (int i = 0; i < 16; ++i) { s1 += O[dl][i]; s2 += O[dl][i] * O[dl][i]; }
    s1 += shx(s1, 32, c.lane); s2 += shx(s2, 32, c.lane);
    if (L.h == 0) { exch[(dvh * 128 + il) * 2] = s1; exch[(dvh * 128 + il) * 2 + 1] = s2; }
    __syncthreads();
    const float t1 = exch[il * 2] + exch[(128 + il) * 2], t2 = exch[il * 2 + 1] + exch[(128 + il) * 2 + 1];
    const float mean = t1 * (1.f / 128.f), var = fmaxf(t2 * (1.f / 128.f) - mean * mean, 0.f), rstd = __builtin_amdgcn_rsqf(var + EPS);
#pragma unroll
    for (int dl = 0; dl < 2; ++dl) { u32x2 w4[4];
#pragma unroll
        for (int gq = 0; gq < 4; ++gq) { const u32x2 gw = gwv[dl][gq]; const float gv[4] = {bflo(gw.x), bfhi(gw.x), bflo(gw.y), bfhi(gw.y)}; float o[4];
#pragma unroll
            for (int e = 0; e < 4; ++e) o[e] = siluf_(gv[e]) * (O[dl][4 * gq + e] - mean) * rstd;
            w4[gq].x = pk2(o[0], o[1]); w4[gq].y = pk2(o[2], o[3]); }
        bf16_t* rowp = oall + tok * KBR + O_RET + h * 128 + 32 * (2 * dvh + dl);
        store_pair_t21(rowp, 0, w4[0], w4[1], L.h); store_pair_t21(rowp, 2, w4[2], w4[3], L.h); }
}

constexpr int KT_PITCH = 272, VT_PITCH = 320, KT_BYTES = 64 * KT_PITCH, VT_BYTES = 64 * VT_PITCH;
struct KvStage { u32x4 k[2], v[2]; };
DI void kv_load(KvStage& s, const bf16_t* kbase, int kp, const bf16_t* vbase, int vp, int row0, int tid) {
    const int key = tid >> 3, cp = tid & 7; const size_t rk = (size_t)(row0 + key) * kp, rv = (size_t)(row0 + key) * vp;
    s.k[0] = *(const u32x4*)(kbase + rk + 8 * cp); s.k[1] = *(const u32x4*)(kbase + rk + 64 + 8 * cp);
    s.v[0] = *(const u32x4*)(vbase + rv + 8 * cp); s.v[1] = *(const u32x4*)(vbase + rv + 64 + 8 * cp);
}
DI void kv_write(const KvStage& s, ldsp Kt, ldsp Vt, int tid) {
    const int key = tid >> 3, cp = tid & 7;
    *(LAS u32x4*)(Kt + key * KT_PITCH + cp * 16) = s.k[0]; *(LAS u32x4*)(Kt + key * KT_PITCH + 128 + cp * 16) = s.k[1];
    *(LAS u32x4*)(Vt + key * VT_PITCH + cp * 16) = s.v[0]; *(LAS u32x4*)(Vt + key * VT_PITCH + 128 + cp * 16) = s.v[1];
}
struct AttnState { f32x16 O[4]; float m, l; };
DI void attn_qk(f32x16 (&st)[2], ldsp Kt, const bf16x8 (&Qf)[8], const LaneIds& L) {
    st[0] = zero16(); st[1] = zero16();
#pragma unroll
    for (int rt = 0; rt < 2; ++rt)
#pragma unroll
        for (int s = 0; s < 8; ++s) st[rt] = MFMA32(*(const LAS bf16x8*)(Kt + (32 * rt + L.r) * KT_PITCH + (16 * s + 8 * L.h) * 2), Qf[s], st[rt]);
}
template <bool MASKW>
DI void attn_softmax_pv(AttnState& A, f32x16 (&st)[2], ldsp Vt, const LaneIds& L, unsigned mw0 = 0u, unsigned mw1 = 0u) {
    float mx = st[0][0];
#pragma unroll
    for (int rt = 0; rt < 2; ++rt)
#pragma unroll
        for (int i = 0; i < 16; ++i) mx = fmaxf(mx, st[rt][i]);
    mx = fmaxf(mx, shx(mx, 32, L.r + 32 * L.h));
    const float mn = fmaxf(A.m, mx);
    float rs = 0.f;
#pragma unroll
    for (int rt = 0; rt < 2; ++rt)
#pragma unroll
        for (int i = 0; i < 16; ++i) { float pv = __builtin_amdgcn_exp2f(st[rt][i] - mn);
            if (MASKW) { const int cr_ = (i & 3) + 8 * (i >> 2); pv = __uint_as_float(__float_as_uint(pv) & (unsigned)__builtin_amdgcn_sbfe((int)(rt ? mw1 : mw0), cr_, 1)); }
            st[rt][i] = pv; rs += pv; }
    rs += shx(rs, 32, L.r + 32 * L.h);
    if (__builtin_amdgcn_ballot_w64(mn > A.m) != 0ull) {
        const float alpha = __builtin_amdgcn_exp2f(A.m - mn);
        A.l *= alpha; A.m = mn;
#pragma unroll
        for (int dt = 0; dt < 4; ++dt)
#pragma unroll
            for (int i = 0; i < 16; ++i) A.O[dt][i] *= alpha;
    }
    A.l += rs;
    ldsp va = Vt + tr_krow_off(L, VT_PITCH);
#pragma unroll
    for (int rt = 0; rt < 2; ++rt)
#pragma unroll
        for (int s2 = 0; s2 < 2; ++s2) { const bf16x8 pk = pack_half(st[rt], s2);
#pragma unroll
            for (int dt = 0; dt < 4; ++dt) A.O[dt] = MFMA32(tr_pair(va + (32 * rt + 16 * s2) * VT_PITCH + dt * 64, 8 * VT_PITCH), pk, A.O[dt]); }
}
DI void attn_store(const AttnState& A, bf16_t* orow, const LaneIds& L) {
    const float inv = 1.f / A.l;
#pragma unroll
    for (int dt = 0; dt < 4; ++dt)
#pragma unroll
        for (int gq = 0; gq < 4; gq += 2) { u32x2 a, b;
            a.x = pk2(A.O[dt][4 * gq] * inv, A.O[dt][4 * gq + 1] * inv); a.y = pk2(A.O[dt][4 * gq + 2] * inv, A.O[dt][4 * gq + 3] * inv);
            b.x = pk2(A.O[dt][4 * gq + 4] * inv, A.O[dt][4 * gq + 5] * inv); b.y = pk2(A.O[dt][4 * gq + 6] * inv, A.O[dt][4 * gq + 7] * inv);
            store_pair_t21(orow, 4 * dt + gq, a, b, L.h); }
}
DI void attn_load_q(bf16x8 (&Qf)[8], const bf16_t* qrow, const float* g, float pre, float scale, const LaneIds& L) {
    float x[8][8]; float ss = 0.f;
#pragma unroll
    for (int s = 0; s < 8; ++s) { unpack8(*(const u32x4*)(qrow + 16 * s + 8 * L.h), x[s]);
#pragma unroll
        for (int e = 0; e < 8; ++e) { x[s][e] *= pre; ss += x[s][e] * x[s][e]; } }
    ss += shx(ss, 32, L.r + 32 * L.h);
    const float f = scale * __builtin_amdgcn_rsqf(ss * (1.f / 128.f) + EPS);
#pragma unroll
    for (int s = 0; s < 8; ++s) { const f32x4 g0 = *(const f32x4*)(g + 16 * s + 8 * L.h), g1 = *(const f32x4*)(g + 16 * s + 8 * L.h + 4);
        Qf[s] = pack8(x[s][0] * f * g0[0], x[s][1] * f * g0[1], x[s][2] * f * g0[2], x[s][3] * f * g0[3], x[s][4] * f * g1[0], x[s][5] * f * g1[1], x[s][6] * f * g1[2], x[s][7] * f * g1[3]); }
}

DI void fox_unit(const Params& p0, const Ctx& c0, int layer, int u) {
    const Ctx c = fresh(c0); const Params p = freshp(p0);
    const int qb = 7 - (u >> 4), bh = u & 15, b = bh >> 2, hd = bh & 3, t0 = 256 * qb;
    const bf16_t* mix = wsb(p, WS_MIX); bf16_t* oall = wsb(p, WS_OALL);
    LAS float* Fs = (LAS float*)c.lds; LAS float* wtot = Fs + 2048; ldsp KV = c.lds + 8192 + 64;
    const LaneIds L = lane_ids(c.lane);
    {
        const float fb = p.fox_f_b[layer * 4 + hd]; float v[4];
#pragma unroll
        for (int e = 0; e < 4; ++e) { const float x = bf2f(mix[(size_t)(b * SEQ + 4 * c.tid + e) * NMIX + C_FF + hd]) + fb; v[e] = (fminf(x, 0.f) - log1pf(__expf(-fabsf(x)))) * LOG2E; }
        v[1] += v[0]; v[2] += v[1]; v[3] += v[2];
        float s = v[3];
#pragma unroll
        for (int o = 1; o < 64; o <<= 1) { const float t = shidx(s, c.lane - o); if (c.lane >= o) s += t; }
        if (c.lane == 63) wtot[c.wave] = s;
        __syncthreads();
        float base = s - v[3];
        for (int w = 0; w < c.wave; ++w) base += wtot[w];
        *(LAS f32x4*)(Fs + 4 * c.tid) = (f32x4){base + v[0], base + v[1], base + v[2], base + v[3]};
    }
    const int tq = t0 + 32 * c.wave + L.r;
    bf16x8 Qf[8];
    attn_load_q(Qf, mix + (size_t)(b * SEQ + tq) * NMIX + C_FQ + hd * 128, p.fox_qn_g + layer * 128, 1.f, 0.08838834764831845f * LOG2E, L);
    AttnState A; for (int i = 0; i < 4; ++i) A.O[i] = zero16(); A.m = -1e30f; A.l = 0.f;
    const bf16_t* kbase = wsb(p, WS_FOXKN) + hd * 128; const bf16_t* vbase = mix + C_FV + hd * 128;
    const int nt = (t0 + 256) / 64;
    KvStage sg; kv_load(sg, kbase, 512, vbase, NMIX, b * SEQ, c.tid); kv_write(sg, KV, KV + KT_BYTES, c.tid);
    __syncthreads();
#pragma unroll 1
    for (int j = 0; j < nt; ++j) {
        const int kb = 64 * j; ldsp Kt = KV + (j & 1) * (KT_BYTES + VT_BYTES), Vt = Kt + KT_BYTES;
        if (j + 1 < nt) kv_load(sg, kbase, 512, vbase, NMIX, b * SEQ + kb + 64, c.tid);
        if (kb <= t0 + 32 * c.wave + 31) {
            f32x16 st[2]; attn_qk(st, Kt, Qf, L);
            const bool diag = kb + 63 > t0 + 32 * c.wave;
#pragma unroll
            for (int rt = 0; rt < 2; ++rt)
#pragma unroll
                for (int gq = 0; gq < 4; ++gq) { const f32x4 fv = *(const LAS f32x4*)(Fs + kb + 32 * rt + 8 * gq + 4 * L.h);
#pragma unroll
                    for (int e = 0; e < 4; ++e) { float sv = st[rt][4 * gq + e] - fv[e]; if (diag && (kb + 32 * rt + 8 * gq + 4 * L.h + e > tq)) sv = -__builtin_inff(); st[rt][4 * gq + e] = sv; } }
            attn_softmax_pv<false>(A, st, Vt, L);
        }
        if (j + 1 < nt) { ldsp Kn = KV + ((j + 1) & 1) * (KT_BYTES + VT_BYTES); kv_write(sg, Kn, Kn + KT_BYTES, c.tid); }
        __syncthreads();
    }
    attn_store(A, oall + (size_t)(b * SEQ + tq) * KBR + O_FOX + hd * 128, L);
}

DI void idx_unit(const Params& p0, const Ctx& c0, int u) {
    const Ctx c = fresh(c0); const Params p = freshp(p0);
    const int qb = 63 - (u >> 2), b = u & 3, t0 = 32 * qb;
    const bf16_t* mix = wsb(p, WS_MIX); const bf16_t* qup = wsb(p, WS_QUP); float* scores = wsf(p, WS_SCORES);
    ldsp KI = c.lds; const LaneIds L = lane_ids(c.lane);
    bf16x8 Af[2][4]; float Wr[2][16];
#pragma unroll
    for (int pp = 0; pp < 2; ++pp) {
        const int tqa = t0 + 4 * c.wave + 2 * pp + ((L.r >> 2) & 1), head = 4 * (L.r >> 3) + (L.r & 3);
#pragma unroll
        for (int s = 0; s < 4; ++s) Af[pp][s] = *(const bf16x8*)(qup + (size_t)(b * SEQ + tqa) * NUP + 512 + head * 64 + 16 * s + 8 * L.h);
        const bf16_t* wrow = mix + (size_t)(b * SEQ + t0 + 4 * c.wave + 2 * pp + L.h) * NMIX + C_IW; float w0[8], w1[8]; unpack8(*(const u32x4*)wrow, w0); unpack8(*(const u32x4*)(wrow + 8), w1);
#pragma unroll
        for (int i = 0; i < 8; ++i) { Wr[pp][i] = w0[i]; Wr[pp][8 + i] = w1[i]; }
    }
    const int nsup = (t0 + 31) / 256 + 1;
    u32x4 sg[4];
#pragma unroll
    for (int i = 0; i < 4; ++i) { const int it = c.tid + 512 * i; sg[i] = *(const u32x4*)(mix + (size_t)(b * SEQ + (it >> 3)) * NMIX + C_IK + 8 * (it & 7)); }
#pragma unroll
    for (int i = 0; i < 4; ++i) { const int it = c.tid + 512 * i; *(LAS u32x4*)(KI + (it >> 3) * 144 + (it & 7) * 16) = sg[i]; }
    __syncthreads();
#pragma unroll 1
    for (int js = 0; js < nsup; ++js) {
        ldsp Kc = KI + (js & 1) * 36864;
        if (js + 1 < nsup) {
#pragma unroll
            for (int i = 0; i < 4; ++i) { const int it = c.tid + 512 * i; sg[i] = *(const u32x4*)(mix + (size_t)(b * SEQ + 256 * (js + 1) + (it >> 3)) * NMIX + C_IK + 8 * (it & 7)); } }
#pragma unroll 1
        for (int kt = 0; kt < 8; ++kt) {
            const int kb = 256 * js + 32 * kt; if (kb > t0 + 31) break;
            bf16x8 Bf[4];
#pragma unroll
            for (int s = 0; s < 4; ++s) Bf[s] = *(const LAS bf16x8*)(Kc + (32 * kt + L.r) * 144 + (16 * s + 8 * L.h) * 2);
#pragma unroll
            for (int pp = 0; pp < 2; ++pp) { f32x16 acc = zero16();
#pragma unroll
                for (int s = 0; s < 4; ++s) acc = MFMA32(Af[pp][s], Bf[s], acc);
                float sc = 0.f;
#pragma unroll
                for (int i = 0; i < 16; ++i) sc += Wr[pp][i] * fmaxf(acc[i], 0.f);
                scores[(size_t)(b * SEQ + t0 + 4 * c.wave + 2 * pp + L.h) * SEQ + kb + L.r] = sc; }
        }
        if (js + 1 < nsup) { ldsp Kn = KI + ((js + 1) & 1) * 36864;
#pragma unroll
            for (int i = 0; i < 4; ++i) { const int it = c.tid + 512 * i; *(LAS u32x4*)(Kn + (it >> 3) * 144 + (it & 7) * 16) = sg[i]; } }
        __syncthreads();
    }
}

template <int NJ>
DI void sel_query(const float* row, unsigned* mrow, int t, int lane) {
    unsigned x[NJ];
#pragma unroll
    for (int j = 0; j < NJ; ++j) { const int key = 64 * j + lane; const unsigned bits = __float_as_uint(row[key]);
        const unsigned uu = (bits & 0x80000000u) ? ~bits : (bits | 0x80000000u); x[j] = (key <= t) ? uu : 0u; }
    unsigned T = 1u; bool exact = (t + 1 <= 256);
    if (!exact) {
#define SEL_COUNT(dst, thr) do { int _c = 0; _Pragma("unroll") for (int j = 0; j < NJ; ++j) _c += __popcll(__ballot(x[j] >= (thr))); dst = _c; } while (0)
        const float ex = 16384.f / (float)(t + 1), mg = 3.f * sqrtf(ex) + 2.f; const int k_hi0 = (int)floorf(ex - mg), k_hi = k_hi0 < 1 ? 1 : k_hi0, k_lo = (int)ceilf(ex + mg);
        unsigned lo = 1u, hi = 0xffffffffu; int clo = t + 1, chi = 0;
        if (k_lo <= 64) { unsigned v = 0u;
#pragma unroll 1
            for (int bit = 31; bit >= 0; --bit) { const unsigned cand = v | (1u << bit); if (__popcll(__ballot(x[0] >= cand)) >= k_lo) v = cand; }
            int cc; SEL_COUNT(cc, v); if (cc >= 256) { lo = v; clo = cc; if (cc == 256) { T = v; exact = true; } } else { hi = v; chi = cc; } }
        if (!exact) { unsigned v = 0u;
#pragma unroll 1
            for (int bit = 31; bit >= 0; --bit) { const unsigned cand = v | (1u << bit); if (__popcll(__ballot(x[0] >= cand)) >= k_hi) v = cand; }
            int cc; SEL_COUNT(cc, v);
            if (cc == 256) { T = v; exact = true; } else if (cc < 256) { if (v < hi) { hi = v; chi = cc; } } else if (v > lo) { lo = v; clo = cc; } }
        if (!exact) {
            int iter = 0;
#pragma unroll 1
            while (hi - lo > 1u) { const unsigned span = hi - lo; unsigned d = span >> 1;
                if ((iter & 1) == 0) { const float fr = (float)(clo - 256) * __builtin_amdgcn_rcpf((float)(clo - chi)); const float fd = fminf((float)span * fr, 4294967040.f);
                    d = (unsigned)fd; d = d < 1u ? 1u : d; d = d > span - 1u ? span - 1u : d; }
                ++iter;
                const unsigned mid = lo + d; int cc; SEL_COUNT(cc, mid);
                if (cc == 256) { T = mid; exact = true; break; }
                if (cc > 256) { lo = mid; clo = cc; } else { hi = mid; chi = cc; } }
            if (!exact) T = lo;
        }
#undef SEL_COUNT
    }
    if (exact) {
#pragma unroll
        for (int j = 0; j < NJ; ++j) { const unsigned long long bal = __ballot(x[j] >= T); if (lane == 0) { mrow[2 * j] = (unsigned)bal; mrow[2 * j + 1] = (unsigned)(bal >> 32); } }
    } else {
        int gt = 0;
#pragma unroll
        for (int j = 0; j < NJ; ++j) gt += __popcll(__ballot(x[j] > T));
        int need = 256 - gt, run = 0;
#pragma unroll
        for (int j = 0; j < NJ; ++j) { const bool eq = x[j] == T; const unsigned long long be = __ballot(eq); const int below = __popcll(be & ((1ull << lane) - 1ull));
            const bool sel = (x[j] > T) || (eq && (run + below < need)); run += __popcll(be);
            const unsigned long long bal = __ballot(sel); if (lane == 0) { mrow[2 * j] = (unsigned)bal; mrow[2 * j + 1] = (unsigned)(bal >> 32); } }
    }
    if (lane < 2 * (32 - NJ)) mrow[2 * NJ + lane] = 0u;
}
DI void sel_unit(const Params& p0, const Ctx& c0, int u) {
    const Ctx c = fresh(c0); const Params p = freshp(p0);
    const int qb = 127 - (u >> 2), b = u & 3, t0 = 16 * qb;
    const float* scores = wsf(p, WS_SCORES); unsigned* msk = (unsigned*)(p.ws + WS_MSK);
    const int grp = (t0 + 15) >> 9;
#pragma unroll 1
    for (int qi = 0; qi < 2; ++qi) {
        const int t = t0 + 2 * c.wave + qi; const float* row = scores + (size_t)(b * SEQ + t) * SEQ; unsigned* mrow = msk + (size_t)(b * SEQ + t) * 64;
        if (grp == 0) sel_query<8>(row, mrow, t, c.lane); else if (grp == 1) sel_query<16>(row, mrow, t, c.lane); else if (grp == 2) sel_query<24>(row, mrow, t, c.lane); else sel_query<32>(row, mrow, t, c.lane);
    }
}
DI void knorm_unit(const Params& p0, const Ctx& c0, int layer, int u) {
    const Ctx c = fresh(c0); const Params p = freshp(p0);
    const bf16_t* mix = wsb(p, WS_MIX); bf16_t* fk = wsb(p, WS_FOXKN); bf16_t* dk = wsb(p, WS_DSAKN);
    const int ch = c.tid & 15, tok = 32 * u + (c.tid >> 4);
    u32x4 raw[5];
#pragma unroll
    for (int hh = 0; hh < 5; ++hh) raw[hh] = *(const u32x4*)(mix + (size_t)tok * NMIX + (hh < 4 ? C_FK + hh * 128 : C_DK) + 8 * ch);
    const f32x4 f0 = *(const f32x4*)(p.fox_kn_g + layer * 128 + 8 * ch), f1 = *(const f32x4*)(p.fox_kn_g + layer * 128 + 8 * ch + 4);
    const f32x4 d0 = *(const f32x4*)(p.dsa_kn_g + layer * 128 + 8 * ch), d1 = *(const f32x4*)(p.dsa_kn_g + layer * 128 + 8 * ch + 4);
#pragma unroll
    for (int hh = 0; hh < 5; ++hh) {
        float a[8]; unpack8(raw[hh], a); float ss = 0.f;
#pragma unroll
        for (int e = 0; e < 8; ++e) ss += a[e] * a[e];
        ss += shx(ss, 1, c.lane); ss += shx(ss, 2, c.lane); ss += shx(ss, 4, c.lane); ss += shx(ss, 8, c.lane);
        const float rstd = __builtin_amdgcn_rsqf(ss * (1.f / 128.f) + EPS); const f32x4 g0 = hh < 4 ? f0 : d0, g1 = hh < 4 ? f1 : d1;
        const bf16x8 o = pack8(a[0] * rstd * g0[0], a[1] * rstd * g0[1], a[2] * rstd * g0[2], a[3] * rstd * g0[3], a[4] * rstd * g1[0], a[5] * rstd * g1[1], a[6] * rstd * g1[2], a[7] * rstd * g1[3]);
        if (hh < 4) *(bf16x8*)(fk + (size_t)tok * 512 + hh * 128 + 8 * ch) = o; else *(bf16x8*)(dk + (size_t)tok * 128 + 8 * ch) = o; }
}
DI void dsa_unit(const Params& p0, const Ctx& c0, int layer, int u) {
    const Ctx c = fresh(c0); const Params p = freshp(p0);
    const int qb = 31 - (u >> 2), b = u & 3, t0 = 64 * qb;
    const bf16_t* mix = wsb(p, WS_MIX); const bf16_t* qup = wsb(p, WS_QUP); bf16_t* oall = wsb(p, WS_OALL); const unsigned* msk = (const unsigned*)(p.ws + WS_MSK);
    LAS unsigned* Msk = (LAS unsigned*)c.lds; LAS float* Bl = (LAS float*)(c.lds + 16640); ldsp KV = c.lds + 16640 + 2048;
    const LaneIds L = lane_ids(c.lane);
    const int hd = c.wave >> 1, qg = c.wave & 1, ql = 32 * qg + L.r, tq = t0 + ql; const size_t tok = (size_t)(b * SEQ + tq);
    const float b31 = p.rel_bias[31 * 4 + hd] * LOG2E;
    if (c.tid < 128) {
        const int d = c.tid; int bk = d;
        if (d >= 16) { bk = 16 + (int)(__logf((float)d * (1.f / 16.f)) * (16.f / 2.0794415416798357f)); bk = bk > 31 ? 31 : bk; }
#pragma unroll
        for (int hh = 0; hh < 4; ++hh) Bl[d * 4 + hh] = (p.rel_bias[bk * 4 + hh] - p.rel_bias[31 * 4 + hh]) * LOG2E;
    }
#pragma unroll
    for (int i = 0; i < 8; ++i) { const int it = c.tid + 512 * i, q = it >> 6, w = it & 63; Msk[q * 65 + w] = msk[(size_t)(b * SEQ + t0 + q) * 64 + w]; }
    (void)b31;
    float rc;
    { float ss = 0.f; const bf16_t* cr = mix + tok * NMIX + C_DCQ + 256 * L.h;
#pragma unroll 4
      for (int i = 0; i < 32; ++i) { float f[8]; unpack8(*(const u32x4*)(cr + 8 * i), f);
#pragma unroll
          for (int e = 0; e < 8; ++e) ss += f[e] * f[e]; }
      ss += shx(ss, 32, L.r + 32 * L.h); rc = __builtin_amdgcn_rsqf(ss * (1.f / 512.f) + EPS); }
    bf16x8 Qf[8];
    attn_load_q(Qf, qup + tok * NUP + hd * 128, p.dsa_qn_g + layer * 128, rc, 0.08838834764831845f * LOG2E, L);
    AttnState A; for (int i = 0; i < 4; ++i) A.O[i] = zero16(); A.m = -1e30f; A.l = 0.f;
    const bf16_t* kbase = wsb(p, WS_DSAKN); const bf16_t* vbase = mix + C_DV;
    const int nt = qb + 1;
    KvStage sg; kv_load(sg, kbase, 128, vbase, NMIX, b * SEQ, c.tid); kv_write(sg, KV, KV + KT_BYTES, c.tid);
    __syncthreads();
#pragma unroll 1
    for (int j = 0; j < nt; ++j) {
        const int kb = 64 * j; ldsp Kt = KV + (j & 1) * (KT_BYTES + VT_BYTES), Vt = Kt + KT_BYTES;
        if (j + 1 < nt) kv_load(sg, kbase, 128, vbase, NMIX, b * SEQ + kb + 64, c.tid);
        {
            f32x16 st[2]; attn_qk(st, Kt, Qf, L);
            const unsigned mw0 = Msk[ql * 65 + 2 * j] >> (4 * L.h), mw1 = Msk[ql * 65 + 2 * j + 1] >> (4 * L.h);
            if (kb + 63 + 128 > t0 + 32 * qg) {
#pragma unroll
                for (int rt = 0; rt < 2; ++rt)
#pragma unroll
                    for (int i = 0; i < 16; ++i) { const int cr_ = (i & 3) + 8 * (i >> 2); const int d = tq - (kb + 32 * rt + cr_ + 4 * L.h);
                        if (d < 128) st[rt][i] += Bl[(d < 0 ? 0 : d) * 4 + hd]; }
            }
            attn_softmax_pv<true>(A, st, Vt, L, mw0, mw1);
        }
        if (j + 1 < nt) { ldsp Kn = KV + ((j + 1) & 1) * (KT_BYTES + VT_BYTES); kv_write(sg, Kn, Kn + KT_BYTES, c.tid); }
        __syncthreads();
    }
    attn_store(A, oall + tok * KBR + O_DSA + hd * 128, L);
}

constexpr int NPH = 9, NPHASES = 1 + DEPTH * NPH;
enum { Q_IDX = 0, Q_SSDST = 1, Q_RETKV = 2, Q_FOX = 3, Q_DSA = 4, Q_SSDO = 5, Q_RETO = 6, Q_SEL = 7 };
#ifndef LB2
#define LB2 2
#endif
__global__ void __launch_bounds__(512, LB2) fwd(Params pk) {
    extern __shared__ __attribute__((aligned(16))) unsigned char lds_raw[];
    Ctx c; c.lds = (ldsp)lds_raw; c.tid = threadIdx.x; c.lane = c.tid & 63; c.wave = __builtin_amdgcn_readfirstlane(c.tid >> 6); c.G = gridDim.x; c.bid = blockIdx.x;
    c.ctl = (gu32*)(pk.ws + WS_CTL);
    if (c.tid < 64) ((LAS unsigned*)(c.lds + LDS_MISC))[c.tid] = 0u;
    __syncthreads();
#if MK_PER_PHASE
#define GRID_BAR() do { } while (0)
#else
    XcdBarrier bar = xcd_barrier_post((unsigned*)(c.ctl + CW_BAR), (volatile LAS unsigned*)(c.lds + LDS_MISC) + 8);
#define GRID_BAR() xcd_barrier(bar)
#endif
    const int lo = pk.ph_lo, hi = pk.ph_hi, rep = pk.rep;
#define IN(k) (lo <= (k) && (k) < hi)
#define SEAM(k) do { if (IN((k) + 1)) GRID_BAR(); } while (0)
#define PHASE(k, ...) if (PH_ON((k) + 1) && IN(pb + (k))) { const Params p = loadp(); unsigned char* wl = p.ws + WS_W + (size_t)l * WL_SIZE; (void)wl; __VA_ARGS__ SEAM(pb + (k)); }
    if (PH_ON(0) && IN(0)) { const Params p = loadp(); p0_prologue(p, c); xprep_phase(c, p.x, wsb(p, WS_HN), wsf(p, WS_SSP)); SEAM(0); }
#pragma unroll 1
    for (int l = 0; l < DEPTH; ++l) {
        const int pb = 1 + l * NPH;
        PHASE(0, {
            pg8::Gemm g{wsb(p, WS_HN), (const bf16_t*)(wl + WL_IN), MTOK, NIN, DM, DM, DM}; pg8::StaticOrder S; S.init(MTOK, NIN, c.G, c.bid);
            pg8::EpiIn E{wsb(p, WS_MIX), wsb(p, WS_GATES), p.gate_b + (size_t)l * NGATE, wsf(p, WS_SSP)};
            pg8::gemm_phase(c.lds, g, S, E);
            convert_on_idle(p, c, l, I_IN, PER_LAYER, (MTOK / 256) * (NIN / 256)); })
        PHASE(1, {
            pg8::Gemm g{wsb(p, WS_MIX) + C_DCQ, (const bf16_t*)(wl + WL_UP), MTOK, NUP, KUP, NMIX, KUP}; pg8::StaticOrder S; S.init(MTOK, NUP, c.G, c.bid);
            pg8::EpiBf16<0> E{wsb(p, WS_QUP), NUP, nullptr};
            pg8::gemm_phase(c.lds, g, S, E);
            if (l + 1 < DEPTH) convert_on_idle(p, c, l + 1, 0, CV_B, (MTOK / 256) * (NUP / 256)); })
        PHASE(2, {
            if (rep == 0 || ((REP_UM >> Q_IDX) & 1)) for (int u; (u = next_unit(c, l, Q_IDX + 8 * rep)) < 256;) idx_unit(p, c, u);
            if (rep == 0 || ((REP_UM >> Q_SSDST) & 1)) for (int u; (u = next_unit(c, l, Q_SSDST + 8 * rep)) < 256;) ssdst_unit(p, c, l, u);
            if (rep == 0 || ((REP_UM >> Q_RETKV) & 1)) for (int u; (u = next_unit(c, l, Q_RETKV + 8 * rep)) < 256;) retkv_unit(p, c, u);
            for (int u = c.bid; u < 256; u += c.G) { knorm_unit(p, c, l, u); } })
        PHASE(3, {
            for (int u; (u = next_unit(c, l, Q_SEL + 8 * rep)) < 512;) sel_unit(p, c, u);
            scan_phase(p, c); })
        PHASE(4, {
            if (rep == 0 || ((REP_UM >> Q_DSA) & 1)) for (int u; (u = next_unit(c, l, Q_DSA + 8 * rep)) < 128;) dsa_unit(p, c, l, u);
            if (rep == 0 || ((REP_UM >> Q_FOX) & 1)) for (int u; (u = next_unit(c, l, Q_FOX + 8 * rep)) < 128;) fox_unit(p, c, l, u);
            if (rep == 0 || ((REP_UM >> Q_SSDO) & 1)) for (int u; (u = next_unit(c, l, Q_SSDO + 8 * rep)) < 256;) ssdo_unit(p, c, l, u);
            if (rep == 0 || ((REP_UM >> Q_RETO) & 1)) for (int u; (u = next_unit(c, l, Q_RETO + 8 * rep)) < 256;) reto_unit(p, c, u);
            if (l + 1 < DEPTH) { __syncthreads(); convert_items(p, c, l + 1, CV_B, I_IN, c.bid * 8 + c.wave, c.G * 8); } })
        PHASE(5, {
            pg8::Gemm g{wsb(p, WS_OALL), (const bf16_t*)(wl + WL_BR), MTOK, DM, KBR, KBR, KBR}; pg8::StaticOrder S; S.init(MTOK, DM, c.G, c.bid);
            pg8::EpiMerge E{wsb(p, WS_MERGED), wsb(p, WS_GATES), wsf(p, WS_SSQH), wsb(p, WS_ONESB)};
            pg8::gemm_phase(c.lds, g, S, E); })
        PHASE(6, {
            pg8::Gemm g{wsb(p, WS_MERGED), (const bf16_t*)(wl + WL_OUT), MTOK, DM, DM, DM, DM}; pg8::StaticOrder S; S.init(MTOK, DM, c.G, c.bid);
            pg8::EpiResid<1, 0> E{wsb(p, WS_HN), nullptr, wsb(p, WS_XRES), wsf(p, WS_SSP), DM};
            pg8::gemm_phase(c.lds, g, S, E); })
        PHASE(7, {
            pg8::Gemm g{wsb(p, WS_XRES), (const bf16_t*)(wl + WL_FF1), MTOK, DFF, DM, DM, DM}; pg8::StaticOrder S; S.init(MTOK, DFF, c.G, c.bid);
            pg8::EpiBf16<1> E{wsb(p, WS_FFH), DFF, wsf(p, WS_SSP)};
            pg8::gemm_phase(c.lds, g, S, E); })
        if (l < DEPTH - 1) {
            PHASE(8, {
                pg8::Gemm g{wsb(p, WS_FFH), (const bf16_t*)(wl + WL_FF2), MTOK, DM, DFF, DFF, DFF}; pg8::StaticOrder S; S.init(MTOK, DM, c.G, c.bid);
                pg8::EpiResid<1, 0> E{wsb(p, WS_XRES), nullptr, wsb(p, WS_HN), wsf(p, WS_SSP), DM};
                pg8::gemm_phase(c.lds, g, S, E); })
        } else {
            PHASE(8, {
                pg8::Gemm g{wsb(p, WS_FFH), (const bf16_t*)(wl + WL_FF2), MTOK, DM, DFF, DFF, DFF}; pg8::StaticOrder S; S.init(MTOK, DM, c.G, c.bid);
                pg8::EpiResid<1, 1> E{wsb(p, WS_XRES), p.out, nullptr, nullptr, DM};
                pg8::gemm_phase(c.lds, g, S, E); })
        }
    }
#undef PHASE
#undef IN
#undef SEAM
}

extern "C" void kernel_launch(void* const* d_in, const int* in_sizes, int n_in, void* d_out, int out_size, void* d_ws, size_t ws_size, hipStream_t stream) {
    static int grid = 0;
    if (grid == 0) {
        if (n_in != 24 || in_sizes[0] != MTOK * DM || out_size != MTOK * DM || ws_size < WS_END) {
            fprintf(stderr, "kernel_launch: unexpected problem (n_in %d, in0 %d, out %d, ws %zu < %zu?); nothing launched\n", n_in, n_in > 0 ? in_sizes[0] : -1, out_size, ws_size, (size_t)WS_END); grid = -1; return; }
        int dev = 0, cus = 0;
        if (hipGetDevice(&dev) != hipSuccess || hipDeviceGetAttribute(&cus, hipDeviceAttributeMultiprocessorCount, dev) != hipSuccess) { grid = -1; return; }
        if (hipFuncSetAttribute((const void*)fwd, hipFuncAttributeMaxDynamicSharedMemorySize, LDS_BYTES) != hipSuccess) { fprintf(stderr, "kernel_launch: hipFuncSetAttribute failed\n"); grid = -1; return; }
        int per_cu = 0;
        if (hipOccupancyMaxActiveBlocksPerMultiprocessor(&per_cu, (const void*)fwd, 512, LDS_BYTES) != hipSuccess || per_cu < 1) { fprintf(stderr, "kernel_launch: occupancy query says %d blocks per CU\n", per_cu); }
        (void)hipGetLastError();
        grid = cus;
    }
    if (grid < 0) return;
    (void)hipMemsetAsync((char*)d_ws + WS_CTL, 0, CTL_ZERO_BYTES, stream);
    Params p{};
    const float** pin = (const float**)&p;
    for (int i = 0; i < 24; ++i) pin[i] = (const float*)d_in[i];
    p.out = (float*)d_out; p.ws = (unsigned char*)d_ws;
#if MK_PER_PHASE
    for (int ph = 0; ph < NPHASES; ++ph) { p.ph_lo = ph; p.ph_hi = ph + 1; p.rep = 0; hipLaunchKernelGGL(fwd, dim3(grid), dim3(512), LDS_BYTES, stream, p);
        if ((ph >= 1 && (ph - 1) % NPH == REPEAT_PH) || (ph == 0 && REPEAT_PH == 100)) { p.rep = 1; hipLaunchKernelGGL(fwd, dim3(grid), dim3(512), LDS_BYTES, stream, p); } }
#else
    p.ph_lo = 0; p.ph_hi = NPHASES; hipLaunchKernelGGL(fwd, dim3(grid), dim3(512), LDS_BYTES, stream, p);
#endif
    const hipError_t le = hipPeekAtLastError();
    if (le != hipSuccess) fprintf(stderr, "kernel_launch: launch failed: %s\n", hipGetErrorName(le));
}
```

```cpp
#include <hip/hip_runtime.h>
#include <cstdio>
#include <cstdint>

#ifndef MK_PER_PHASE
#define MK_PER_PHASE 0
#endif
#ifndef REPEAT_PH
#define REPEAT_PH -1
#endif
#ifndef REP_UM
#define REP_UM 0xFF
#endif
#ifndef PHMASK
#define PHMASK 0xFFFFu
#endif
#define PH_ON(k) ((PHMASK >> (k)) & 1u)
#ifndef UM
#define UM 0xFF
#endif

#define DI __device__ __forceinline__
#define LAS __attribute__((address_space(3)))
#define GAS __attribute__((address_space(1)))
typedef unsigned short bf16_t;
typedef short bf16x8 __attribute__((ext_vector_type(8)));
typedef short s16x4 __attribute__((ext_vector_type(4)));
typedef float f32x2 __attribute__((ext_vector_type(2)));
typedef float f32x4 __attribute__((ext_vector_type(4)));
typedef float f32x16 __attribute__((ext_vector_type(16)));
typedef unsigned u32x2 __attribute__((ext_vector_type(2)));
typedef unsigned u32x4 __attribute__((ext_vector_type(4)));
typedef __bf16 bf16x2_t __attribute__((ext_vector_type(2)));
typedef GAS unsigned gu32;
typedef LAS unsigned char* ldsp;

constexpr int NB = 4, SEQ = 2048, DM = 2048, DEPTH = 4, MTOK = NB * SEQ;
constexpr int DFF = 8192, IN_TOTAL = 15204;
constexpr int NMIX = 7168, NGATE = 8192, NIN = NMIX + NGATE;
constexpr int NUP = 1536, KUP = 512, KBR = 2560;
constexpr float EPS = 1e-6f;
constexpr float LOG2E = 1.4426950408889634f;
constexpr int C_RQ = 0, C_RK = 512, C_RV = 1024, C_RG = 1536, C_FQ = 2048, C_FK = 2560, C_FV = 3072, C_DCQ = 3584, C_DK = 4096, C_DV = 4224,
              C_IK = 4352, C_SZ = 4416, C_SX = 5440, C_SB = 6464, C_SC = 6720, C_IW = 6976, C_SDT = 6992, C_FF = 7008, C_MIXEND = 7012;
constexpr int O_RET = 0, O_FOX = 512, O_DSA = 1024, O_SSD = 1536;

constexpr size_t MiB = 1u << 20;
constexpr size_t WS_CTL = 0, CTL_ZERO_BYTES = 1 * MiB;
constexpr size_t WL_IN = 0, WL_UP = WL_IN + (size_t)NIN * DM * 2, WL_BR = WL_UP + (size_t)NUP * KUP * 2, WL_OUT = WL_BR + (size_t)DM * KBR * 2,
                 WL_FF1 = WL_OUT + (size_t)DM * DM * 2, WL_FF2 = WL_FF1 + (size_t)DFF * DM * 2, WL_SIZE = WL_FF2 + (size_t)DM * DFF * 2;
constexpr size_t WS_W = 2 * MiB;
constexpr size_t WS_ACT = ((WS_W + DEPTH * WL_SIZE + MiB - 1) / MiB) * MiB;
constexpr size_t WS_XRES = WS_ACT, WS_X1 = WS_XRES + 64 * MiB, WS_HN = WS_X1 + 64 * MiB, WS_MIX = WS_HN + 32 * MiB, WS_GATES = WS_MIX + 112 * MiB,
                 WS_QUP = WS_GATES + 128 * MiB, WS_OALL = WS_QUP + 24 * MiB, WS_MERGED = WS_OALL + 40 * MiB, WS_FFH = WS_MERGED + 32 * MiB,
                 WS_SCORES = WS_FFH + 128 * MiB, WS_KVS = WS_SCORES + 64 * MiB, WS_PREVR = WS_KVS + 16 * MiB, WS_ST = WS_PREVR + 8 * MiB,
                 WS_PREVS = WS_ST + 32 * MiB, WS_XBCC = WS_PREVS + 16 * MiB, WS_ACS = WS_XBCC + 24 * MiB, WS_BS = WS_ACS + 1 * MiB, WS_SSQH = WS_BS + 1 * MiB, WS_SSP = WS_SSQH + 1 * MiB, WS_FOXKN = WS_SSP + 1 * MiB, WS_DSAKN = WS_FOXKN + 8 * MiB, WS_MSK = WS_DSAKN + 2 * MiB,
                 WS_END = WS_MSK + 2 * MiB;
constexpr int CW_BAR = 4096;
constexpr int CW_QUEUE = 16384;
constexpr int NQUEUE = 16;

constexpr int LDS_BYTES = 147456;
constexpr int LDS_WORK = 143360;
constexpr int LDS_MISC = LDS_WORK;

DI float bf2f(unsigned short b) { return __uint_as_float(((unsigned)b) << 16); }
DI float bflo(unsigned u) { return __uint_as_float(u << 16); }
DI float bfhi(unsigned u) { return __uint_as_float(u & 0xffff0000u); }
DI unsigned pk2(float lo, float hi) { f32x2 v = {lo, hi}; bf16x2_t b = __builtin_convertvector(v, bf16x2_t); return __builtin_bit_cast(unsigned, b); }
DI unsigned short f2bf(float f) { return (unsigned short)(pk2(f, 0.f) & 0xffffu); }
DI bf16x8 pack8(float a0, float a1, float a2, float a3, float a4, float a5, float a6, float a7) {
    u32x4 p; p.x = pk2(a0, a1); p.y = pk2(a2, a3); p.z = pk2(a4, a5); p.w = pk2(a6, a7); return __builtin_bit_cast(bf16x8, p); }
DI void unpack8(const u32x4 v, float (&f)[8]) { f[0] = bflo(v.x); f[1] = bfhi(v.x); f[2] = bflo(v.y); f[3] = bfhi(v.y); f[4] = bflo(v.z); f[5] = bfhi(v.z); f[6] = bflo(v.w); f[7] = bfhi(v.w); }
DI float sigmoidf_(float x) { return __builtin_amdgcn_rcpf(1.f + __builtin_amdgcn_exp2f(-LOG2E * x)); }
DI float siluf_(float x) { return x * __builtin_amdgcn_rcpf(1.f + __builtin_amdgcn_exp2f(-LOG2E * x)); }
#define MFMA32(a, b, c) __builtin_amdgcn_mfma_f32_32x32x16_bf16((a), (b), (c), 0, 0, 0)
DI int crow(int i, int h) { return (i & 3) + 8 * (i >> 2) + 4 * h; }
DI s16x4 trrd(ldsp p) { return __builtin_bit_cast(s16x4, __builtin_amdgcn_ds_read_tr16_b64_v4i16((LAS s16x4*)p)); }
DI bf16x8 tr_pair(ldsp p, int off2) { s16x4 lo = trrd(p), hi = trrd(p + off2); return __builtin_shufflevector(lo, hi, 0, 1, 2, 3, 4, 5, 6, 7); }
DI float shidx(float v, int src) { return __int_as_float(__builtin_amdgcn_ds_bpermute(src << 2, __float_as_int(v))); }
DI float shx(float v, int m, int lane) { return shidx(v, lane ^ m); }
DI void store_pair_t21(bf16_t* rowp, int k, u32x2 a, u32x2 b, int h) {
    const auto rx = __builtin_amdgcn_permlane32_swap(a.x, b.x, false, false), ry = __builtin_amdgcn_permlane32_swap(a.y, b.y, false, false);
    u32x4 w; w.x = rx[0]; w.y = ry[0]; w.z = rx[1]; w.w = ry[1];
    *(u32x4*)(rowp + 8 * k + (h ? 8 : 0)) = w;
}
DI f32x16 zero16() { f32x16 z; for (int i = 0; i < 16; ++i) z[i] = 0.f; return z; }

#define XB_TMO      128
#define XB_XCNT(j)  (256  + 64 * (j))
#define XB_XSUB(j)  (1280 + 64 * (j))
#define XB_XGEN(j)  (2304 + 64 * (j))
#define XB_TOP      3328
#define XB_TOPGEN   3392
#define XCD_BAR_WORDS 3456
#define XB_SPIN_CAP (1u << 18)
DI unsigned xb_ld(unsigned* p)              { return __hip_atomic_load(p, __ATOMIC_RELAXED, __HIP_MEMORY_SCOPE_AGENT); }
DI unsigned xb_add(unsigned* p, unsigned v) { return __hip_atomic_fetch_add(p, v, __ATOMIC_RELAXED, __HIP_MEMORY_SCOPE_AGENT); }
DI unsigned xb_xcc_id() { return (unsigned)__builtin_amdgcn_s_getreg((3 << 11) | 20) & 0xFu; }
#define XB_SPIN(cond, bar) do { unsigned _sp = 0; while (cond) { __builtin_amdgcn_s_sleep(1); \
    if ((++_sp & 255u) == 0u) { if (xb_ld(&(bar)[XB_TMO])) break; if (_sp > XB_SPIN_CAP) { atomicAdd(&(bar)[XB_TMO], 1u); break; } } } } while (0)
struct XcdBarrier { unsigned* bar; unsigned x; volatile LAS unsigned* st; };
DI XcdBarrier xcd_barrier_post(unsigned* bar, volatile LAS unsigned* st) {
    XcdBarrier b; b.bar = bar; b.x = xb_xcc_id(); b.st = st;
    if (threadIdx.x == 0) (void)xb_add(&bar[XB_XCNT(b.x)], 1u);
    return b;
}
DI void xcd_barrier_complete(unsigned* bar, unsigned x, unsigned& nloc, unsigned& nx) {
    const unsigned G = gridDim.x * gridDim.y * gridDim.z;
    unsigned sum, cnt, mine, sp = 0u;
    for (;;) {
        sum = 0u; cnt = 0u; mine = 0u;
#pragma unroll
        for (unsigned j = 0; j < 16; ++j) { const unsigned c = xb_ld(&bar[XB_XCNT(j)]); sum += c; cnt += (c > 0u) ? 1u : 0u; mine = (j == x) ? c : mine; }
        if (sum == G) break;
        __builtin_amdgcn_s_sleep(1);
        if ((++sp & 255u) == 0u) { if (xb_ld(&bar[XB_TMO])) break; if (sp > XB_SPIN_CAP) { atomicAdd(&bar[XB_TMO], 1u); break; } }
    }
    nloc = mine > 0u ? mine : 1u; nx = cnt > 0u ? cnt : 1u;
}
DI void xcd_barrier(const XcdBarrier& b) {
    asm volatile("s_waitcnt vmcnt(0)" ::: "memory");
    __syncthreads();
    if (threadIdx.x == 0) {
        unsigned* bar = b.bar; { GAS unsigned* w = (GAS unsigned*)bar; asm volatile("" : "+s"(w)); bar = (unsigned*)w; }
        __builtin_amdgcn_s_waitcnt(0);
        unsigned nloc = b.st[0], nx = b.st[1];
        if (nloc == 0u) { xcd_barrier_complete(bar, b.x, nloc, nx); b.st[0] = nloc; b.st[1] = nx; }
        const unsigned old = xb_add(&bar[XB_XSUB(b.x)], 1u);
        const unsigned gen = old / nloc;
        if (old + 1u == (gen + 1u) * nloc) {
            __builtin_amdgcn_fence(__ATOMIC_RELEASE, "agent");
            asm volatile("s_waitcnt vmcnt(0)" ::: "memory");
            const unsigned og = xb_add(&bar[XB_TOP], 1u);
            const unsigned tg = og / nx;
            if (og + 1u == (tg + 1u) * nx) xb_add(&bar[XB_TOPGEN], 1u);
            else XB_SPIN(xb_ld(&bar[XB_TOPGEN]) == tg, bar);
            __builtin_amdgcn_fence(__ATOMIC_ACQUIRE, "agent");
            xb_add(&bar[XB_XGEN(b.x)], 1u);
            asm volatile("s_waitcnt vmcnt(0)" ::: "memory");
        } else {
            XB_SPIN(xb_ld(&bar[XB_XGEN(b.x)]) == gen, bar);
            __builtin_amdgcn_fence(__ATOMIC_ACQUIRE, "agent");
            asm volatile("s_waitcnt vmcnt(0)" ::: "memory");
        }
    }
    __syncthreads();
}

namespace pg8 {
constexpr int BM = 256, BK = 64, HALF = 128, HTB = HALF * BK * 2, STAGE_BYTES = 8 * HTB, NXCD = 8, WGM = 8;
__host__ __device__ __forceinline__ int lds_byte(int r, int c) { const int st = (r >> 4) * 2 + (c >> 5), rr = r & 15, cc = c & 31, ob = rr * 64 + cc * 2; return st * 1024 + (ob ^ (((ob >> 9) & 1) << 5)); }
__host__ __device__ __forceinline__ void stage_rc(int b, int& R, int& C) { const int st = b / 1024, sb = b % 1024, swz = sb ^ (((sb >> 9) & 1) << 5); R = (st >> 1) * 16 + swz / 64; C = (st & 1) * 32 + (swz % 64) / 2; }
__host__ __device__ __forceinline__ int perm32(int rho) { const int n = rho >> 4, i = rho & 15; return 8 * (i >> 2) + 4 * n + (i & 3); }
struct Unit { int pm, pn; };
struct Gemm { const bf16_t* A; const bf16_t* Bt; int M, N, K, lda, ldb; };
struct StaticOrder {
    int nM, nN, nwg, G, c;
    __host__ __device__ void init(int M, int N, int G_, int c_) { nM = M / BM; nN = N / BM; nwg = nM * nN; G = G_; c = c_; }
    __host__ __device__ bool next(int i, Unit& u) const {
        const long L = (long)i * G + c; if (L >= nwg) return false;
        int wgid = (int)L; { const int q = nwg / NXCD, r = nwg % NXCD, xcd = wgid % NXCD, off = wgid / NXCD; wgid = (xcd < r ? xcd * (q + 1) : r * (q + 1) + (xcd - r) * q) + off; }
        const int nig = WGM * nN, gid = wgid / nig, fm = gid * WGM, gsz = (nM - fm) < WGM ? (nM - fm) : WGM;
        u.pm = fm + ((wgid % nig) % gsz); u.pn = (wgid % nig) / gsz; return true;
    }
};
typedef f32x4 Acc[2][2][4][2];

template <class Epi>
DI void gemm_phase(ldsp lds, const Gemm g, const StaticOrder& S, const Epi& E) {
    int tid = threadIdx.x; asm volatile("" : "+v"(tid));
    const int wid = __builtin_amdgcn_readfirstlane(tid >> 6), lane = tid & 63, wr = wid >> 2, wc = wid & 3, fr = lane & 15, fq = lane >> 4;
    const int K = g.K, nt = K / BK;
    unsigned voffA[2], voffB[2];
#pragma unroll
    for (int i = 0; i < 2; ++i) { int R, C; stage_rc(tid * 16 + i * 8192, R, C); const int Rb = Epi::PERM ? ((R & ~31) + perm32(R & 31)) : R;
        voffA[i] = (unsigned)(R * g.lda + C) * 2u; voffB[i] = (unsigned)(Rb * g.ldb + C) * 2u; }
    const size_t kstep = (size_t)(BK * 2);
    const size_t hstepA = (size_t)HALF * g.lda * 2, hstepB = (size_t)HALF * g.ldb * 2;
    const size_t tstepA = 2 * hstepA, tstepB = 2 * hstepB;
    const unsigned ldsw = (unsigned)wid * 1024u;
    const int aoff = lds_byte(wr * 64 + fr, fq * 8), boff = lds_byte(wc * 32 + fr, fq * 8);
#define PG8_SA(b, h) (((b) * 2 + (h)) * HTB)
#define PG8_SB(b, h) ((4 + (b) * 2 + (h)) * HTB)
#define PG8_STAGE(bufoff, gbase, voff) do { _Pragma("unroll") for (int _i = 0; _i < 2; ++_i) \
        __builtin_amdgcn_global_load_lds((const unsigned*)((const char*)(gbase) + (voff)[_i]), (LAS unsigned*)(lds + (bufoff) + ldsw + _i * 8192), 16, 0, 0); } while (0)
#define PG8_LDA(dst, b, h) do { _Pragma("unroll") for (int m = 0; m < 4; ++m) _Pragma("unroll") for (int k = 0; k < 2; ++k) dst[m][k] = *(const LAS bf16x8*)(lds + PG8_SA(b, h) + aoff + m * 2048 + k * 1024); } while (0)
#define PG8_LDB(dst, b, h) do { _Pragma("unroll") for (int n = 0; n < 2; ++n) _Pragma("unroll") for (int k = 0; k < 2; ++k) dst[n][k] = *(const LAS bf16x8*)(lds + PG8_SB(b, h) + boff + n * 2048 + k * 1024); } while (0)
#define PG8_MMA(ai, bj, At, Bt) do { __builtin_amdgcn_s_setprio(1); _Pragma("unroll") for (int m = 0; m < 4; ++m) _Pragma("unroll") for (int n = 0; n < 2; ++n) _Pragma("unroll") for (int k = 0; k < 2; ++k) \
        acc[ai][bj][m][n] = __builtin_amdgcn_mfma_f32_16x16x32_bf16(Bt[n][k], At[m][k], acc[ai][bj][m][n], 0, 0, 0); __builtin_amdgcn_s_setprio(0); } while (0)
#define PG8_WAIT_V(n) asm volatile("s_waitcnt vmcnt(" #n ")" ::: "memory")
#define PG8_WAIT_L(n) asm volatile("s_waitcnt lgkmcnt(" #n ")" ::: "memory")
#define PG8_BAR __builtin_amdgcn_s_barrier()
#define PG8_SCHED __builtin_amdgcn_sched_barrier(0)
    Unit cur, nxt; int ui = 0;
    if (!S.next(0, cur)) return;
    if constexpr (Epi::HAS_MID) { E.prep(lds, cur, tid); __syncthreads(); }
    Acc acc;
#pragma unroll
    for (int a = 0; a < 2; ++a)
#pragma unroll
        for (int b = 0; b < 2; ++b)
#pragma unroll
            for (int m = 0; m < 4; ++m)
#pragma unroll
                for (int n = 0; n < 2; ++n) acc[a][b][m][n] = (f32x4){0.f, 0.f, 0.f, 0.f};
    bf16x8 At[4][2], B0[2][2], B1[2][2];
    f32x4 rsA = {0.f, 0.f, 0.f, 0.f}, rsB = rsA;
    const char* cA = (const char*)g.A + (size_t)cur.pm * tstepA; const char* cB = (const char*)g.Bt + (size_t)cur.pn * tstepB;
    PG8_STAGE(PG8_SB(0, 0), cB, voffB); PG8_STAGE(PG8_SB(0, 1), cB + hstepB, voffB); PG8_STAGE(PG8_SA(0, 0), cA, voffA); PG8_STAGE(PG8_SA(0, 1), cA + hstepA, voffA);
    if (wr == 1) PG8_BAR;
    PG8_WAIT_V(2); PG8_BAR;
    PG8_STAGE(PG8_SB(1, 0), cB + kstep, voffB); PG8_STAGE(PG8_SA(1, 0), cA + kstep, voffA); PG8_STAGE(PG8_SB(1, 1), cB + hstepB + kstep, voffB);
    PG8_WAIT_V(6); PG8_BAR;
    for (;;) {
        const bool has_next = S.next(ui + 1, nxt);
        const char* nA = has_next ? (const char*)g.A + (size_t)nxt.pm * tstepA : cA; const char* nB = has_next ? (const char*)g.Bt + (size_t)nxt.pn * tstepB : cB;
        for (int t = 0; t < nt; t += 2) {
            const bool last = (t == nt - 2);
            const char* a1 = cA + (size_t)(t + 1) * kstep;
            const char* a2 = last ? nA : cA + (size_t)(t + 2) * kstep; const char* b2 = last ? nB : cB + (size_t)(t + 2) * kstep;
            const char* a3 = a2 + kstep; const char* b3 = b2 + kstep;
            if constexpr (Epi::HAS_MID) { if (E.is_mid(t)) { E.mid(acc, cur, t, wr, wc, fr, fq, lds); PG8_SCHED; } }
            if constexpr (Epi::ROWSCALE) { if (last && tid < 256) { const f32x4* sp = (const f32x4*)(E.ssp + (size_t)(cur.pm * BM + tid) * 8); rsA = sp[0]; rsB = sp[1]; } }
            PG8_LDB(B0, 0, 0); PG8_LDB(B1, 0, 1); PG8_SCHED; PG8_LDA(At, 0, 0); PG8_STAGE(PG8_SA(1, 1), a1 + hstepA, voffA);
            PG8_WAIT_V(8); PG8_WAIT_L(0); PG8_BAR; PG8_MMA(0, 0, At, B0); PG8_MMA(0, 1, At, B1); PG8_BAR; PG8_SCHED;
            PG8_LDA(At, 0, 1); PG8_STAGE(PG8_SB(0, 0), b2, voffB); PG8_STAGE(PG8_SB(0, 1), b2 + hstepB, voffB); PG8_STAGE(PG8_SA(0, 0), a2, voffA);
            PG8_WAIT_V(8); PG8_WAIT_L(0); PG8_BAR; PG8_MMA(1, 0, At, B0); PG8_MMA(1, 1, At, B1); PG8_BAR; PG8_SCHED;
            PG8_LDB(B0, 1, 0); PG8_LDB(B1, 1, 1); PG8_SCHED; PG8_LDA(At, 1, 0); PG8_STAGE(PG8_SA(0, 1), a2 + hstepA, voffA);
            PG8_WAIT_V(8); PG8_WAIT_L(0); PG8_BAR; PG8_MMA(0, 0, At, B0); PG8_MMA(0, 1, At, B1); PG8_BAR; PG8_SCHED;
            PG8_LDA(At, 1, 1); PG8_STAGE(PG8_SB(1, 0), b3, voffB); PG8_STAGE(PG8_SB(1, 1), b3 + hstepB, voffB); PG8_STAGE(PG8_SA(1, 0), a3, voffA);
            PG8_WAIT_V(8); PG8_WAIT_L(0); PG8_BAR; PG8_MMA(1, 0, At, B0); PG8_MMA(1, 1, At, B1); PG8_BAR; PG8_SCHED;
        }
        if (wr == 0) PG8_BAR;
        if constexpr (Epi::ROWSCALE) {
            LAS float* tab = (LAS float*)(lds + STAGE_BYTES);
            if (tid < 256) { const float t = ((rsA[0] + rsA[1]) + (rsA[2] + rsA[3])) + ((rsB[0] + rsB[1]) + (rsB[2] + rsB[3])); tab[tid] = __builtin_amdgcn_rsqf(t * (1.f / (float)DM) + EPS); }
            PG8_WAIT_L(0); PG8_BAR; asm volatile("" ::: "memory");
        }
        E(acc, cur, wr, wc, fr, fq, lds);
        if (!has_next) break;
#pragma unroll
        for (int a = 0; a < 2; ++a)
#pragma unroll
            for (int b = 0; b < 2; ++b)
#pragma unroll
                for (int m = 0; m < 4; ++m)
#pragma unroll
                    for (int n = 0; n < 2; ++n) acc[a][b][m][n] = (f32x4){0.f, 0.f, 0.f, 0.f};
        cur = nxt; cA = nA; cB = nB; ++ui;
        if constexpr (Epi::HAS_MID) { PG8_BAR; E.prep(lds, cur, tid); PG8_WAIT_L(0); PG8_BAR; }
        if (wr == 1) PG8_BAR;
    }
    PG8_WAIT_V(0);
    PG8_BAR;
#undef PG8_SA
#undef PG8_SB
#undef PG8_STAGE
#undef PG8_LDA
#undef PG8_LDB
#undef PG8_MMA
#undef PG8_WAIT_V
#undef PG8_WAIT_L
#undef PG8_BAR
#undef PG8_SCHED
}

DI void store8(bf16_t* p, const f32x4 v0, const f32x4 v1) { u32x4 w; w.x = pk2(v0[0], v0[1]); w.y = pk2(v0[2], v0[3]); w.z = pk2(v1[0], v1[1]); w.w = pk2(v1[2], v1[3]); *(u32x4*)p = w; }
struct EpiIn {
    static constexpr bool PERM = true, HAS_MID = false, ROWSCALE = true;
    bf16_t* mix; bf16_t* gates; const float* gate_b; const float* ssp;
    DI void operator()(const Acc& acc, const Unit& u, int wr, int wc, int fr, int fq, ldsp lds) const {
        const int row0 = u.pm * BM + wr * 64 + fr; const LAS float* tab = (const LAS float*)(lds + STAGE_BYTES);
        if (u.pn < NMIX / BM) {
            const int col0 = u.pn * BM + wc * 32 + 8 * fq;
#pragma unroll
            for (int ai = 0; ai < 2; ++ai)
#pragma unroll
                for (int m = 0; m < 4; ++m) { const float rs = tab[wr * 64 + fr + ai * HALF + m * 16]; bf16_t* rowp = mix + (size_t)(row0 + ai * HALF + m * 16) * NMIX + col0;
#pragma unroll
                    for (int bj = 0; bj < 2; ++bj) store8(rowp + bj * HALF, acc[ai][bj][m][0] * rs, acc[ai][bj][m][1] * rs); }
        } else {
            const int col0 = (u.pn - NMIX / BM) * BM + wc * 32 + 8 * fq;
            f32x4 bv[2][2];
#pragma unroll
            for (int bj = 0; bj < 2; ++bj)
#pragma unroll
                for (int n = 0; n < 2; ++n) bv[bj][n] = *(const f32x4*)(gate_b + col0 + bj * HALF + 4 * n);
#pragma unroll
            for (int ai = 0; ai < 2; ++ai)
#pragma unroll
                for (int m = 0; m < 4; ++m) { const float rs = tab[wr * 64 + fr + ai * HALF + m * 16]; bf16_t* rowp = gates + (size_t)(row0 + ai * HALF + m * 16) * NGATE + col0;
#pragma unroll
                    for (int bj = 0; bj < 2; ++bj) { f32x4 v0 = acc[ai][bj][m][0] * rs + bv[bj][0], v1 = acc[ai][bj][m][1] * rs + bv[bj][1];
#pragma unroll
                        for (int j = 0; j < 4; ++j) { v0[j] = fmaxf(sigmoidf_(v0[j]), 1e-20f); v1[j] = fmaxf(sigmoidf_(v1[j]), 1e-20f); }
                        store8(rowp + bj * HALF, v0, v1); } }
        }
    }
};
template <int ACT  > struct EpiBf16 {
    static constexpr bool PERM = true, HAS_MID = false, ROWSCALE = (ACT == 1);
    bf16_t* O; int ldc; const float* ssp;
    DI void operator()(const Acc& acc, const Unit& u, int wr, int wc, int fr, int fq, ldsp lds) const {
        const int row0 = u.pm * BM + wr * 64 + fr, col0 = u.pn * BM + wc * 32 + 8 * fq; const LAS float* tab = (const LAS float*)(lds + STAGE_BYTES);
#pragma unroll
        for (int ai = 0; ai < 2; ++ai)
#pragma unroll
            for (int m = 0; m < 4; ++m) { bf16_t* rowp = O + (size_t)(row0 + ai * HALF + m * 16) * ldc + col0;
                float rs2 = 1.f; if (ACT == 1) { const float rs = tab[wr * 64 + fr + ai * HALF + m * 16]; rs2 = rs * rs; }
#pragma unroll
                for (int bj = 0; bj < 2; ++bj) { f32x4 v0 = acc[ai][bj][m][0], v1 = acc[ai][bj][m][1];
                    if (ACT == 1) {
#pragma unroll
                        for (int j = 0; j < 4; ++j) { const float a = fmaxf(v0[j], 0.f), b = fmaxf(v1[j], 0.f); v0[j] = a * a * rs2; v1[j] = b * b * rs2; } }
                    store8(rowp + bj * HALF, v0, v1); } }
    }
};
template <int RES, int OUTF> struct EpiResid {
    static constexpr bool PERM = true, HAS_MID = false, ROWSCALE = false;
    const void* resid; float* out; bf16_t* xb; float* ssp; int ldc;
    DI void operator()(const Acc& acc, const Unit& u, int wr, int wc, int fr, int fq, ldsp lds) const {
        const int row0 = u.pm * BM + wr * 64 + fr, col0 = u.pn * BM + wc * 32 + 8 * fq;
#pragma unroll
        for (int ai = 0; ai < 2; ++ai) {
            f32x4 rf[RES == 0 ? 4 : 1][2][2]; u32x4 rw[RES == 1 ? 4 : 1][2];
#pragma unroll
            for (int m = 0; m < 4; ++m) { const size_t off = (size_t)(row0 + ai * HALF + m * 16) * ldc + col0;
#pragma unroll
                for (int bj = 0; bj < 2; ++bj) {
                    if (RES == 0) { rf[RES == 0 ? m : 0][bj][0] = *(const f32x4*)((const float*)resid + off + bj * HALF); rf[RES == 0 ? m : 0][bj][1] = *(const f32x4*)((const float*)resid + off + bj * HALF + 4); }
                    else rw[RES == 1 ? m : 0][bj] = *(const u32x4*)((const bf16_t*)resid + off + bj * HALF); } }
#pragma unroll
            for (int m = 0; m < 4; ++m) { const int row = row0 + ai * HALF + m * 16; const size_t off = (size_t)row * ldc + col0; float ss = 0.f;
#pragma unroll
                for (int bj = 0; bj < 2; ++bj) { f32x4 r0, r1;
                    if (RES == 0) { r0 = rf[RES == 0 ? m : 0][bj][0]; r1 = rf[RES == 0 ? m : 0][bj][1]; }
                    else { float f[8]; unpack8(rw[RES == 1 ? m : 0][bj], f); r0 = (f32x4){f[0], f[1], f[2], f[3]}; r1 = (f32x4){f[4], f[5], f[6], f[7]}; }
                    const f32x4 o0 = r0 + acc[ai][bj][m][0], o1 = r1 + acc[ai][bj][m][1];
                    if (OUTF) { *(f32x4*)(out + off + bj * HALF) = o0; *(f32x4*)(out + off + bj * HALF + 4) = o1; }
                    else { ss += ((o0[0] * o0[0] + o0[1] * o0[1]) + (o0[2] * o0[2] + o0[3] * o0[3])) + ((o1[0] * o1[0] + o1[1] * o1[1]) + (o1[2] * o1[2] + o1[3] * o1[3])); store8(xb + off + bj * HALF, o0, o1); } }
                if (!OUTF) { ss += shx(ss, 16, fr + 16 * fq); ss += shx(ss, 32, fr + 16 * fq); if (fq == 0) ((LAS float*)(lds + STAGE_BYTES))[(wr * 64 + fr + ai * HALF + m * 16) * 4 + wc] = ss; } } }
        if (!OUTF) {
            asm volatile("s_waitcnt lgkmcnt(0)" ::: "memory"); __builtin_amdgcn_s_barrier(); asm volatile("" ::: "memory");
            const int t = 64 * (4 * wr + wc) + fr + 16 * fq;
            if (t < 256) { const f32x4 q = *(const LAS f32x4*)(lds + STAGE_BYTES + t * 16); ssp[(size_t)(u.pm * BM + t) * 8 + u.pn] = (q[0] + q[1]) + (q[2] + q[3]); }
        }
    }
};
struct EpiMerge {
    static constexpr bool PERM = true, HAS_MID = true, ROWSCALE = false;
    bf16_t* O; const bf16_t* gates; const float* ssqh;
    DI bool is_mid(int t) const { return t == 8 || t == 16 || t == 24 || t == 32; }
    DI void prep(ldsp lds, const Unit& u, int tid) const {
        if (tid < 256) { const f32x4* p = (const f32x4*)(ssqh + (size_t)(u.pm * BM + tid) * 16); const f32x4 a = p[0], b = p[1], c = p[2], d = p[3];
            const float s0 = ((a[0] + a[1]) + (a[2] + a[3])) + ((b[0] + b[1]) + (b[2] + b[3])), s1 = ((c[0] + c[1]) + (c[2] + c[3])) + ((d[0] + d[1]) + (d[2] + d[3]));
            LAS float* tab = (LAS float*)(lds + STAGE_BYTES) + 2 * tid; tab[0] = __builtin_amdgcn_rsqf(s0 * (1.f / 512.f) + EPS); tab[1] = __builtin_amdgcn_rsqf(s1 * (1.f / 512.f) + EPS); }
    }
    DI void ld8(const bf16_t* p, float (&f)[8]) const { unpack8(*(const u32x4*)p, f); }
    DI void mid(Acc& acc, const Unit& u, int t, int wr, int wc, int fr, int fq, ldsp lds) const {
        int row0 = u.pm * BM + wr * 64 + fr; asm volatile("" : "+v"(row0));
        const int col0 = u.pn * BM + wc * 32 + 8 * fq;
        const int seg = t >> 3;
        const int bnum = (seg - 1) * DM, bden = (seg > 3 ? 3 : seg) * DM;
        const unsigned m3 = (seg == 3) ? 0xffffffffu : 0u, m4 = (seg == 4) ? 0xffffffffu : 0u, one = 0x3f800000u;
        const LAS f32x2* tab = (const LAS f32x2*)(lds + STAGE_BYTES);
#pragma unroll
        for (int ai = 0; ai < 2; ++ai)
#pragma unroll
          for (int mh = 0; mh < 2; ++mh) {
            u32x4 gn[2][2], gd[2][2];
#pragma unroll
            for (int m2 = 0; m2 < 2; ++m2) { const bf16_t* gr = gates + (size_t)(row0 + ai * HALF + (2 * mh + m2) * 16) * NGATE + col0;
#pragma unroll
                for (int bj = 0; bj < 2; ++bj) { gn[m2][bj] = *(const u32x4*)(gr + bnum + bj * HALF); gd[m2][bj] = *(const u32x4*)(gr + bden + bj * HALF); } }
#pragma unroll
            for (int m2 = 0; m2 < 2; ++m2) { const int m = 2 * mh + m2; const f32x2 r = tab[wr * 64 + fr + ai * HALF + m * 16];
                const unsigned u0 = __float_as_uint(r[0]), u1 = __float_as_uint(r[1]);
                const float sa = __uint_as_float((u0 & m4) | (one & ~m4)), sb = __uint_as_float((u0 & m3) | (u1 & m4) | (one & ~(m3 | m4)));
                const float rr = sa * __builtin_amdgcn_rcpf(sb);
#pragma unroll
                for (int bj = 0; bj < 2; ++bj) { float num[8], den[8]; unpack8(gn[m2][bj], num); unpack8(gd[m2][bj], den);
#pragma unroll
                    for (int j = 0; j < 4; ++j) { acc[ai][bj][m][0][j] *= num[j] * __builtin_amdgcn_rcpf(den[j]) * rr; acc[ai][bj][m][1][j] *= num[4 + j] * __builtin_amdgcn_rcpf(den[4 + j]) * rr; } } }
            asm volatile("" ::: "memory"); }
    }
    DI void operator()(const Acc& acc, const Unit& u, int wr, int wc, int fr, int fq, ldsp lds) const {
        const int row0 = u.pm * BM + wr * 64 + fr, col0 = u.pn * BM + wc * 32 + 8 * fq;
        const LAS f32x2* tab = (const LAS f32x2*)(lds + STAGE_BYTES);
#pragma unroll
        for (int ai = 0; ai < 2; ++ai) {
            u32x4 gg[4][2];
#pragma unroll
            for (int m = 0; m < 4; ++m)
#pragma unroll
                for (int bj = 0; bj < 2; ++bj) gg[m][bj] = *(const u32x4*)(gates + (size_t)(row0 + ai * HALF + m * 16) * NGATE + 3 * DM + col0 + bj * HALF);
#pragma unroll
            for (int m = 0; m < 4; ++m) { const int row = row0 + ai * HALF + m * 16; const float r1 = tab[wr * 64 + fr + ai * HALF + m * 16][1];
#pragma unroll
                for (int bj = 0; bj < 2; ++bj) { float g[8]; unpack8(gg[m][bj], g); f32x4 v0 = acc[ai][bj][m][0], v1 = acc[ai][bj][m][1];
#pragma unroll
                    for (int j = 0; j < 4; ++j) { v0[j] *= g[j] * r1; v1[j] *= g[4 + j] * r1; }
                    store8(O + (size_t)row * DM + col0 + bj * HALF, v0, v1); } }
            asm volatile("" ::: "memory"); }
    }
};
}

struct Params {
    const float* x; const float* norm1_g; const float* w_in; const float* gate_b; const float* fox_f_b; const float* fox_qn_g; const float* fox_kn_g;
    const float* dsa_cq_g; const float* dsa_w_uq; const float* dsa_w_qidx; const float* dsa_qn_g; const float* dsa_kn_g; const float* rel_bias;
    const float* ssd_conv_w; const float* ssd_conv_b; const float* ssd_dt_bias; const float* ssd_a_log; const float* ssd_d; const float* ssd_norm_g;
    const float* w_br; const float* w_out; const float* norm2_g; const float* w_ff1; const float* w_ff2;
    float* out; unsigned char* ws;
    int ph_lo, ph_hi, rep, pad;
};
struct Ctx {
    ldsp lds; int tid, lane, wave, G, bid;
    gu32* ctl;
};
DI Ctx fresh(const Ctx& c0) { Ctx c = c0; int t = c0.tid; asm volatile("" : "+v"(t)); c.tid = t; c.lane = t & 63; c.wave = __builtin_amdgcn_readfirstlane(t >> 6); return c; }
DI Params freshp(const Params& p0) { Params p = p0; GAS unsigned char* w = (GAS unsigned char*)p0.ws; asm volatile("" : "+s"(w)); p.ws = (unsigned char*)w; return p; }
typedef __attribute__((address_space(4))) const Params* kargp;
DI Params loadp() {
#if defined(__HIP_DEVICE_COMPILE__)
    kargp k = (kargp)__builtin_amdgcn_kernarg_segment_ptr(); asm volatile("" : "+s"(k)); Params p = *k;
    GAS unsigned char* w = (GAS unsigned char*)p.ws; asm volatile("" : "+s"(w)); p.ws = (unsigned char*)w; return p;
#else
    return Params{};
#endif
}
DI bf16_t* wsb(const Params& p, size_t off) { return (bf16_t*)(p.ws + off); }
DI float*  wsf(const Params& p, size_t off) { return (float*)(p.ws + off); }

DI int next_unit(const Ctx& c, int layer, int q) {
    volatile LAS int* slot = (volatile LAS int*)(c.lds + LDS_MISC);
    __syncthreads();
    int qi = (layer * NQUEUE + q) * 64; asm volatile("" : "+s"(qi));
    if (c.tid == 0) *slot = (int)__hip_atomic_fetch_add((unsigned*)(c.ctl + CW_QUEUE + qi), 1u, __ATOMIC_RELAXED, __HIP_MEMORY_SCOPE_AGENT);
    __syncthreads();
    return *slot;
}

DI int in_dest_row(int n) {
    if (n < 3584) return n;
    if (n < 3588) return C_FF + (n - 3584);
    if (n < 4420) return n - 4;
    if (n < 4436) return C_IW + (n - 4420);
    if (n < 6996) return n - 20;
    if (n < 7012) return n - 4;
    return n + (NMIX - 7012);
}
template <int MAP>
DI void transpose_item(const float* W, int K, int N, bf16_t* WT, int ldk, int row_off, const float* kscale, LAS float* scr, int item, int lane) {
    const int nblk = (N + 63) / 64, kb = item / nblk, nb = item % nblk, k0 = 64 * kb, n0 = 64 * nb;
    const int nq = n0 + 4 * (lane & 15); const bool nok = nq < N;
    f32x4 v[16];
#pragma unroll
    for (int i = 0; i < 16; ++i) { const int kk = 4 * i + (lane >> 4); v[i] = nok ? *(const f32x4*)(W + (size_t)(k0 + kk) * N + nq) : (f32x4){0.f, 0.f, 0.f, 0.f}; }
    const int c = lane & 7;
    f32x4 s0 = {1.f, 1.f, 1.f, 1.f}, s1 = s0; if (kscale) { s0 = *(const f32x4*)(kscale + k0 + 8 * c); s1 = *(const f32x4*)(kscale + k0 + 8 * c + 4); }
#pragma unroll
    for (int i = 0; i < 16; ++i) { const int kk = 4 * i + (lane >> 4); LAS float* d = scr + kk * 65 + 4 * (lane & 15); d[0] = v[i][0]; d[1] = v[i][1]; d[2] = v[i][2]; d[3] = v[i][3]; }
    asm volatile("s_waitcnt lgkmcnt(0)" ::: "memory");
#pragma unroll
    for (int j = 0; j < 8; ++j) { const int n = (lane >> 3) + 8 * j; const LAS float* s = scr + (8 * c) * 65 + n;
        u32x4 o; o.x = pk2(s[0 * 65] * s0[0], s[1 * 65] * s0[1]); o.y = pk2(s[2 * 65] * s0[2], s[3 * 65] * s0[3]); o.z = pk2(s[4 * 65] * s1[0], s[5 * 65] * s1[1]); o.w = pk2(s[6 * 65] * s1[2], s[7 * 65] * s1[3]);
        if (n0 + n < N) { const int dr = MAP ? in_dest_row(n0 + n) : row_off + n0 + n; *(u32x4*)(WT + (size_t)dr * ldk + k0 + 8 * c) = o; } }
    asm volatile("s_waitcnt lgkmcnt(0)" ::: "memory");
}
constexpr int I_IN = (DM / 64) * ((IN_TOTAL + 63) / 64), I_UQ = (KUP / 64) * (512 / 64), I_QI = (KUP / 64) * (1024 / 64), I_BR = (KBR / 64) * (DM / 64),
              I_OUT = (DM / 64) * (DM / 64), I_F1 = (DM / 64) * (DFF / 64), I_F2 = (DFF / 64) * (DM / 64), PER_LAYER = I_IN + I_UQ + I_QI + I_BR + I_OUT + I_F1 + I_F2;
DI void convert_items(const Params& p0, const Ctx& c0, int l, int lo, int hi, int wv, int nw) {
    const Ctx c = fresh(c0); const Params p = freshp(p0);
    LAS float* scr = (LAS float*)(c.lds + c.wave * 16640);
    unsigned char* wl = p.ws + WS_W + (size_t)l * WL_SIZE;
    for (int it = lo + wv; it < hi; it += nw) {
        int r = it;
        if (r < I_IN) { transpose_item<1>(p.w_in + (size_t)l * DM * IN_TOTAL, DM, IN_TOTAL, (bf16_t*)(wl + WL_IN), DM, 0, p.norm1_g + l * DM, scr, r, c.lane); continue; } r -= I_IN;
        if (r < I_UQ) { transpose_item<0>(p.dsa_w_uq + (size_t)l * KUP * 512, KUP, 512, (bf16_t*)(wl + WL_UP), KUP, 0, p.dsa_cq_g + l * KUP, scr, r, c.lane); continue; } r -= I_UQ;
        if (r < I_QI) { transpose_item<0>(p.dsa_w_qidx + (size_t)l * KUP * 1024, KUP, 1024, (bf16_t*)(wl + WL_UP), KUP, 512, p.dsa_cq_g + l * KUP, scr, r, c.lane); continue; } r -= I_QI;
        if (r < I_BR) { transpose_item<0>(p.w_br + (size_t)l * KBR * DM, KBR, DM, (bf16_t*)(wl + WL_BR), KBR, 0, nullptr, scr, r, c.lane); continue; } r -= I_BR;
        if (r < I_OUT) { transpose_item<0>(p.w_out + (size_t)l * DM * DM, DM, DM, (bf16_t*)(wl + WL_OUT), DM, 0, nullptr, scr, r, c.lane); continue; } r -= I_OUT;
        if (r < I_F1) { transpose_item<0>(p.w_ff1 + (size_t)l * DM * DFF, DM, DFF, (bf16_t*)(wl + WL_FF1), DM, 0, p.norm2_g + l * DM, scr, r, c.lane); continue; } r -= I_F1;
        transpose_item<0>(p.w_ff2 + (size_t)l * DFF * DM, DFF, DM, (bf16_t*)(wl + WL_FF2), DFF, 0, nullptr, scr, r, c.lane);
    }
}
constexpr int CV_B = 3072;
DI void convert_on_idle(const Params& p, const Ctx& c, int l, int lo, int hi, int nunits) {
    const int first_idle = nunits % c.G;
    if (first_idle == 0) convert_items(p, c, l, lo, hi, c.bid * 8 + c.wave, c.G * 8);
    else if (c.bid >= first_idle) convert_items(p, c, l, lo, hi, (c.bid - first_idle) * 8 + c.wave, (c.G - first_idle) * 8);
}
DI void p0_prologue(const Params& p0, const Ctx& c0) {
    const Ctx c = fresh(c0); const Params p = freshp(p0);
    convert_items(p, c, 0, 0, I_IN, c.bid * 8 + c.wave, c.G * 8);
    constexpr int PADROWS = NMIX - C_MIXEND, CH = DM / 8;
    for (int i = (c.bid * 512 + c.tid); i < DEPTH * PADROWS * CH; i += c.G * 512) { const int l = i / (PADROWS * CH), r = (i / CH) % PADROWS, ch = i % CH;
        *(u32x4*)((bf16_t*)(p.ws + WS_W + (size_t)l * WL_SIZE + WL_IN) + (size_t)(C_MIXEND + r) * DM + ch * 8) = (u32x4){0u, 0u, 0u, 0u}; }
}

DI float wave_sum(float v, int lane) {
#pragma unroll
    for (int o = 1; o < 64; o <<= 1) v += shx(v, o, lane);
    return v;
}
DI void xprep_phase(const Ctx& c0, const float* x, bf16_t* xb, float* ssp) {
    const Ctx c = fresh(c0);
    const int gw = c.bid * 8 + c.wave, NGW = c.G * 8;
    for (int m = gw; m < MTOK; m += NGW) {
        const f32x4* xr = (const f32x4*)(x + (size_t)m * DM) + c.lane;
        f32x4 v[8]; float s = 0.f;
#pragma unroll
        for (int j = 0; j < 8; ++j) { v[j] = xr[64 * j]; s += (v[j][0] * v[j][0] + v[j][1] * v[j][1]) + (v[j][2] * v[j][2] + v[j][3] * v[j][3]); }
        s = wave_sum(s, c.lane);
        u32x2* o = (u32x2*)(xb + (size_t)m * DM) + c.lane;
#pragma unroll
        for (int j = 0; j < 8; ++j) { u32x2 w; w.x = pk2(v[j][0], v[j][1]); w.y = pk2(v[j][2], v[j][3]); o[64 * j] = w; }
        if (c.lane < 8) ssp[(size_t)m * 8 + c.lane] = (c.lane == 0) ? s : 0.f;
    }
}

DI void scan_phase(const Params& p0, const Ctx& c0) {
    const Ctx c = fresh(c0); const Params p = freshp(p0);
    const float* kvs = wsf(p, WS_KVS); bf16_t* prevr = wsb(p, WS_PREVR); const float* st = wsf(p, WS_ST); bf16_t* prevs = wsb(p, WS_PREVS); const float* acs = wsf(p, WS_ACS);
    const int gt = c.bid * 512 + c.tid, NT = c.G * 512;
    for (int e = gt; e < 16 * 4096; e += NT) {
        const int bh = e / 4096, q = e % 4096, h = bh & 3;
        const float cd = __expf(128.f * log1pf(-exp2f(-5.f - (float)h)));
        f32x4 kv[16];
#pragma unroll
        for (int n = 0; n < 16; ++n) kv[n] = *(const f32x4*)(kvs + ((size_t)(bh * 16 + n) * 16384) + (size_t)q * 4);
        f32x4 s = {0.f, 0.f, 0.f, 0.f};
#pragma unroll
        for (int n = 0; n < 16; ++n) { const size_t o = ((size_t)(bh * 16 + n) * 16384) + (size_t)q * 4;
            u32x2 w; w.x = pk2(s[0], s[1]); w.y = pk2(s[2], s[3]); *(u32x2*)(prevr + o) = w; s = s * cd + kv[n]; }
    }
    for (int e = gt; e < 64 * 2048; e += NT) {
        const int bhd = e / 2048, q = e % 2048, b = bhd >> 4, hd = bhd & 15;
        f32x4 v[16]; float cd[16];
#pragma unroll
        for (int n = 0; n < 16; ++n) { v[n] = *(const f32x4*)(st + ((size_t)((b * 16 + n) * 16 + hd) * 8192) + (size_t)q * 4); cd[n] = acs[(size_t)(b * SEQ + 128 * n + 127) * 16 + hd]; }
        f32x4 s = {0.f, 0.f, 0.f, 0.f};
#pragma unroll
        for (int n = 0; n < 16; ++n) { const size_t o = ((size_t)((b * 16 + n) * 16 + hd) * 8192) + (size_t)q * 4;
            u32x2 w; w.x = pk2(s[0], s[1]); w.y = pk2(s[2], s[3]); *(u32x2*)(prevs + o) = w; s = s * __expf(cd[n]) + v[n]; }
    }
}

struct LaneIds { int r, h, blk, q, pp; };
DI LaneIds lane_ids(int lane) { LaneIds L; L.r = lane & 31; L.h = lane >> 5; L.blk = (lane >> 4) & 1; L.q = (lane & 15) >> 2; L.pp = lane & 3; return L; }
DI int tr_nat_off(const LaneIds& L, int st) { return (8 * L.h + L.q) * st + 32 * L.blk + 8 * L.pp; }
DI int tr_krow_off(const LaneIds& L, int st) { return (4 * L.h + L.q) * st + 32 * L.blk + 8 * L.pp; }
DI bf16x8 pack_half(const f32x16& x, int s) { return pack8(x[8 * s], x[8 * s + 1], x[8 * s + 2], x[8 * s + 3], x[8 * s + 4], x[8 * s + 5], x[8 * s + 6], x[8 * s + 7]); }
DI float softplusf_(float x) { return x > 20.f ? x : log1pf(__expf(x)); }

DI void ssdst_unit(const Params& p0, const Ctx& c0, int layer, int u) {
    const Ctx c = fresh(c0); const Params p = freshp(p0);
    const int b = u >> 6, n = (u >> 2) & 15, g = (u >> 1) & 1, half = u & 1, T0 = b * SEQ + 128 * n;
    const bf16_t* mix = wsb(p, WS_MIX); bf16_t* xbcc = wsb(p, WS_XBCC); float* acsg = wsf(p, WS_ACS); float* bsg = wsf(p, WS_BS); float* stg = wsf(p, WS_ST);
    ldsp Xt = c.lds, Bt = c.lds + 73728; LAS float* sdec = (LAS float*)(c.lds + 73728 + 40960);
    const LaneIds L = lane_ids(c.lane);
    if (c.wave < 4) {
        const int hd = g * 8 + half * 4 + c.wave; const float dtb = p.ssd_dt_bias[layer * 16 + hd], A = -__expf(p.ssd_a_log[layer * 16 + hd]);
        const int l0 = 2 * c.lane;
        const float dt0 = softplusf_(bf2f(mix[(size_t)(T0 + l0) * NMIX + C_SDT + hd]) + dtb), dt1 = softplusf_(bf2f(mix[(size_t)(T0 + l0 + 1) * NMIX + C_SDT + hd]) + dtb);
        const float a0 = dt0 * A, a1 = dt1 * A; float s = a0 + a1;
#pragma unroll
        for (int o = 1; o < 64; o <<= 1) { const float t = shidx(s, c.lane - o); if (c.lane >= o) s += t; }
        const float c1 = s, c0 = s - a1, last = shidx(s, 63);
        acsg[(size_t)(T0 + l0) * 16 + hd] = c0; acsg[(size_t)(T0 + l0 + 1) * 16 + hd] = c1;
        bsg[(size_t)(T0 + l0) * 16 + hd] = -c0 + __logf(dt0); bsg[(size_t)(T0 + l0 + 1) * 16 + hd] = -c1 + __logf(dt1);
        sdec[c.wave * 128 + l0] = dt0 * __expf(last - c0); sdec[c.wave * 128 + l0 + 1] = dt1 * __expf(last - c1);
    }
    __syncthreads();
    const int NCH = half ? 64 : 48;
    const float* cw = p.ssd_conv_w + (size_t)layer * 4 * 1536; const float* cb = p.ssd_conv_b + (size_t)layer * 1536;
    {
        const int cc = c.lane, l0 = 16 * c.wave;
        if (cc < NCH) {
            int ch; if (cc < 32) ch = g * 512 + half * 256 + 8 * cc; else if (cc < 48) ch = 1024 + g * 128 + 8 * (cc - 32); else ch = 1280 + g * 128 + 8 * (cc - 48);
            const int mcol = C_SX + ch;
            u32x4 xr[19];
#pragma unroll
            for (int i = 0; i < 19; ++i) { const int tl = 128 * n + l0 - 3 + i; xr[i] = (tl >= 0) ? *(const u32x4*)(mix + (size_t)(b * SEQ + tl) * NMIX + mcol) : (u32x4){0u, 0u, 0u, 0u}; }
            float w[4][8], bs8[8];
#pragma unroll
            for (int j = 0; j < 4; ++j) { const f32x4 w0 = *(const f32x4*)(cw + j * 1536 + ch), w1 = *(const f32x4*)(cw + j * 1536 + ch + 4);
                w[j][0] = w0[0]; w[j][1] = w0[1]; w[j][2] = w0[2]; w[j][3] = w0[3]; w[j][4] = w1[0]; w[j][5] = w1[1]; w[j][6] = w1[2]; w[j][7] = w1[3]; }
            { const f32x4 b0 = *(const f32x4*)(cb + ch), b1 = *(const f32x4*)(cb + ch + 4); bs8[0] = b0[0]; bs8[1] = b0[1]; bs8[2] = b0[2]; bs8[3] = b0[3]; bs8[4] = b1[0]; bs8[5] = b1[1]; bs8[6] = b1[2]; bs8[7] = b1[3]; }
#pragma unroll
            for (int i = 0; i < 16; ++i) { const int l = l0 + i; float a[8];
#pragma unroll
                for (int e = 0; e < 8; ++e) a[e] = bs8[e];
#pragma unroll
                for (int j = 0; j < 4; ++j) { float xv[8]; unpack8(xr[i + j], xv);
#pragma unroll
                    for (int e = 0; e < 8; ++e) a[e] += w[j][e] * xv[e]; }
#pragma unroll
                for (int e = 0; e < 8; ++e) a[e] = siluf_(a[e]);
                const bf16x8 v = pack8(a[0], a[1], a[2], a[3], a[4], a[5], a[6], a[7]);
                if (cc < 32) { *(bf16x8*)(xbcc + (size_t)(T0 + l) * 1536 + ch) = v; const float sc = sdec[(cc >> 3) * 128 + l];
                    *(LAS bf16x8*)(Xt + l * 576 + cc * 16) = pack8(a[0] * sc, a[1] * sc, a[2] * sc, a[3] * sc, a[4] * sc, a[5] * sc, a[6] * sc, a[7] * sc); }
                else if (cc < 48) { if (half == 0) *(bf16x8*)(xbcc + (size_t)(T0 + l) * 1536 + ch) = v; *(LAS bf16x8*)(Bt + l * 320 + (cc - 32) * 16) = v; }
                else *(bf16x8*)(xbcc + (size_t)(T0 + l) * 1536 + ch) = v;
            }
        }
    }
    __syncthreads();
    {
        const int hq = c.wave & 3, kh = c.wave >> 2, hd = g * 8 + half * 4 + hq;
        f32x16 acc[2][2]; for (int i = 0; i < 2; ++i) for (int j = 0; j < 2; ++j) acc[i][j] = zero16();
        ldsp xa = Xt + tr_nat_off(L, 576) + hq * 128, ba = Bt + tr_nat_off(L, 320) + kh * 128;
#pragma unroll
        for (int ks = 0; ks < 8; ++ks) {
            bf16x8 A[2], Bf[2];
#pragma unroll
            for (int t = 0; t < 2; ++t) { A[t] = tr_pair(xa + ks * 16 * 576 + t * 64, 4 * 576); Bf[t] = tr_pair(ba + ks * 16 * 320 + t * 64, 4 * 320); }
#pragma unroll
            for (int pt = 0; pt < 2; ++pt)
#pragma unroll
                for (int kt = 0; kt < 2; ++kt) acc[pt][kt] = MFMA32(A[pt], Bf[kt], acc[pt][kt]);
        }
        float* o = stg + (size_t)((b * 16 + n) * 16 + hd) * 8192;
#pragma unroll
        for (int pt = 0; pt < 2; ++pt)
#pragma unroll
            for (int kt = 0; kt < 2; ++kt)
#pragma unroll
                for (int i = 0; i < 16; ++i) o[(32 * pt + crow(i, L.h)) * 128 + kh * 64 + 32 * kt + L.r] = acc[pt][kt][i];
    }
}
DI void ssdo_unit(const Params& p0, const Ctx& c0, int layer, int u) {
    const Ctx c = fresh(c0); const Params p = freshp(p0);
    const int b = u >> 6, n = (u >> 2) & 15, g = (u >> 1) & 1, half = u & 1, T0 = b * SEQ + 128 * n;
    const bf16_t* mix = wsb(p, WS_MIX); const bf16_t* xbcc = wsb(p, WS_XBCC); const float* acsg = wsf(p, WS_ACS); const float* bsg = wsf(p, WS_BS);
    const bf16_t* prevs = wsb(p, WS_PREVS); bf16_t* oall = wsb(p, WS_OALL); float* ssqh = wsf(p, WS_SSQH);
    ldsp XS = c.lds, BC = c.lds + 73728; LAS float* tacs = (LAS float*)(c.lds + 73728 + 34816); LAS float* tbs = tacs + 512;
    const LaneIds L = lane_ids(c.lane);
    const int hq = c.wave & 3, pr = c.wave >> 2, hd = g * 8 + half * 4 + hq;
    const bf16_t* prv = prevs + (size_t)((b * 16 + n) * 16 + hd) * 8192;
    u32x4 xs8[8], bc4[4];
#pragma unroll
    for (int i = 0; i < 8; ++i) { const int it = c.tid + 512 * i, l = it >> 5, cc = it & 31; xs8[i] = *(const u32x4*)(xbcc + (size_t)(T0 + l) * 1536 + g * 512 + half * 256 + 8 * cc); }
#pragma unroll
    for (int i = 0; i < 4; ++i) { const int it = c.tid + 512 * i, l = it >> 4, cc = it & 15; bc4[i] = *(const u32x4*)(xbcc + (size_t)(T0 + l) * 1536 + 1024 + g * 128 + 8 * cc); }
    const float ta = acsg[(size_t)(T0 + (c.tid & 127)) * 16 + g * 8 + half * 4 + (c.tid >> 7)], tb = bsg[(size_t)(T0 + (c.tid & 127)) * 16 + g * 8 + half * 4 + (c.tid >> 7)];
    bf16x8 Ap[2][8];
#pragma unroll
    for (int pt = 0; pt < 2; ++pt)
#pragma unroll
        for (int ks = 0; ks < 8; ++ks) Ap[pt][ks] = *(const bf16x8*)(prv + (32 * pt + L.r) * 128 + 16 * ks + 8 * L.h);
#pragma unroll
    for (int i = 0; i < 8; ++i) { const int it = c.tid + 512 * i, l = it >> 5, cc = it & 31; *(LAS u32x4*)(XS + l * 576 + cc * 16) = xs8[i]; }
#pragma unroll
    for (int i = 0; i < 4; ++i) { const int it = c.tid + 512 * i, l = it >> 4, cc = it & 15; *(LAS u32x4*)(BC + l * 272 + cc * 16) = bc4[i]; }
    tacs[c.tid] = ta; tbs[c.tid] = tb;
    __syncthreads();
    const float Dsk = p.ssd_d[layer * 16 + hd];
    const float* ng = p.ssd_norm_g + (size_t)layer * 1024 + g * 512 + half * 256 + hq * 64;
#pragma unroll
    for (int li = 0; li < 2; ++li) {
        const int lt = pr == 0 ? (li == 0 ? 0 : 3) : (li == 0 ? 1 : 2);
        const int l = 32 * lt + L.r; const size_t tok = (size_t)(T0 + l);
        bf16x8 Cf[8];
#pragma unroll
        for (int ks = 0; ks < 8; ++ks) Cf[ks] = *(const bf16x8*)(xbcc + tok * 1536 + 1280 + g * 128 + 16 * ks + 8 * L.h);
        u32x2 zw8[2][4];
#pragma unroll
        for (int pt = 0; pt < 2; ++pt)
#pragma unroll
            for (int gq = 0; gq < 4; ++gq) zw8[pt][gq] = *(const u32x2*)(mix + tok * NMIX + C_SZ + g * 512 + half * 256 + hq * 64 + 32 * pt + 8 * gq + 4 * L.h);
        f32x16 O[2]; O[0] = zero16(); O[1] = zero16();
#pragma unroll
        for (int pt = 0; pt < 2; ++pt)
#pragma unroll
            for (int ks = 0; ks < 8; ++ks) { O[pt] = MFMA32(Ap[pt][ks], Cf[ks], O[pt]); }

        const float acl = tacs[hq * 128 + l], eA = __expf(acl);
#pragma unroll
        for (int pt = 0; pt < 2; ++pt)
#pragma unroll
            for (int i = 0; i < 16; ++i) O[pt][i] *= eA;
#pragma unroll 1
        for (int st = 0; st <= lt; ++st) {
            f32x16 mt = zero16();
#pragma unroll
            for (int ks = 0; ks < 8; ++ks) { const bf16x8 A = *(const LAS bf16x8*)(BC + (32 * st + L.r) * 272 + (16 * ks + 8 * L.h) * 2); mt = MFMA32(A, Cf[ks], mt); }
#pragma unroll
            for (int gq = 0; gq < 4; ++gq) { const f32x4 bv = *(const LAS f32x4*)(tbs + hq * 128 + 32 * st + 8 * gq + 4 * L.h);
#pragma unroll
                for (int e = 0; e < 4; ++e) { const int s = 32 * st + 8 * gq + 4 * L.h + e; const float w = __expf(acl + bv[e]); mt[4 * gq + e] = (l >= s) ? mt[4 * gq + e] * w : 0.f; } }
            const bf16x8 pk0 = pack_half(mt, 0), pk1 = pack_half(mt, 1);
            ldsp xa = XS + tr_krow_off(L, 576) + (32 * st) * 576 + hq * 128;
#pragma unroll
            for (int pt = 0; pt < 2; ++pt) { O[pt] = MFMA32(tr_pair(xa + pt * 64, 8 * 576), pk0, O[pt]); O[pt] = MFMA32(tr_pair(xa + 16 * 576 + pt * 64, 8 * 576), pk1, O[pt]); }
        }
        float ssq = 0.f;
#pragma unroll
        for (int pt = 0; pt < 2; ++pt) { u32x2 w4[4];
#pragma unroll
            for (int gq = 0; gq < 4; ++gq) { const int pch = 32 * pt + 8 * gq + 4 * L.h;
                const u32x2 xw = *(const LAS u32x2*)(XS + l * 576 + (hq * 64 + pch) * 2);
                const u32x2 zw = zw8[pt][gq];
                const f32x4 gn = *(const f32x4*)(ng + pch);
                const float xv[4] = {bflo(xw.x), bfhi(xw.x), bflo(xw.y), bfhi(xw.y)}, zv[4] = {bflo(zw.x), bfhi(zw.x), bflo(zw.y), bfhi(zw.y)};
                float o[4];
#pragma unroll
                for (int e = 0; e < 4; ++e) { const float y = O[pt][4 * gq + e] + Dsk * xv[e]; const float gt = y * siluf_(zv[e]); ssq += gt * gt; o[e] = gt * gn[e]; }
                w4[gq].x = pk2(o[0], o[1]); w4[gq].y = pk2(o[2], o[3]); }
            bf16_t* rowp = oall + tok * KBR + O_SSD + g * 512 + half * 256 + hq * 64 + 32 * pt;
            store_pair_t21(rowp, 0, w4[0], w4[1], L.h); store_pair_t21(rowp, 2, w4[2], w4[3], L.h); }
        ssq += shx(ssq, 32, c.lane);
        if (L.h == 0) ssqh[tok * 16 + hd] = ssq;
    }
}

DI float ret_loggamma(int h) { return log1pf(-exp2f(-5.f - (float)h)); }
struct RetKV { u32x4 ka[2], kb[2], v[4]; };
DI void ret_load_kv(RetKV& r, const Ctx& c, const bf16_t* mix, int T0, int h) {
#pragma unroll
    for (int i = 0; i < 2; ++i) { const int it = c.tid + 512 * i, j = it >> 3, cc = it & 7; const bf16_t* row = mix + (size_t)(T0 + j) * NMIX + C_RK + h * 128;
        r.ka[i] = *(const u32x4*)(row + 8 * cc); r.kb[i] = *(const u32x4*)(row + 64 + 8 * cc); }
#pragma unroll
    for (int i = 0; i < 4; ++i) { const int it = c.tid + 512 * i, j = it >> 4, cc = it & 15; r.v[i] = *(const u32x4*)(mix + (size_t)(T0 + j) * NMIX + C_RV + h * 128 + 8 * cc); }
}
DI void ret_write_kv(const RetKV& r, const Ctx& c, int n, int h, ldsp Kt, int st, bool with_decay, ldsp Vt) {
    const float lg = ret_loggamma(h);
#pragma unroll
    for (int i = 0; i < 2; ++i) {
        const int it = c.tid + 512 * i, j = it >> 3, cc = it & 7; float x1[8], x2[8]; unpack8(r.ka[i], x1); unpack8(r.kb[i], x2);
        const float sc = 0.08838834764831845f * (with_decay ? __expf(lg * (float)(127 - j)) : 1.f), pos = (float)(128 * n + j);
        float o1[8], o2[8];
#pragma unroll
        for (int e = 0; e < 8; ++e) { const float inv = __builtin_amdgcn_exp2f(-(float)(8 * cc + e) * 0.20762050593046014f); const float ang = __fmul_rn(pos, inv); float rev = ang * 0.15915494309189535f; rev = __builtin_amdgcn_fractf(rev);
            const float sn = __builtin_amdgcn_sinf(rev), cs = __builtin_amdgcn_cosf(rev); o1[e] = (x1[e] * cs - x2[e] * sn) * sc; o2[e] = (x1[e] * sn + x2[e] * cs) * sc; }
        *(LAS bf16x8*)(Kt + j * st + cc * 16) = pack8(o1[0], o1[1], o1[2], o1[3], o1[4], o1[5], o1[6], o1[7]);
        *(LAS bf16x8*)(Kt + j * st + 128 + cc * 16) = pack8(o2[0], o2[1], o2[2], o2[3], o2[4], o2[5], o2[6], o2[7]);
    }
#pragma unroll
    for (int i = 0; i < 4; ++i) { const int it = c.tid + 512 * i, j = it >> 4, cc = it & 15; *(LAS u32x4*)(Vt + j * 320 + cc * 16) = r.v[i]; }
}
DI void retkv_unit(const Params& p0, const Ctx& c0, int u) {
    const Ctx c = fresh(c0); const Params p = freshp(p0);
    const int b = u >> 6, h = (u >> 4) & 3, n = u & 15, T0 = b * SEQ + 128 * n;
    const bf16_t* mix = wsb(p, WS_MIX); float* kvs = wsf(p, WS_KVS) + (size_t)u * 16384;
    ldsp Kt = c.lds, Vt = c.lds + 40960; const LaneIds L = lane_ids(c.lane);
    { RetKV r; ret_load_kv(r, c, mix, T0, h); ret_write_kv(r, c, n, h, Kt, 320, true, Vt); }
    __syncthreads();
    const int rt = c.wave >> 1, chh = c.wave & 1;
    f32x16 acc[2]; acc[0] = zero16(); acc[1] = zero16();
    ldsp va = Vt + tr_nat_off(L, 320) + rt * 64, ka = Kt + tr_nat_off(L, 320) + chh * 128;
#pragma unroll
    for (int ks = 0; ks < 8; ++ks) { const bf16x8 A = tr_pair(va + ks * 16 * 320, 4 * 320);
#pragma unroll
        for (int t = 0; t < 2; ++t) acc[t] = MFMA32(A, tr_pair(ka + ks * 16 * 320 + t * 64, 4 * 320), acc[t]); }
#pragma unroll
    for (int t = 0; t < 2; ++t)
#pragma unroll
        for (int i = 0; i < 16; ++i) kvs[(32 * rt + crow(i, L.h)) * 128 + chh * 64 + 32 * t + L.r] = acc[t][i];
}
DI void reto_unit(const Params& p0, const Ctx& c0, int u) {
    const Ctx c = fresh(c0); const Params p = freshp(p0);
    const int b = u >> 6, h = (u >> 4) & 3, n = u & 15, T0 = b * SEQ + 128 * n;
    const bf16_t* mix = wsb(p, WS_MIX); const bf16_t* prv = wsb(p, WS_PREVR) + (size_t)u * 16384; bf16_t* oall = wsb(p, WS_OALL);
    ldsp Kt = c.lds, Vt = c.lds + 34816; LAS float* exch = (LAS float*)(c.lds + 34816 + 40960); const LaneIds L = lane_ids(c.lane);
    const int qg = c.wave & 3, dvh = c.wave >> 2, il = 32 * qg + L.r; const size_t tok = (size_t)(T0 + il);
    const float lg = ret_loggamma(h);
    RetKV rkv; ret_load_kv(rkv, c, mix, T0, h);
    u32x4 qraw[8]; { const bf16_t* row = mix + tok * NMIX + C_RQ + h * 128;
#pragma unroll
      for (int s = 0; s < 4; ++s) { qraw[s] = *(const u32x4*)(row + 16 * s + 8 * L.h); qraw[s + 4] = *(const u32x4*)(row + 64 + 16 * s + 8 * L.h); } }
    bf16x8 Ap[2][8];
#pragma unroll
    for (int dl = 0; dl < 2; ++dl)
#pragma unroll
        for (int s = 0; s < 8; ++s) Ap[dl][s] = *(const bf16x8*)(prv + (32 * (2 * dvh + dl) + L.r) * 128 + 16 * s + 8 * L.h);
    u32x2 gwv[2][4];
#pragma unroll
    for (int dl = 0; dl < 2; ++dl)
#pragma unroll
        for (int gq = 0; gq < 4; ++gq) gwv[dl][gq] = *(const u32x2*)(mix + tok * NMIX + C_RG + h * 128 + 32 * (2 * dvh + dl) + 8 * gq + 4 * L.h);
    ret_write_kv(rkv, c, n, h, Kt, 272, false, Vt);
    bf16x8 Qf[8];
    { const float pos = (float)(128 * n + il);
#pragma unroll
      for (int s = 0; s < 4; ++s) { float x1[8], x2[8], o1[8], o2[8]; unpack8(qraw[s], x1); unpack8(qraw[s + 4], x2);
#pragma unroll
          for (int e = 0; e < 8; ++e) { const float inv = __builtin_amdgcn_exp2f(-(float)(16 * s + 8 * L.h + e) * 0.20762050593046014f); const float ang = __fmul_rn(pos, inv); float rev = ang * 0.15915494309189535f; rev = __builtin_amdgcn_fractf(rev);
              const float sn = __builtin_amdgcn_sinf(rev), cs = __builtin_amdgcn_cosf(rev); o1[e] = x1[e] * cs - x2[e] * sn; o2[e] = x1[e] * sn + x2[e] * cs; }
          Qf[s] = pack8(o1[0], o1[1], o1[2], o1[3], o1[4], o1[5], o1[6], o1[7]); Qf[s + 4] = pack8(o2[0], o2[1], o2[2], o2[3], o2[4], o2[5], o2[6], o2[7]); } }
    f32x16 O[2]; O[0] = zero16(); O[1] = zero16();
#pragma unroll
    for (int dl = 0; dl < 2; ++dl)
#pragma unroll
        for (int s = 0; s < 8; ++s) { O[dl] = MFMA32(Ap[dl][s], Qf[s], O[dl]); }

    { const float qd = __expf(lg * (float)(il + 1));
#pragma unroll
      for (int dl = 0; dl < 2; ++dl)
#pragma unroll
          for (int i = 0; i < 16; ++i) O[dl][i] *= qd; }
    __syncthreads();
#pragma unroll 1
    for (int rt = 0; rt <= qg; ++rt) {
        f32x16 st = zero16();
#pragma unroll
        for (int s = 0; s < 8; ++s) { const bf16x8 A = *(const LAS bf16x8*)(Kt + (32 * rt + L.r) * 272 + (16 * s + 8 * L.h) * 2); st = MFMA32(A, Qf[s], st); }
#pragma unroll
        for (int i = 0; i < 16; ++i) { const int j = 32 * rt + crow(i, L.h); st[i] = (il >= j) ? st[i] * __expf(lg * (float)(il - j)) : 0.f; }
        const bf16x8 pk0 = pack_half(st, 0), pk1 = pack_half(st, 1);
        ldsp va = Vt + tr_krow_off(L, 320) + (32 * rt) * 320 + dvh * 128;
#pragma unroll
        for (int dl = 0; dl < 2; ++dl) { O[dl] = MFMA32(tr_pair(va + dl * 64, 8 * 320), pk0, O[dl]); O[dl] = MFMA32(tr_pair(va + 16 * 320 + dl * 64, 8 * 320), pk1, O[dl]); }
    }
    float s1 = 0.f, s2 = 0.f;
#pragma unroll
    for (int dl = 0; dl < 2; ++dl)
#pragma unroll
        for (int i = 0; i < 16; ++i) { s1 += O[dl][i]; s2 += O[dl][i] * O[dl][i]; }
    s1 += shx(s1, 32, c.lane); s2 += shx(s2, 32, c.lane);
    if (L.h == 0) { exch[(dvh * 128 + il) * 2] = s1; exch[(dvh * 128 + il) * 2 + 1] = s2; }
    __syncthreads();
    const float t1 = exch[il * 2] + exch[(128 + il) * 2], t2 = exch[il * 2 + 1] + exch[(128 + il) * 2 + 1];
    const float mean = t1 * (1.f / 128.f), var = fmaxf(t2 * (1.f / 128.f) - mean * mean, 0.f), rstd = __builtin_amdgcn_rsqf(var + EPS);
#pragma unroll
    for (int dl = 0; dl < 2; ++dl) { u32x2 w4[4];
#pragma unroll
        for (int gq = 0; gq < 4; ++gq) { const u32x2 gw = gwv[dl][gq]; const float gv[4] = {bflo(gw.x), bfhi(gw.x), bflo(gw.y), bfhi(gw.y)}; float o[4];
#pragma unroll
            for (int e = 0; e < 4; ++e) o[e] = siluf_(gv[e]) * (O[dl][4 * gq + e] - mean) * rstd;
            w4[gq].x = pk2(o[0], o[1]); w4[gq].y = pk2(o[2], o[3]); }
        bf16_t* rowp = oall + tok * KBR + O_RET + h * 128 + 32 * (2 * dvh + dl);
        store_pair_t21(rowp, 0, w4[0], w4[1], L.h); store_pair_t21(rowp, 2, w4[2], w4[3], L.h); }
}

constexpr int KT_PITCH = 272, VT_PITCH = 320, KT_BYTES = 64 * KT_PITCH, VT_BYTES = 64 * VT_PITCH;
struct KvStage { u32x4 k[2], v[2]; };
DI void kv_load(KvStage& s, const bf16_t* kbase, int kp, const bf16_t* vbase, int vp, int row0, int tid) {
    const int key = tid >> 3, cp = tid & 7; const size_t rk = (size_t)(row0 + key) * kp, rv = (size_t)(row0 + key) * vp;
    s.k[0] = *(const u32x4*)(kbase + rk + 8 * cp); s.k[1] = *(const u32x4*)(kbase + rk + 64 + 8 * cp);
    s.v[0] = *(const u32x4*)(vbase + rv + 8 * cp); s.v[1] = *(const u32x4*)(vbase + rv + 64 + 8 * cp);
}
DI void kv_write(const KvStage& s, ldsp Kt, ldsp Vt, int tid) {
    const int key = tid >> 3, cp = tid & 7;
    *(LAS u32x4*)(Kt + key * KT_PITCH + cp * 16) = s.k[0]; *(LAS u32x4*)(Kt + key * KT_PITCH + 128 + cp * 16) = s.k[1];
    *(LAS u32x4*)(Vt + key * VT_PITCH + cp * 16) = s.v[0]; *(LAS u32x4*)(Vt + key * VT_PITCH + 128 + cp * 16) = s.v[1];
}
struct AttnState { f32x16 O[4]; float m, l; };
DI void attn_qk(f32x16 (&st)[2], ldsp Kt, const bf16x8 (&Qf)[8], const LaneIds& L) {
    st[0] = zero16(); st[1] = zero16();
#pragma unroll
    for (int rt = 0; rt < 2; ++rt)
#pragma unroll
        for (int s = 0; s < 8; ++s) st[rt] = MFMA32(*(const LAS bf16x8*)(Kt + (32 * rt + L.r) * KT_PITCH + (16 * s + 8 * L.h) * 2), Qf[s], st[rt]);
}
template <bool MASKW>
DI void attn_softmax_pv(AttnState& A, f32x16 (&st)[2], ldsp Vt, const LaneIds& L, unsigned mw0 = 0u, unsigned mw1 = 0u) {
    float mx = st[0][0];
#pragma unroll
    for (int rt = 0; rt < 2; ++rt)
#pragma unroll
        for (int i = 0; i < 16; ++i) mx = fmaxf(mx, st[rt][i]);
    mx = fmaxf(mx, shx(mx, 32, L.r + 32 * L.h));
    const float mn = fmaxf(A.m, mx);
    float rs = 0.f;
#pragma unroll
    for (int rt = 0; rt < 2; ++rt)
#pragma unroll
        for (int i = 0; i < 16; ++i) { float pv = __builtin_amdgcn_exp2f(st[rt][i] - mn);
            if (MASKW) { const int cr_ = (i & 3) + 8 * (i >> 2); pv = __uint_as_float(__float_as_uint(pv) & (unsigned)__builtin_amdgcn_sbfe((int)(rt ? mw1 : mw0), cr_, 1)); }
            st[rt][i] = pv; rs += pv; }
    rs += shx(rs, 32, L.r + 32 * L.h);
    if (__builtin_amdgcn_ballot_w64(mn > A.m) != 0ull) {
        const float alpha = __builtin_amdgcn_exp2f(A.m - mn);
        A.l *= alpha; A.m = mn;
#pragma unroll
        for (int dt = 0; dt < 4; ++dt)
#pragma unroll
            for (int i = 0; i < 16; ++i) A.O[dt][i] *= alpha;
    }
    A.l += rs;
    ldsp va = Vt + tr_krow_off(L, VT_PITCH);
#pragma unroll
    for (int rt = 0; rt < 2; ++rt)
#pragma unroll
        for (int s2 = 0; s2 < 2; ++s2) { const bf16x8 pk = pack_half(st[rt], s2);
#pragma unroll
            for (int dt = 0; dt < 4; ++dt) A.O[dt] = MFMA32(tr_pair(va + (32 * rt + 16 * s2) * VT_PITCH + dt * 64, 8 * VT_PITCH), pk, A.O[dt]); }
}
DI void attn_store(const AttnState& A, bf16_t* orow, const LaneIds& L) {
    const float inv = 1.f / A.l;
#pragma unroll
    for (int dt = 0; dt < 4; ++dt)
#pragma unroll
        for (int gq = 0; gq < 4; gq += 2) { u32x2 a, b;
            a.x = pk2(A.O[dt][4 * gq] * inv, A.O[dt][4 * gq + 1] * inv); a.y = pk2(A.O[dt][4 * gq + 2] * inv, A.O[dt][4 * gq + 3] * inv);
            b.x = pk2(A.O[dt][4 * gq + 4] * inv, A.O[dt][4 * gq + 5] * inv); b.y = pk2(A.O[dt][4 * gq + 6] * inv, A.O[dt][4 * gq + 7] * inv);
            store_pair_t21(orow, 4 * dt + gq, a, b, L.h); }
}
DI void attn_load_q(bf16x8 (&Qf)[8], const bf16_t* qrow, const float* g, float pre, float scale, const LaneIds& L) {
    float x[8][8]; float ss = 0.f;
#pragma unroll
    for (int s = 0; s < 8; ++s) { unpack8(*(const u32x4*)(qrow + 16 * s + 8 * L.h), x[s]);
#pragma unroll
        for (int e = 0; e < 8; ++e) { x[s][e] *= pre; ss += x[s][e] * x[s][e]; } }
    ss += shx(ss, 32, L.r + 32 * L.h);
    const float f = scale * __builtin_amdgcn_rsqf(ss * (1.f / 128.f) + EPS);
#pragma unroll
    for (int s = 0; s < 8; ++s) { const f32x4 g0 = *(const f32x4*)(g + 16 * s + 8 * L.h), g1 = *(const f32x4*)(g + 16 * s + 8 * L.h + 4);
        Qf[s] = pack8(x[s][0] * f * g0[0], x[s][1] * f * g0[1], x[s][2] * f * g0[2], x[s][3] * f * g0[3], x[s][4] * f * g1[0], x[s][5] * f * g1[1], x[s][6] * f * g1[2], x[s][7] * f * g1[3]); }
}

DI void fox_unit(const Params& p0, const Ctx& c0, int layer, int u) {
    const Ctx c = fresh(c0); const Params p = freshp(p0);
    const int qb = 7 - (u >> 4), bh = u & 15, b = bh >> 2, hd = bh & 3, t0 = 256 * qb;
    const bf16_t* mix = wsb(p, WS_MIX); bf16_t* oall = wsb(p, WS_OALL);
    LAS float* Fs = (LAS float*)c.lds; LAS float* wtot = Fs + 2048; ldsp KV = c.lds + 8192 + 64;
    const LaneIds L = lane_ids(c.lane);
    {
        const float fb = p.fox_f_b[layer * 4 + hd]; float v[4];
#pragma unroll
        for (int e = 0; e < 4; ++e) { const float x = bf2f(mix[(size_t)(b * SEQ + 4 * c.tid + e) * NMIX + C_FF + hd]) + fb; v[e] = (fminf(x, 0.f) - log1pf(__expf(-fabsf(x)))) * LOG2E; }
        v[1] += v[0]; v[2] += v[1]; v[3] += v[2];
        float s = v[3];
#pragma unroll
        for (int o = 1; o < 64; o <<= 1) { const float t = shidx(s, c.lane - o); if (c.lane >= o) s += t; }
        if (c.lane == 63) wtot[c.wave] = s;
        __syncthreads();
        float base = s - v[3];
        for (int w = 0; w < c.wave; ++w) base += wtot[w];
        *(LAS f32x4*)(Fs + 4 * c.tid) = (f32x4){base + v[0], base + v[1], base + v[2], base + v[3]};
    }
    const int tq = t0 + 32 * c.wave + L.r;
    bf16x8 Qf[8];
    attn_load_q(Qf, mix + (size_t)(b * SEQ + tq) * NMIX + C_FQ + hd * 128, p.fox_qn_g + layer * 128, 1.f, 0.08838834764831845f * LOG2E, L);
    AttnState A; for (int i = 0; i < 4; ++i) A.O[i] = zero16(); A.m = -1e30f; A.l = 0.f;
    const bf16_t* kbase = wsb(p, WS_FOXKN) + hd * 128; const bf16_t* vbase = mix + C_FV + hd * 128;
    const int nt = (t0 + 256) / 64;
    KvStage sg; kv_load(sg, kbase, 512, vbase, NMIX, b * SEQ, c.tid); kv_write(sg, KV, KV + KT_BYTES, c.tid);
    __syncthreads();
#pragma unroll 1
    for (int j = 0; j < nt; ++j) {
        const int kb = 64 * j; ldsp Kt = KV + (j & 1) * (KT_BYTES + VT_BYTES), Vt = Kt + KT_BYTES;
        if (j + 1 < nt) kv_load(sg, kbase, 512, vbase, NMIX, b * SEQ + kb + 64, c.tid);
        if (kb <= t0 + 32 * c.wave + 31) {
            f32x16 st[2]; attn_qk(st, Kt, Qf, L);
            const bool diag = kb + 63 > t0 + 32 * c.wave;
#pragma unroll
            for (int rt = 0; rt < 2; ++rt)
#pragma unroll
                for (int gq = 0; gq < 4; ++gq) { const f32x4 fv = *(const LAS f32x4*)(Fs + kb + 32 * rt + 8 * gq + 4 * L.h);
#pragma unroll
                    for (int e = 0; e < 4; ++e) { float sv = st[rt][4 * gq + e] - fv[e]; if (diag && (kb + 32 * rt + 8 * gq + 4 * L.h + e > tq)) sv = -__builtin_inff(); st[rt][4 * gq + e] = sv; } }
            attn_softmax_pv<false>(A, st, Vt, L);
        }
        if (j + 1 < nt) { ldsp Kn = KV + ((j + 1) & 1) * (KT_BYTES + VT_BYTES); kv_write(sg, Kn, Kn + KT_BYTES, c.tid); }
        __syncthreads();
    }
    attn_store(A, oall + (size_t)(b * SEQ + tq) * KBR + O_FOX + hd * 128, L);
}

DI void idx_unit(const Params& p0, const Ctx& c0, int u) {
    const Ctx c = fresh(c0); const Params p = freshp(p0);
    const int qb = 63 - (u >> 2), b = u & 3, t0 = 32 * qb;
    const bf16_t* mix = wsb(p, WS_MIX); const bf16_t* qup = wsb(p, WS_QUP); float* scores = wsf(p, WS_SCORES);
    ldsp KI = c.lds; const LaneIds L = lane_ids(c.lane);
    bf16x8 Af[2][4]; float Wr[2][16];
#pragma unroll
    for (int pp = 0; pp < 2; ++pp) {
        const int tqa = t0 + 4 * c.wave + 2 * pp + ((L.r >> 2) & 1), head = 4 * (L.r >> 3) + (L.r & 3);
#pragma unroll
        for (int s = 0; s < 4; ++s) Af[pp][s] = *(const bf16x8*)(qup + (size_t)(b * SEQ + tqa) * NUP + 512 + head * 64 + 16 * s + 8 * L.h);
        const bf16_t* wrow = mix + (size_t)(b * SEQ + t0 + 4 * c.wave + 2 * pp + L.h) * NMIX + C_IW; float w0[8], w1[8]; unpack8(*(const u32x4*)wrow, w0); unpack8(*(const u32x4*)(wrow + 8), w1);
#pragma unroll
        for (int i = 0; i < 8; ++i) { Wr[pp][i] = w0[i]; Wr[pp][8 + i] = w1[i]; }
    }
    const int nsup = (t0 + 31) / 256 + 1;
    u32x4 sg[4];
#pragma unroll
    for (int i = 0; i < 4; ++i) { const int it = c.tid + 512 * i; sg[i] = *(const u32x4*)(mix + (size_t)(b * SEQ + (it >> 3)) * NMIX + C_IK + 8 * (it & 7)); }
#pragma unroll
    for (int i = 0; i < 4; ++i) { const int it = c.tid + 512 * i; *(LAS u32x4*)(KI + (it >> 3) * 144 + (it & 7) * 16) = sg[i]; }
    __syncthreads();
#pragma unroll 1
    for (int js = 0; js < nsup; ++js) {
        ldsp Kc = KI + (js & 1) * 36864;
        if (js + 1 < nsup) {
#pragma unroll
            for (int i = 0; i < 4; ++i) { const int it = c.tid + 512 * i; sg[i] = *(const u32x4*)(mix + (size_t)(b * SEQ + 256 * (js + 1) + (it >> 3)) * NMIX + C_IK + 8 * (it & 7)); } }
#pragma unroll 1
        for (int kt = 0; kt < 8; ++kt) {
            const int kb = 256 * js + 32 * kt; if (kb > t0 + 31) break;
            bf16x8 Bf[4];
#pragma unroll
            for (int s = 0; s < 4; ++s) Bf[s] = *(const LAS bf16x8*)(Kc + (32 * kt + L.r) * 144 + (16 * s + 8 * L.h) * 2);
#pragma unroll
            for (int pp = 0; pp < 2; ++pp) { f32x16 acc = zero16();
#pragma unroll
                for (int s = 0; s < 4; ++s) acc = MFMA32(Af[pp][s], Bf[s], acc);
                float sc = 0.f;
#pragma unroll
                for (int i = 0; i < 16; ++i) sc += Wr[pp][i] * fmaxf(acc[i], 0.f);
                scores[(size_t)(b * SEQ + t0 + 4 * c.wave + 2 * pp + L.h) * SEQ + kb + L.r] = sc; }
        }
        if (js + 1 < nsup) { ldsp Kn = KI + ((js + 1) & 1) * 36864;
#pragma unroll
            for (int i = 0; i < 4; ++i) { const int it = c.tid + 512 * i; *(LAS u32x4*)(Kn + (it >> 3) * 144 + (it & 7) * 16) = sg[i]; } }
        __syncthreads();
    }
}

template <int NJ>
DI void sel_query(const float* row, unsigned* mrow, int t, int lane) {
    unsigned x[NJ];
#pragma unroll
    for (int j = 0; j < NJ; ++j) { const int key = 64 * j + lane; const unsigned bits = __float_as_uint(row[key]);
        const unsigned uu = (bits & 0x80000000u) ? ~bits : (bits | 0x80000000u); x[j] = (key <= t) ? uu : 0u; }
    unsigned T = 1u; bool exact = (t + 1 <= 256);
    if (!exact) {
#define SEL_COUNT(dst, thr) do { int _c = 0; _Pragma("unroll") for (int j = 0; j < NJ; ++j) _c += __popcll(__ballot(x[j] >= (thr))); dst = _c; } while (0)
        const float ex = 16384.f / (float)(t + 1), mg = 3.f * sqrtf(ex) + 2.f; const int k_hi0 = (int)floorf(ex - mg), k_hi = k_hi0 < 1 ? 1 : k_hi0, k_lo = (int)ceilf(ex + mg);
        unsigned lo = 1u, hi = 0xffffffffu;
        if (k_lo <= 64) { unsigned v = 0u;
#pragma unroll 1
            for (int bit = 31; bit >= 0; --bit) { const unsigned cand = v | (1u << bit); if (__popcll(__ballot(x[0] >= cand)) >= k_lo) v = cand; }
            int cc; SEL_COUNT(cc, v); if (cc >= 256) { lo = v; if (cc == 256) { T = v; exact = true; } } else hi = v; }
        if (!exact) { unsigned v = 0u;
#pragma unroll 1
            for (int bit = 31; bit >= 0; --bit) { const unsigned cand = v | (1u << bit); if (__popcll(__ballot(x[0] >= cand)) >= k_hi) v = cand; }
            int cc; SEL_COUNT(cc, v);
            if (cc == 256) { T = v; exact = true; } else if (cc < 256) { if (v < hi) hi = v; } else if (v > lo) lo = v; }
        if (!exact) {
#pragma unroll 1
            while (hi - lo > 1u) { const unsigned mid = lo + ((hi - lo) >> 1); int cc; SEL_COUNT(cc, mid);
                if (cc == 256) { T = mid; exact = true; break; }
                if (cc > 256) lo = mid; else hi = mid; }
            if (!exact) T = lo;
        }
#undef SEL_COUNT
    }
    if (exact) {
#pragma unroll
        for (int j = 0; j < NJ; ++j) { const unsigned long long bal = __ballot(x[j] >= T); if (lane == 0) { mrow[2 * j] = (unsigned)bal; mrow[2 * j + 1] = (unsigned)(bal >> 32); } }
    } else {
        int gt = 0;
#pragma unroll
        for (int j = 0; j < NJ; ++j) gt += __popcll(__ballot(x[j] > T));
        int need = 256 - gt, run = 0;
#pragma unroll
        for (int j = 0; j < NJ; ++j) { const bool eq = x[j] == T; const unsigned long long be = __ballot(eq); const int below = __popcll(be & ((1ull << lane) - 1ull));
            const bool sel = (x[j] > T) || (eq && (run + below < need)); run += __popcll(be);
            const unsigned long long bal = __ballot(sel); if (lane == 0) { mrow[2 * j] = (unsigned)bal; mrow[2 * j + 1] = (unsigned)(bal >> 32); } }
    }
    if (lane < 2 * (32 - NJ)) mrow[2 * NJ + lane] = 0u;
}
DI void sel_unit(const Params& p0, const Ctx& c0, int u) {
    const Ctx c = fresh(c0); const Params p = freshp(p0);
    const int qb = 127 - (u >> 2), b = u & 3, t0 = 16 * qb;
    const float* scores = wsf(p, WS_SCORES); unsigned* msk = (unsigned*)(p.ws + WS_MSK);
    const int grp = (t0 + 15) >> 9;
#pragma unroll 1
    for (int qi = 0; qi < 2; ++qi) {
        const int t = t0 + 2 * c.wave + qi; const float* row = scores + (size_t)(b * SEQ + t) * SEQ; unsigned* mrow = msk + (size_t)(b * SEQ + t) * 64;
        if (grp == 0) sel_query<8>(row, mrow, t, c.lane); else if (grp == 1) sel_query<16>(row, mrow, t, c.lane); else if (grp == 2) sel_query<24>(row, mrow, t, c.lane); else sel_query<32>(row, mrow, t, c.lane);
    }
}
DI void knorm_unit(const Params& p0, const Ctx& c0, int layer, int u) {
    const Ctx c = fresh(c0); const Params p = freshp(p0);
    const bf16_t* mix = wsb(p, WS_MIX); bf16_t* fk = wsb(p, WS_FOXKN); bf16_t* dk = wsb(p, WS_DSAKN);
    const int ch = c.tid & 15, tok = 32 * u + (c.tid >> 4);
    u32x4 raw[5];
#pragma unroll
    for (int hh = 0; hh < 5; ++hh) raw[hh] = *(const u32x4*)(mix + (size_t)tok * NMIX + (hh < 4 ? C_FK + hh * 128 : C_DK) + 8 * ch);
    const f32x4 f0 = *(const f32x4*)(p.fox_kn_g + layer * 128 + 8 * ch), f1 = *(const f32x4*)(p.fox_kn_g + layer * 128 + 8 * ch + 4);
    const f32x4 d0 = *(const f32x4*)(p.dsa_kn_g + layer * 128 + 8 * ch), d1 = *(const f32x4*)(p.dsa_kn_g + layer * 128 + 8 * ch + 4);
#pragma unroll
    for (int hh = 0; hh < 5; ++hh) {
        float a[8]; unpack8(raw[hh], a); float ss = 0.f;
#pragma unroll
        for (int e = 0; e < 8; ++e) ss += a[e] * a[e];
        ss += shx(ss, 1, c.lane); ss += shx(ss, 2, c.lane); ss += shx(ss, 4, c.lane); ss += shx(ss, 8, c.lane);
        const float rstd = __builtin_amdgcn_rsqf(ss * (1.f / 128.f) + EPS); const f32x4 g0 = hh < 4 ? f0 : d0, g1 = hh < 4 ? f1 : d1;
        const bf16x8 o = pack8(a[0] * rstd * g0[0], a[1] * rstd * g0[1], a[2] * rstd * g0[2], a[3] * rstd * g0[3], a[4] * rstd * g1[0], a[5] * rstd * g1[1], a[6] * rstd * g1[2], a[7] * rstd * g1[3]);
        if (hh < 4) *(bf16x8*)(fk + (size_t)tok * 512 + hh * 128 + 8 * ch) = o; else *(bf16x8*)(dk + (size_t)tok * 128 + 8 * ch) = o; }
}
DI void dsa_unit(const Params& p0, const Ctx& c0, int layer, int u) {
    const Ctx c = fresh(c0); const Params p = freshp(p0);
    const int qb = 31 - (u >> 2), b = u & 3, t0 = 64 * qb;
    const bf16_t* mix = wsb(p, WS_MIX); const bf16_t* qup = wsb(p, WS_QUP); bf16_t* oall = wsb(p, WS_OALL); const unsigned* msk = (const unsigned*)(p.ws + WS_MSK);
    LAS unsigned* Msk = (LAS unsigned*)c.lds; LAS float* Bl = (LAS float*)(c.lds + 16640); ldsp KV = c.lds + 16640 + 2048;
    const LaneIds L = lane_ids(c.lane);
    const int hd = c.wave >> 1, qg = c.wave & 1, ql = 32 * qg + L.r, tq = t0 + ql; const size_t tok = (size_t)(b * SEQ + tq);
    const float b31 = p.rel_bias[31 * 4 + hd] * LOG2E;
    if (c.tid < 128) {
        const int d = c.tid; int bk = d;
        if (d >= 16) { bk = 16 + (int)(__logf((float)d * (1.f / 16.f)) * (16.f / 2.0794415416798357f)); bk = bk > 31 ? 31 : bk; }
#pragma unroll
        for (int hh = 0; hh < 4; ++hh) Bl[d * 4 + hh] = (p.rel_bias[bk * 4 + hh] - p.rel_bias[31 * 4 + hh]) * LOG2E;
    }
#pragma unroll
    for (int i = 0; i < 8; ++i) { const int it = c.tid + 512 * i, q = it >> 6, w = it & 63; Msk[q * 65 + w] = msk[(size_t)(b * SEQ + t0 + q) * 64 + w]; }
    (void)b31;
    float rc;
    { float ss = 0.f; const bf16_t* cr = mix + tok * NMIX + C_DCQ + 256 * L.h;
#pragma unroll 4
      for (int i = 0; i < 32; ++i) { float f[8]; unpack8(*(const u32x4*)(cr + 8 * i), f);
#pragma unroll
          for (int e = 0; e < 8; ++e) ss += f[e] * f[e]; }
      ss += shx(ss, 32, L.r + 32 * L.h); rc = __builtin_amdgcn_rsqf(ss * (1.f / 512.f) + EPS); }
    bf16x8 Qf[8];
    attn_load_q(Qf, qup + tok * NUP + hd * 128, p.dsa_qn_g + layer * 128, rc, 0.08838834764831845f * LOG2E, L);
    AttnState A; for (int i = 0; i < 4; ++i) A.O[i] = zero16(); A.m = -1e30f; A.l = 0.f;
    const bf16_t* kbase = wsb(p, WS_DSAKN); const bf16_t* vbase = mix + C_DV;
    const int nt = qb + 1;
    KvStage sg; kv_load(sg, kbase, 128, vbase, NMIX, b * SEQ, c.tid); kv_write(sg, KV, KV + KT_BYTES, c.tid);
    __syncthreads();
#pragma unroll 1
    for (int j = 0; j < nt; ++j) {
        const int kb = 64 * j; ldsp Kt = KV + (j & 1) * (KT_BYTES + VT_BYTES), Vt = Kt + KT_BYTES;
        if (j + 1 < nt) kv_load(sg, kbase, 128, vbase, NMIX, b * SEQ + kb + 64, c.tid);
        {
            f32x16 st[2]; attn_qk(st, Kt, Qf, L);
            const unsigned mw0 = Msk[ql * 65 + 2 * j] >> (4 * L.h), mw1 = Msk[ql * 65 + 2 * j + 1] >> (4 * L.h);
            if (kb + 63 + 128 > t0 + 32 * qg) {
#pragma unroll
                for (int rt = 0; rt < 2; ++rt)
#pragma unroll
                    for (int i = 0; i < 16; ++i) { const int cr_ = (i & 3) + 8 * (i >> 2); const int d = tq - (kb + 32 * rt + cr_ + 4 * L.h);
                        if (d < 128) st[rt][i] += Bl[(d < 0 ? 0 : d) * 4 + hd]; }
            }
            attn_softmax_pv<true>(A, st, Vt, L, mw0, mw1);
        }
        if (j + 1 < nt) { ldsp Kn = KV + ((j + 1) & 1) * (KT_BYTES + VT_BYTES); kv_write(sg, Kn, Kn + KT_BYTES, c.tid); }
        __syncthreads();
    }
    attn_store(A, oall + tok * KBR + O_DSA + hd * 128, L);
}

constexpr int NPH = 9, NPHASES = 1 + DEPTH * NPH;
enum { Q_IDX = 0, Q_SSDST = 1, Q_RETKV = 2, Q_FOX = 3, Q_DSA = 4, Q_SSDO = 5, Q_RETO = 6, Q_SEL = 7 };
#ifndef LB2
#define LB2 2
#endif
__global__ void __launch_bounds__(512, LB2) fwd(Params pk) {
    extern __shared__ __attribute__((aligned(16))) unsigned char lds_raw[];
    Ctx c; c.lds = (ldsp)lds_raw; c.tid = threadIdx.x; c.lane = c.tid & 63; c.wave = __builtin_amdgcn_readfirstlane(c.tid >> 6); c.G = gridDim.x; c.bid = blockIdx.x;
    c.ctl = (gu32*)(pk.ws + WS_CTL);
    if (c.tid < 64) ((LAS unsigned*)(c.lds + LDS_MISC))[c.tid] = 0u;
    __syncthreads();
#if MK_PER_PHASE
#define GRID_BAR() do { } while (0)
#else
    XcdBarrier bar = xcd_barrier_post((unsigned*)(c.ctl + CW_BAR), (volatile LAS unsigned*)(c.lds + LDS_MISC) + 8);
#define GRID_BAR() xcd_barrier(bar)
#endif
    const int lo = pk.ph_lo, hi = pk.ph_hi, rep = pk.rep;
#define IN(k) (lo <= (k) && (k) < hi)
#define SEAM(k) do { if (IN((k) + 1)) GRID_BAR(); } while (0)
#define PHASE(k, ...) if (PH_ON((k) + 1) && IN(pb + (k))) { const Params p = loadp(); unsigned char* wl = p.ws + WS_W + (size_t)l * WL_SIZE; (void)wl; __VA_ARGS__ SEAM(pb + (k)); }
    if (PH_ON(0) && IN(0)) { const Params p = loadp(); p0_prologue(p, c); xprep_phase(c, p.x, wsb(p, WS_HN), wsf(p, WS_SSP)); SEAM(0); }
#pragma unroll 1
    for (int l = 0; l < DEPTH; ++l) {
        const int pb = 1 + l * NPH;
        PHASE(0, {
            pg8::Gemm g{wsb(p, WS_HN), (const bf16_t*)(wl + WL_IN), MTOK, NIN, DM, DM, DM}; pg8::StaticOrder S; S.init(MTOK, NIN, c.G, c.bid);
            pg8::EpiIn E{wsb(p, WS_MIX), wsb(p, WS_GATES), p.gate_b + (size_t)l * NGATE, wsf(p, WS_SSP)};
            pg8::gemm_phase(c.lds, g, S, E);
            convert_on_idle(p, c, l, I_IN, PER_LAYER, (MTOK / 256) * (NIN / 256)); })
        PHASE(1, {
            pg8::Gemm g{wsb(p, WS_MIX) + C_DCQ, (const bf16_t*)(wl + WL_UP), MTOK, NUP, KUP, NMIX, KUP}; pg8::StaticOrder S; S.init(MTOK, NUP, c.G, c.bid);
            pg8::EpiBf16<0> E{wsb(p, WS_QUP), NUP, nullptr};
            pg8::gemm_phase(c.lds, g, S, E);
            if (l + 1 < DEPTH) convert_on_idle(p, c, l + 1, 0, CV_B, (MTOK / 256) * (NUP / 256)); })
        PHASE(2, {
            if (rep == 0 || ((REP_UM >> Q_IDX) & 1)) for (int u; (u = next_unit(c, l, Q_IDX + 8 * rep)) < 256;) idx_unit(p, c, u);
            if (rep == 0 || ((REP_UM >> Q_SSDST) & 1)) for (int u; (u = next_unit(c, l, Q_SSDST + 8 * rep)) < 256;) ssdst_unit(p, c, l, u);
            if (rep == 0 || ((REP_UM >> Q_RETKV) & 1)) for (int u; (u = next_unit(c, l, Q_RETKV + 8 * rep)) < 256;) retkv_unit(p, c, u);
            for (int u = c.bid; u < 256; u += c.G) { knorm_unit(p, c, l, u); } })
        PHASE(3, {
            for (int u; (u = next_unit(c, l, Q_SEL + 8 * rep)) < 512;) sel_unit(p, c, u);
            scan_phase(p, c); })
        PHASE(4, {
            if (rep == 0 || ((REP_UM >> Q_DSA) & 1)) for (int u; (u = next_unit(c, l, Q_DSA + 8 * rep)) < 128;) dsa_unit(p, c, l, u);
            if (rep == 0 || ((REP_UM >> Q_FOX) & 1)) for (int u; (u = next_unit(c, l, Q_FOX + 8 * rep)) < 128;) fox_unit(p, c, l, u);
            if (rep == 0 || ((REP_UM >> Q_SSDO) & 1)) for (int u; (u = next_unit(c, l, Q_SSDO + 8 * rep)) < 256;) ssdo_unit(p, c, l, u);
            if (rep == 0 || ((REP_UM >> Q_RETO) & 1)) for (int u; (u = next_unit(c, l, Q_RETO + 8 * rep)) < 256;) reto_unit(p, c, u);
            if (l + 1 < DEPTH) { __syncthreads(); convert_items(p, c, l + 1, CV_B, I_IN, c.bid * 8 + c.wave, c.G * 8); } })
        PHASE(5, {
            pg8::Gemm g{wsb(p, WS_OALL), (const bf16_t*)(wl + WL_BR), MTOK, DM, KBR, KBR, KBR}; pg8::StaticOrder S; S.init(MTOK, DM, c.G, c.bid);
            pg8::EpiMerge E{wsb(p, WS_MERGED), wsb(p, WS_GATES), wsf(p, WS_SSQH)};
            pg8::gemm_phase(c.lds, g, S, E); })
        PHASE(6, {
            pg8::Gemm g{wsb(p, WS_MERGED), (const bf16_t*)(wl + WL_OUT), MTOK, DM, DM, DM, DM}; pg8::StaticOrder S; S.init(MTOK, DM, c.G, c.bid);
            pg8::EpiResid<1, 0> E{wsb(p, WS_HN), nullptr, wsb(p, WS_XRES), wsf(p, WS_SSP), DM};
            pg8::gemm_phase(c.lds, g, S, E); })
        PHASE(7, {
            pg8::Gemm g{wsb(p, WS_XRES), (const bf16_t*)(wl + WL_FF1), MTOK, DFF, DM, DM, DM}; pg8::StaticOrder S; S.init(MTOK, DFF, c.G, c.bid);
            pg8::EpiBf16<1> E{wsb(p, WS_FFH), DFF, wsf(p, WS_SSP)};
            pg8::gemm_phase(c.lds, g, S, E); })
        if (l < DEPTH - 1) {
            PHASE(8, {
                pg8::Gemm g{wsb(p, WS_FFH), (const bf16_t*)(wl + WL_FF2), MTOK, DM, DFF, DFF, DFF}; pg8::StaticOrder S; S.init(MTOK, DM, c.G, c.bid);
                pg8::EpiResid<1, 0> E{wsb(p, WS_XRES), nullptr, wsb(p, WS_HN), wsf(p, WS_SSP), DM};
                pg8::gemm_phase(c.lds, g, S, E); })
        } else {
            PHASE(8, {
                pg8::Gemm g{wsb(p, WS_FFH), (const bf16_t*)(wl + WL_FF2), MTOK, DM, DFF, DFF, DFF}; pg8::StaticOrder S; S.init(MTOK, DM, c.G, c.bid);
                pg8::EpiResid<1, 1> E{wsb(p, WS_XRES), p.out, nullptr, nullptr, DM};
                pg8::gemm_phase(c.lds, g, S, E); })
        }
    }
#undef PHASE
#undef IN
#undef SEAM
}

extern "C" void kernel_launch(void* const* d_in, const int* in_sizes, int n_in, void* d_out, int out_size, void* d_ws, size_t ws_size, hipStream_t stream) {
    static int grid = 0;
    if (grid == 0) {
        if (n_in != 24 || in_sizes[0] != MTOK * DM || out_size != MTOK * DM || ws_size < WS_END) {
            fprintf(stderr, "kernel_launch: unexpected problem (n_in %d, in0 %d, out %d, ws %zu < %zu?); nothing launched\n", n_in, n_in > 0 ? in_sizes[0] : -1, out_size, ws_size, (size_t)WS_END); grid = -1; return; }
        int dev = 0, cus = 0;
        if (hipGetDevice(&dev) != hipSuccess || hipDeviceGetAttribute(&cus, hipDeviceAttributeMultiprocessorCount, dev) != hipSuccess) { grid = -1; return; }
        if (hipFuncSetAttribute((const void*)fwd, hipFuncAttributeMaxDynamicSharedMemorySize, LDS_BYTES) != hipSuccess) { fprintf(stderr, "kernel_launch: hipFuncSetAttribute failed\n"); grid = -1; return; }
        int per_cu = 0;
        if (hipOccupancyMaxActiveBlocksPerMultiprocessor(&per_cu, (const void*)fwd, 512, LDS_BYTES) != hipSuccess || per_cu < 1) { fprintf(stderr, "kernel_launch: occupancy query says %d blocks per CU\n", per_cu); }
        (void)hipGetLastError();
        grid = cus;
    }
    if (grid < 0) return;
    (void)hipMemsetAsync((char*)d_ws + WS_CTL, 0, CTL_ZERO_BYTES, stream);
    Params p{};
    const float** pin = (const float**)&p;
    for (int i = 0; i < 24; ++i) pin[i] = (const float*)d_in[i];
    p.out = (float*)d_out; p.ws = (unsigned char*)d_ws;
#if MK_PER_PHASE
    for (int ph = 0; ph < NPHASES; ++ph) { p.ph_lo = ph; p.ph_hi = ph + 1; p.rep = 0; hipLaunchKernelGGL(fwd, dim3(grid), dim3(512), LDS_BYTES, stream, p);
        if ((ph >= 1 && (ph - 1) % NPH == REPEAT_PH) || (ph == 0 && REPEAT_PH == 100)) { p.rep = 1; hipLaunchKernelGGL(fwd, dim3(grid), dim3(512), LDS_BYTES, stream, p); } }
#else
    p.ph_lo = 0; p.ph_hi = NPHASES; hipLaunchKernelGGL(fwd, dim3(grid), dim3(512), LDS_BYTES, stream, p);
#endif
    const hipError_t le = hipPeekAtLastError();
    if (le != hipSuccess) fprintf(stderr, "kernel_launch: launch failed: %s\n", hipGetErrorName(le));
}
```

```cpp
#include <hip/hip_runtime.h>
#include <cstdio>
#include <cstdint>

#ifndef MK_PER_PHASE
#define MK_PER_PHASE 0
#endif
#ifndef REPEAT_PH
#define REPEAT_PH -1
#endif
#ifndef REP_UM
#define REP_UM 0xFF
#endif
#ifndef PHMASK
#define PHMASK 0xFFFFu
#endif
#define PH_ON(k) ((PHMASK >> (k)) & 1u)
#ifndef UM
#define UM 0xFF
#endif

#define DI __device__ __forceinline__
#define LAS __attribute__((address_space(3)))
#define GAS __attribute__((address_space(1)))
typedef unsigned short bf16_t;
typedef short bf16x8 __attribute__((ext_vector_type(8)));
typedef short s16x4 __attribute__((ext_vector_type(4)));
typedef float f32x2 __attribute__((ext_vector_type(2)));
typedef float f32x4 __attribute__((ext_vector_type(4)));
typedef float f32x16 __attribute__((ext_vector_type(16)));
typedef unsigned u32x2 __attribute__((ext_vector_type(2)));
typedef unsigned u32x4 __attribute__((ext_vector_type(4)));
typedef __bf16 bf16x2_t __attribute__((ext_vector_type(2)));
typedef GAS unsigned gu32;
typedef LAS unsigned char* ldsp;

constexpr int NB = 4, SEQ = 2048, DM = 2048, DEPTH = 4, MTOK = NB * SEQ;
constexpr int DFF = 8192, IN_TOTAL = 15204;
constexpr int NMIX = 7168, NGATE = 8192, NIN = NMIX + NGATE;
constexpr int NUP = 1536, KUP = 512, KBR = 2560;
constexpr float EPS = 1e-6f;
constexpr float LOG2E = 1.4426950408889634f;
constexpr int C_RQ = 0, C_RK = 512, C_RV = 1024, C_RG = 1536, C_FQ = 2048, C_FK = 2560, C_FV = 3072, C_DCQ = 3584, C_DK = 4096, C_DV = 4224,
              C_IK = 4352, C_SZ = 4416, C_SX = 5440, C_SB = 6464, C_SC = 6720, C_IW = 6976, C_SDT = 6992, C_FF = 7008, C_MIXEND = 7012;
constexpr int O_RET = 0, O_FOX = 512, O_DSA = 1024, O_SSD = 1536;

constexpr size_t MiB = 1u << 20;
constexpr size_t WS_CTL = 0, CTL_ZERO_BYTES = 1 * MiB;
constexpr size_t WL_IN = 0, WL_UP = WL_IN + (size_t)NIN * DM * 2, WL_BR = WL_UP + (size_t)NUP * KUP * 2, WL_OUT = WL_BR + (size_t)DM * KBR * 2,
                 WL_FF1 = WL_OUT + (size_t)DM * DM * 2, WL_FF2 = WL_FF1 + (size_t)DFF * DM * 2, WL_SIZE = WL_FF2 + (size_t)DM * DFF * 2;
constexpr size_t WS_W = 2 * MiB;
constexpr size_t WS_ACT = ((WS_W + DEPTH * WL_SIZE + MiB - 1) / MiB) * MiB;
constexpr size_t WS_XRES = WS_ACT, WS_X1 = WS_XRES + 64 * MiB, WS_HN = WS_X1 + 64 * MiB, WS_MIX = WS_HN + 32 * MiB, WS_GATES = WS_MIX + 112 * MiB,
                 WS_QUP = WS_GATES + 128 * MiB, WS_OALL = WS_QUP + 24 * MiB, WS_MERGED = WS_OALL + 40 * MiB, WS_FFH = WS_MERGED + 32 * MiB,
                 WS_SCORES = WS_FFH + 128 * MiB, WS_KVS = WS_SCORES + 64 * MiB, WS_PREVR = WS_KVS + 16 * MiB, WS_ST = WS_PREVR + 8 * MiB,
                 WS_PREVS = WS_ST + 32 * MiB, WS_XBCC = WS_PREVS + 16 * MiB, WS_ACS = WS_XBCC + 24 * MiB, WS_BS = WS_ACS + 1 * MiB, WS_SSQH = WS_BS + 1 * MiB, WS_SSP = WS_SSQH + 1 * MiB, WS_FOXKN = WS_SSP + 1 * MiB, WS_DSAKN = WS_FOXKN + 8 * MiB, WS_MSK = WS_DSAKN + 2 * MiB,
                 WS_ONES = WS_MSK + 2 * MiB, WS_END = WS_ONES + 1 * MiB;
constexpr int CW_BAR = 4096;
constexpr int CW_QUEUE = 16384;
constexpr int NQUEUE = 16;

constexpr int LDS_BYTES = 147456;
constexpr int LDS_WORK = 143360;
constexpr int LDS_MISC = LDS_WORK;

DI float bf2f(unsigned short b) { return __uint_as_float(((unsigned)b) << 16); }
DI float bflo(unsigned u) { return __uint_as_float(u << 16); }
DI float bfhi(unsigned u) { return __uint_as_float(u & 0xffff0000u); }
DI unsigned pk2(float lo, float hi) { f32x2 v = {lo, hi}; bf16x2_t b = __builtin_convertvector(v, bf16x2_t); return __builtin_bit_cast(unsigned, b); }
DI unsigned short f2bf(float f) { return (unsigned short)(pk2(f, 0.f) & 0xffffu); }
DI bf16x8 pack8(float a0, float a1, float a2, float a3, float a4, float a5, float a6, float a7) {
    u32x4 p; p.x = pk2(a0, a1); p.y = pk2(a2, a3); p.z = pk2(a4, a5); p.w = pk2(a6, a7); return __builtin_bit_cast(bf16x8, p); }
DI void unpack8(const u32x4 v, float (&f)[8]) { f[0] = bflo(v.x); f[1] = bfhi(v.x); f[2] = bflo(v.y); f[3] = bfhi(v.y); f[4] = bflo(v.z); f[5] = bfhi(v.z); f[6] = bflo(v.w); f[7] = bfhi(v.w); }
DI float sigmoidf_(float x) { return __builtin_amdgcn_rcpf(1.f + __builtin_amdgcn_exp2f(-LOG2E * x)); }
DI float siluf_(float x) { return x * __builtin_amdgcn_rcpf(1.f + __builtin_amdgcn_exp2f(-LOG2E * x)); }
#define MFMA32(a, b, c) __builtin_amdgcn_mfma_f32_32x32x16_bf16((a), (b), (c), 0, 0, 0)
DI int crow(int i, int h) { return (i & 3) + 8 * (i >> 2) + 4 * h; }
DI s16x4 trrd(ldsp p) { return __builtin_bit_cast(s16x4, __builtin_amdgcn_ds_read_tr16_b64_v4i16((LAS s16x4*)p)); }
DI bf16x8 tr_pair(ldsp p, int off2) { s16x4 lo = trrd(p), hi = trrd(p + off2); return __builtin_shufflevector(lo, hi, 0, 1, 2, 3, 4, 5, 6, 7); }
DI float shidx(float v, int src) { return __int_as_float(__builtin_amdgcn_ds_bpermute(src << 2, __float_as_int(v))); }
DI float shx(float v, int m, int lane) { return shidx(v, lane ^ m); }
DI void store_pair_t21(bf16_t* rowp, int k, u32x2 a, u32x2 b, int h) {
    const auto rx = __builtin_amdgcn_permlane32_swap(a.x, b.x, false, false), ry = __builtin_amdgcn_permlane32_swap(a.y, b.y, false, false);
    u32x4 w; w.x = rx[0]; w.y = ry[0]; w.z = rx[1]; w.w = ry[1];
    *(u32x4*)(rowp + 8 * k + (h ? 8 : 0)) = w;
}
DI f32x16 zero16() { f32x16 z; for (int i = 0; i < 16; ++i) z[i] = 0.f; return z; }

#define XB_TMO      128
#define XB_XCNT(j)  (256  + 64 * (j))
#define XB_XSUB(j)  (1280 + 64 * (j))
#define XB_XGEN(j)  (2304 + 64 * (j))
#define XB_TOP      3328
#define XB_TOPGEN   3392
#define XCD_BAR_WORDS 3456
#define XB_SPIN_CAP (1u << 18)
DI unsigned xb_ld(unsigned* p)              { return __hip_atomic_load(p, __ATOMIC_RELAXED, __HIP_MEMORY_SCOPE_AGENT); }
DI unsigned xb_add(unsigned* p, unsigned v) { return __hip_atomic_fetch_add(p, v, __ATOMIC_RELAXED, __HIP_MEMORY_SCOPE_AGENT); }
DI unsigned xb_xcc_id() { return (unsigned)__builtin_amdgcn_s_getreg((3 << 11) | 20) & 0xFu; }
#define XB_SPIN(cond, bar) do { unsigned _sp = 0; while (cond) { __builtin_amdgcn_s_sleep(1); \
    if ((++_sp & 255u) == 0u) { if (xb_ld(&(bar)[XB_TMO])) break; if (_sp > XB_SPIN_CAP) { atomicAdd(&(bar)[XB_TMO], 1u); break; } } } } while (0)
struct XcdBarrier { unsigned* bar; unsigned x; volatile LAS unsigned* st; };
DI XcdBarrier xcd_barrier_post(unsigned* bar, volatile LAS unsigned* st) {
    XcdBarrier b; b.bar = bar; b.x = xb_xcc_id(); b.st = st;
    if (threadIdx.x == 0) (void)xb_add(&bar[XB_XCNT(b.x)], 1u);
    return b;
}
DI void xcd_barrier_complete(unsigned* bar, unsigned x, unsigned& nloc, unsigned& nx) {
    const unsigned G = gridDim.x * gridDim.y * gridDim.z;
    unsigned sum, cnt, mine, sp = 0u;
    for (;;) {
        sum = 0u; cnt = 0u; mine = 0u;
#pragma unroll
        for (unsigned j = 0; j < 16; ++j) { const unsigned c = xb_ld(&bar[XB_XCNT(j)]); sum += c; cnt += (c > 0u) ? 1u : 0u; mine = (j == x) ? c : mine; }
        if (sum == G) break;
        __builtin_amdgcn_s_sleep(1);
        if ((++sp & 255u) == 0u) { if (xb_ld(&bar[XB_TMO])) break; if (sp > XB_SPIN_CAP) { atomicAdd(&bar[XB_TMO], 1u); break; } }
    }
    nloc = mine > 0u ? mine : 1u; nx = cnt > 0u ? cnt : 1u;
}
DI void xcd_barrier(const XcdBarrier& b) {
    asm volatile("s_waitcnt vmcnt(0)" ::: "memory");
    __syncthreads();
    if (threadIdx.x == 0) {
        unsigned* bar = b.bar; { GAS unsigned* w = (GAS unsigned*)bar; asm volatile("" : "+s"(w)); bar = (unsigned*)w; }
        __builtin_amdgcn_s_waitcnt(0);
        unsigned nloc = b.st[0], nx = b.st[1];
        if (nloc == 0u) { xcd_barrier_complete(bar, b.x, nloc, nx); b.st[0] = nloc; b.st[1] = nx; }
        const unsigned old = xb_add(&bar[XB_XSUB(b.x)], 1u);
        const unsigned gen = old / nloc;
        if (old + 1u == (gen + 1u) * nloc) {
            __builtin_amdgcn_fence(__ATOMIC_RELEASE, "agent");
            asm volatile("s_waitcnt vmcnt(0)" ::: "memory");
            const unsigned og = xb_add(&bar[XB_TOP], 1u);
            const unsigned tg = og / nx;
            if (og + 1u == (tg + 1u) * nx) xb_add(&bar[XB_TOPGEN], 1u);
            else XB_SPIN(xb_ld(&bar[XB_TOPGEN]) == tg, bar);
            __builtin_amdgcn_fence(__ATOMIC_ACQUIRE, "agent");
            xb_add(&bar[XB_XGEN(b.x)], 1u);
            asm volatile("s_waitcnt vmcnt(0)" ::: "memory");
        } else {
            XB_SPIN(xb_ld(&bar[XB_XGEN(b.x)]) == gen, bar);
            __builtin_amdgcn_fence(__ATOMIC_ACQUIRE, "agent");
            asm volatile("s_waitcnt vmcnt(0)" ::: "memory");
        }
    }
    __syncthreads();
}

namespace pg8 {
constexpr int BM = 256, BK = 64, HALF = 128, HTB = HALF * BK * 2, STAGE_BYTES = 8 * HTB, NXCD = 8, WGM = 8;
__host__ __device__ __forceinline__ int lds_byte(int r, int c) { const int st = (r >> 4) * 2 + (c >> 5), rr = r & 15, cc = c & 31, ob = rr * 64 + cc * 2; return st * 1024 + (ob ^ (((ob >> 9) & 1) << 5)); }
__host__ __device__ __forceinline__ void stage_rc(int b, int& R, int& C) { const int st = b / 1024, sb = b % 1024, swz = sb ^ (((sb >> 9) & 1) << 5); R = (st >> 1) * 16 + swz / 64; C = (st & 1) * 32 + (swz % 64) / 2; }
__host__ __device__ __forceinline__ int perm32(int rho) { const int n = rho >> 4, i = rho & 15; return 8 * (i >> 2) + 4 * n + (i & 3); }
struct Unit { int pm, pn; };
struct Gemm { const bf16_t* A; const bf16_t* Bt; int M, N, K, lda, ldb; };
struct StaticOrder {
    int nM, nN, nwg, G, c;
    __host__ __device__ void init(int M, int N, int G_, int c_) { nM = M / BM; nN = N / BM; nwg = nM * nN; G = G_; c = c_; }
    __host__ __device__ bool next(int i, Unit& u) const {
        const long L = (long)i * G + c; if (L >= nwg) return false;
        int wgid = (int)L; { const int q = nwg / NXCD, r = nwg % NXCD, xcd = wgid % NXCD, off = wgid / NXCD; wgid = (xcd < r ? xcd * (q + 1) : r * (q + 1) + (xcd - r) * q) + off; }
        const int nig = WGM * nN, gid = wgid / nig, fm = gid * WGM, gsz = (nM - fm) < WGM ? (nM - fm) : WGM;
        u.pm = fm + ((wgid % nig) % gsz); u.pn = (wgid % nig) / gsz; return true;
    }
};
typedef f32x4 Acc[2][2][4][2];

template <class Epi>
DI void gemm_phase(ldsp lds, const Gemm g, const StaticOrder& S, const Epi& E) {
    int tid = threadIdx.x; asm volatile("" : "+v"(tid));
    const int wid = __builtin_amdgcn_readfirstlane(tid >> 6), lane = tid & 63, wr = wid >> 2, wc = wid & 3, fr = lane & 15, fq = lane >> 4;
    const int K = g.K, nt = K / BK;
    unsigned voffA[2], voffB[2];
#pragma unroll
    for (int i = 0; i < 2; ++i) { int R, C; stage_rc(tid * 16 + i * 8192, R, C); const int Rb = Epi::PERM ? ((R & ~31) + perm32(R & 31)) : R;
        voffA[i] = (unsigned)(R * g.lda + C) * 2u; voffB[i] = (unsigned)(Rb * g.ldb + C) * 2u; }
    const size_t kstep = (size_t)(BK * 2);
    const size_t hstepA = (size_t)HALF * g.lda * 2, hstepB = (size_t)HALF * g.ldb * 2;
    const size_t tstepA = 2 * hstepA, tstepB = 2 * hstepB;
    const unsigned ldsw = (unsigned)wid * 1024u;
    const int aoff = lds_byte(wr * 64 + fr, fq * 8), boff = lds_byte(wc * 32 + fr, fq * 8);
#define PG8_SA(b, h) (((b) * 2 + (h)) * HTB)
#define PG8_SB(b, h) ((4 + (b) * 2 + (h)) * HTB)
#define PG8_STAGE(bufoff, gbase, voff) do { _Pragma("unroll") for (int _i = 0; _i < 2; ++_i) \
        __builtin_amdgcn_global_load_lds((const unsigned*)((const char*)(gbase) + (voff)[_i]), (LAS unsigned*)(lds + (bufoff) + ldsw + _i * 8192), 16, 0, 0); } while (0)
#define PG8_LDA(dst, b, h) do { _Pragma("unroll") for (int m = 0; m < 4; ++m) _Pragma("unroll") for (int k = 0; k < 2; ++k) dst[m][k] = *(const LAS bf16x8*)(lds + PG8_SA(b, h) + aoff + m * 2048 + k * 1024); } while (0)
#define PG8_LDB(dst, b, h) do { _Pragma("unroll") for (int n = 0; n < 2; ++n) _Pragma("unroll") for (int k = 0; k < 2; ++k) dst[n][k] = *(const LAS bf16x8*)(lds + PG8_SB(b, h) + boff + n * 2048 + k * 1024); } while (0)
#define PG8_MMA(ai, bj, At, Bt) do { __builtin_amdgcn_s_setprio(1); _Pragma("unroll") for (int m = 0; m < 4; ++m) _Pragma("unroll") for (int n = 0; n < 2; ++n) _Pragma("unroll") for (int k = 0; k < 2; ++k) \
        acc[ai][bj][m][n] = __builtin_amdgcn_mfma_f32_16x16x32_bf16(Bt[n][k], At[m][k], acc[ai][bj][m][n], 0, 0, 0); __builtin_amdgcn_s_setprio(0); } while (0)
#define PG8_WAIT_V(n) asm volatile("s_waitcnt vmcnt(" #n ")" ::: "memory")
#define PG8_WAIT_L(n) asm volatile("s_waitcnt lgkmcnt(" #n ")" ::: "memory")
#define PG8_BAR __builtin_amdgcn_s_barrier()
#define PG8_SCHED __builtin_amdgcn_sched_barrier(0)
    Unit cur, nxt; int ui = 0;
    if (!S.next(0, cur)) return;
    if constexpr (Epi::HAS_MID) { E.prep(lds, cur, tid); __syncthreads(); }
    Acc acc;
#pragma unroll
    for (int a = 0; a < 2; ++a)
#pragma unroll
        for (int b = 0; b < 2; ++b)
#pragma unroll
            for (int m = 0; m < 4; ++m)
#pragma unroll
                for (int n = 0; n < 2; ++n) acc[a][b][m][n] = (f32x4){0.f, 0.f, 0.f, 0.f};
    bf16x8 At[4][2], B0[2][2], B1[2][2];
    f32x4 rsA = {0.f, 0.f, 0.f, 0.f}, rsB = rsA;
    const char* cA = (const char*)g.A + (size_t)cur.pm * tstepA; const char* cB = (const char*)g.Bt + (size_t)cur.pn * tstepB;
    PG8_STAGE(PG8_SB(0, 0), cB, voffB); PG8_STAGE(PG8_SB(0, 1), cB + hstepB, voffB); PG8_STAGE(PG8_SA(0, 0), cA, voffA); PG8_STAGE(PG8_SA(0, 1), cA + hstepA, voffA);
    if (wr == 1) PG8_BAR;
    PG8_WAIT_V(2); PG8_BAR;
    PG8_STAGE(PG8_SB(1, 0), cB + kstep, voffB); PG8_STAGE(PG8_SA(1, 0), cA + kstep, voffA); PG8_STAGE(PG8_SB(1, 1), cB + hstepB + kstep, voffB);
    PG8_WAIT_V(6); PG8_BAR;
    for (;;) {
        const bool has_next = S.next(ui + 1, nxt);
        const char* nA = has_next ? (const char*)g.A + (size_t)nxt.pm * tstepA : cA; const char* nB = has_next ? (const char*)g.Bt + (size_t)nxt.pn * tstepB : cB;
        for (int t = 0; t < nt; t += 2) {
            const bool last = (t == nt - 2);
            const char* a1 = cA + (size_t)(t + 1) * kstep;
            const char* a2 = last ? nA : cA + (size_t)(t + 2) * kstep; const char* b2 = last ? nB : cB + (size_t)(t + 2) * kstep;
            const char* a3 = a2 + kstep; const char* b3 = b2 + kstep;
            if constexpr (Epi::HAS_MID) { if (E.is_mid(t)) { E.mid(acc, cur, t, wr, wc, fr, fq, lds); PG8_SCHED; } }
            if constexpr (Epi::ROWSCALE) { if (last && tid < 256) { const f32x4* sp = (const f32x4*)(E.ssp + (size_t)(cur.pm * BM + tid) * 8); rsA = sp[0]; rsB = sp[1]; } }
            PG8_LDB(B0, 0, 0); PG8_LDB(B1, 0, 1); PG8_SCHED; PG8_LDA(At, 0, 0); PG8_STAGE(PG8_SA(1, 1), a1 + hstepA, voffA);
            PG8_WAIT_V(8); PG8_WAIT_L(0); PG8_BAR; PG8_MMA(0, 0, At, B0); PG8_MMA(0, 1, At, B1); PG8_BAR; PG8_SCHED;
            PG8_LDA(At, 0, 1); PG8_STAGE(PG8_SB(0, 0), b2, voffB); PG8_STAGE(PG8_SB(0, 1), b2 + hstepB, voffB); PG8_STAGE(PG8_SA(0, 0), a2, voffA);
            PG8_WAIT_V(8); PG8_WAIT_L(0); PG8_BAR; PG8_MMA(1, 0, At, B0); PG8_MMA(1, 1, At, B1); PG8_BAR; PG8_SCHED;
            PG8_LDB(B0, 1, 0); PG8_LDB(B1, 1, 1); PG8_SCHED; PG8_LDA(At, 1, 0); PG8_STAGE(PG8_SA(0, 1), a2 + hstepA, voffA);
            PG8_WAIT_V(8); PG8_WAIT_L(0); PG8_BAR; PG8_MMA(0, 0, At, B0); PG8_MMA(0, 1, At, B1); PG8_BAR; PG8_SCHED;
            PG8_LDA(At, 1, 1); PG8_STAGE(PG8_SB(1, 0), b3, voffB); PG8_STAGE(PG8_SB(1, 1), b3 + hstepB, voffB); PG8_STAGE(PG8_SA(1, 0), a3, voffA);
            PG8_WAIT_V(8); PG8_WAIT_L(0); PG8_BAR; PG8_MMA(1, 0, At, B0); PG8_MMA(1, 1, At, B1); PG8_BAR; PG8_SCHED;
        }
        if (wr == 0) PG8_BAR;
        if constexpr (Epi::ROWSCALE) {
            LAS float* tab = (LAS float*)(lds + STAGE_BYTES);
            if (tid < 256) { const float t = ((rsA[0] + rsA[1]) + (rsA[2] + rsA[3])) + ((rsB[0] + rsB[1]) + (rsB[2] + rsB[3])); tab[tid] = __builtin_amdgcn_rsqf(t * (1.f / (float)DM) + EPS); }
            PG8_WAIT_L(0); PG8_BAR; asm volatile("" ::: "memory");
        }
        E(acc, cur, wr, wc, fr, fq, lds);
        if (!has_next) break;
#pragma unroll
        for (int a = 0; a < 2; ++a)
#pragma unroll
            for (int b = 0; b < 2; ++b)
#pragma unroll
                for (int m = 0; m < 4; ++m)
#pragma unroll
                    for (int n = 0; n < 2; ++n) acc[a][b][m][n] = (f32x4){0.f, 0.f, 0.f, 0.f};
        cur = nxt; cA = nA; cB = nB; ++ui;
        if constexpr (Epi::HAS_MID) { PG8_BAR; E.prep(lds, cur, tid); PG8_WAIT_L(0); PG8_BAR; }
        if (wr == 1) PG8_BAR;
    }
    PG8_WAIT_V(0);
    PG8_BAR;
#undef PG8_SA
#undef PG8_SB
#undef PG8_STAGE
#undef PG8_LDA
#undef PG8_LDB
#undef PG8_MMA
#undef PG8_WAIT_V
#undef PG8_WAIT_L
#undef PG8_BAR
#undef PG8_SCHED
}

DI void store8(bf16_t* p, const f32x4 v0, const f32x4 v1) { u32x4 w; w.x = pk2(v0[0], v0[1]); w.y = pk2(v0[2], v0[3]); w.z = pk2(v1[0], v1[1]); w.w = pk2(v1[2], v1[3]); *(u32x4*)p = w; }
struct EpiIn {
    static constexpr bool PERM = true, HAS_MID = false, ROWSCALE = true;
    bf16_t* mix; bf16_t* gates; const float* gate_b; const float* ssp;
    DI void operator()(const Acc& acc, const Unit& u, int wr, int wc, int fr, int fq, ldsp lds) const {
        const int row0 = u.pm * BM + wr * 64 + fr; const LAS float* tab = (const LAS float*)(lds + STAGE_BYTES);
        if (u.pn < NMIX / BM) {
            const int col0 = u.pn * BM + wc * 32 + 8 * fq;
#pragma unroll
            for (int ai = 0; ai < 2; ++ai)
#pragma unroll
                for (int m = 0; m < 4; ++m) { const float rs = tab[wr * 64 + fr + ai * HALF + m * 16]; bf16_t* rowp = mix + (size_t)(row0 + ai * HALF + m * 16) * NMIX + col0;
#pragma unroll
                    for (int bj = 0; bj < 2; ++bj) store8(rowp + bj * HALF, acc[ai][bj][m][0] * rs, acc[ai][bj][m][1] * rs); }
        } else {
            const int ch8 = (u.pn - NMIX / BM) * 64 + wc * 16 + 8 * (fq & 1), ch0 = ch8 + 4 * (fq >> 1), h = fq >> 1;
            f32x4 bv[4];
#pragma unroll
            for (int i = 0; i < 4; ++i) bv[i] = *(const f32x4*)(gate_b + i * DM + ch0);
#pragma unroll
            for (int ai = 0; ai < 2; ++ai)
#pragma unroll
                for (int m = 0; m < 4; ++m) { const float rs = tab[wr * 64 + fr + ai * HALF + m * 16]; bf16_t* rowp = gates + (size_t)(row0 + ai * HALF + m * 16) * NGATE + ch8;
                    f32x4 d[4], e[4];
#pragma unroll
                    for (int i = 0; i < 4; ++i) { const f32x4 x = acc[ai][i >> 1][m][i & 1] * rs + bv[i];
#pragma unroll
                        for (int j = 0; j < 4; ++j) { d[i][j] = fminf(1.f + __builtin_amdgcn_exp2f(-LOG2E * x[j]), 1e20f); e[i][j] = __builtin_amdgcn_rcpf(d[i][j]); } }
#pragma unroll
                    for (int k = 0; k < 4; k += 2) { const f32x4 ra = e[k] * d[k + 1], rb = (k + 1 < 3) ? e[k + 1] * d[k + 1 < 3 ? k + 2 : 3] : e[3];
                        const auto rx = __builtin_amdgcn_permlane32_swap(pk2(ra[0], ra[1]), pk2(rb[0], rb[1]), false, false), ry = __builtin_amdgcn_permlane32_swap(pk2(ra[2], ra[3]), pk2(rb[2], rb[3]), false, false);
                        u32x4 w; w.x = rx[0]; w.y = ry[0]; w.z = rx[1]; w.w = ry[1];
                        *(u32x4*)(rowp + (k + h) * DM) = w; } }
        }
    }
};
template <int ACT  > struct EpiBf16 {
    static constexpr bool PERM = true, HAS_MID = false, ROWSCALE = (ACT == 1);
    bf16_t* O; int ldc; const float* ssp;
    DI void operator()(const Acc& acc, const Unit& u, int wr, int wc, int fr, int fq, ldsp lds) const {
        const int row0 = u.pm * BM + wr * 64 + fr, col0 = u.pn * BM + wc * 32 + 8 * fq; const LAS float* tab = (const LAS float*)(lds + STAGE_BYTES);
#pragma unroll
        for (int ai = 0; ai < 2; ++ai)
#pragma unroll
            for (int m = 0; m < 4; ++m) { bf16_t* rowp = O + (size_t)(row0 + ai * HALF + m * 16) * ldc + col0;
                float rs2 = 1.f; if (ACT == 1) { const float rs = tab[wr * 64 + fr + ai * HALF + m * 16]; rs2 = rs * rs; }
#pragma unroll
                for (int bj = 0; bj < 2; ++bj) { f32x4 v0 = acc[ai][bj][m][0], v1 = acc[ai][bj][m][1];
                    if (ACT == 1) {
#pragma unroll
                        for (int j = 0; j < 4; ++j) { const float a = fmaxf(v0[j], 0.f), b = fmaxf(v1[j], 0.f); v0[j] = a * a * rs2; v1[j] = b * b * rs2; } }
                    store8(rowp + bj * HALF, v0, v1); } }
    }
};
template <int RES, int OUTF> struct EpiResid {
    static constexpr bool PERM = true, HAS_MID = false, ROWSCALE = false;
    const void* resid; float* out; bf16_t* xb; float* ssp; int ldc;
    DI void operator()(const Acc& acc, const Unit& u, int wr, int wc, int fr, int fq, ldsp lds) const {
        const int row0 = u.pm * BM + wr * 64 + fr, col0 = u.pn * BM + wc * 32 + 8 * fq;
#pragma unroll
        for (int ai = 0; ai < 2; ++ai) {
            f32x4 rf[RES == 0 ? 4 : 1][2][2]; u32x4 rw[RES == 1 ? 4 : 1][2];
#pragma unroll
            for (int m = 0; m < 4; ++m) { const size_t off = (size_t)(row0 + ai * HALF + m * 16) * ldc + col0;
#pragma unroll
                for (int bj = 0; bj < 2; ++bj) {
                    if (RES == 0) { rf[RES == 0 ? m : 0][bj][0] = *(const f32x4*)((const float*)resid + off + bj * HALF); rf[RES == 0 ? m : 0][bj][1] = *(const f32x4*)((const float*)resid + off + bj * HALF + 4); }
                    else rw[RES == 1 ? m : 0][bj] = *(const u32x4*)((const bf16_t*)resid + off + bj * HALF); } }
#pragma unroll
            for (int m = 0; m < 4; ++m) { const int row = row0 + ai * HALF + m * 16; const size_t off = (size_t)row * ldc + col0; float ss = 0.f;
#pragma unroll
                for (int bj = 0; bj < 2; ++bj) { f32x4 r0, r1;
                    if (RES == 0) { r0 = rf[RES == 0 ? m : 0][bj][0]; r1 = rf[RES == 0 ? m : 0][bj][1]; }
                    else { float f[8]; unpack8(rw[RES == 1 ? m : 0][bj], f); r0 = (f32x4){f[0], f[1], f[2], f[3]}; r1 = (f32x4){f[4], f[5], f[6], f[7]}; }
                    const f32x4 o0 = r0 + acc[ai][bj][m][0], o1 = r1 + acc[ai][bj][m][1];
                    if (OUTF) { *(f32x4*)(out + off + bj * HALF) = o0; *(f32x4*)(out + off + bj * HALF + 4) = o1; }
                    else { ss += ((o0[0] * o0[0] + o0[1] * o0[1]) + (o0[2] * o0[2] + o0[3] * o0[3])) + ((o1[0] * o1[0] + o1[1] * o1[1]) + (o1[2] * o1[2] + o1[3] * o1[3])); store8(xb + off + bj * HALF, o0, o1); } }
                if (!OUTF) { ss += shx(ss, 16, fr + 16 * fq); ss += shx(ss, 32, fr + 16 * fq); if (fq == 0) ((LAS float*)(lds + STAGE_BYTES))[(wr * 64 + fr + ai * HALF + m * 16) * 4 + wc] = ss; } } }
        if (!OUTF) {
            asm volatile("s_waitcnt lgkmcnt(0)" ::: "memory"); __builtin_amdgcn_s_barrier(); asm volatile("" ::: "memory");
            const int t = 64 * (4 * wr + wc) + fr + 16 * fq;
            if (t < 256) { const f32x4 q = *(const LAS f32x4*)(lds + STAGE_BYTES + t * 16); ssp[(size_t)(u.pm * BM + t) * 8 + u.pn] = (q[0] + q[1]) + (q[2] + q[3]); }
        }
    }
};
struct EpiMerge {
    static constexpr bool PERM = true, HAS_MID = true, ROWSCALE = false;
    bf16_t* O; const bf16_t* gates; const float* ssqh; const bf16_t* ones;
    DI bool is_mid(int t) const { return t == 8 || t == 16 || t == 24 || t == 32; }
    DI void prep(ldsp lds, const Unit& u, int tid) const {
        if (tid < 256) { const f32x4* p = (const f32x4*)(ssqh + (size_t)(u.pm * BM + tid) * 16); const f32x4 a = p[0], b = p[1], c = p[2], d = p[3];
            const float s0 = ((a[0] + a[1]) + (a[2] + a[3])) + ((b[0] + b[1]) + (b[2] + b[3])), s1 = ((c[0] + c[1]) + (c[2] + c[3])) + ((d[0] + d[1]) + (d[2] + d[3]));
            LAS float* tab = (LAS float*)(lds + STAGE_BYTES) + 2 * tid; tab[0] = __builtin_amdgcn_rsqf(s0 * (1.f / 512.f) + EPS); tab[1] = __builtin_amdgcn_rsqf(s1 * (1.f / 512.f) + EPS); }
    }
    DI void ld8(const bf16_t* p, float (&f)[8]) const { unpack8(*(const u32x4*)p, f); }
    DI void ldb(u32x4 (&g)[2][2], const bf16_t* pl, size_t pitch, int row0, int b) const {
#pragma unroll
        for (int m2 = 0; m2 < 2; ++m2)
#pragma unroll
            for (int bj = 0; bj < 2; ++bj) g[m2][bj] = *(const u32x4*)(pl + (size_t)(row0 + (b >> 1) * HALF + (2 * (b & 1) + m2) * 16) * pitch + bj * HALF);
    }
    DI void mid(Acc& acc, const Unit& u, int t, int wr, int wc, int fr, int fq, ldsp lds) const {
        int row0 = u.pm * BM + wr * 64 + fr; asm volatile("" : "+v"(row0));
        const int col0 = u.pn * BM + wc * 32 + 8 * fq;
        const int seg = t >> 3;
        const bf16_t* pl = (seg < 4 ? gates + (seg - 1) * DM : ones) + col0; const size_t pitch = seg < 4 ? (size_t)NGATE : (size_t)0;
        const unsigned m3 = (seg == 3) ? 0xffffffffu : 0u, m4 = (seg == 4) ? 0xffffffffu : 0u, one = 0x3f800000u;
        const LAS f32x2* tab = (const LAS f32x2*)(lds + STAGE_BYTES);
        u32x4 gb[2][2][2];
        ldb(gb[0], pl, pitch, row0, 0);
#pragma unroll
        for (int b = 0; b < 4; ++b) { const int ai = b >> 1, mh = b & 1;
            if (b + 1 < 4) ldb(gb[(b + 1) & 1], pl, pitch, row0, b + 1);
#pragma unroll
            for (int m2 = 0; m2 < 2; ++m2) { const int m = 2 * mh + m2; const f32x2 r = tab[wr * 64 + fr + ai * HALF + m * 16];
                const unsigned u0 = __float_as_uint(r[0]), u1 = __float_as_uint(r[1]);
                const float sa = __uint_as_float((u0 & m4) | (one & ~m4)), sb = __uint_as_float((u0 & m3) | (u1 & m4) | (one & ~(m3 | m4)));
                const float rr = sa * __builtin_amdgcn_rcpf(sb);
#pragma unroll
                for (int bj = 0; bj < 2; ++bj) { float q[8]; unpack8(gb[b & 1][m2][bj], q);
#pragma unroll
                    for (int j = 0; j < 4; ++j) { acc[ai][bj][m][0][j] *= q[j] * rr; acc[ai][bj][m][1][j] *= q[4 + j] * rr; } } }
            asm volatile("" ::: "memory"); }
    }
    DI void operator()(const Acc& acc, const Unit& u, int wr, int wc, int fr, int fq, ldsp lds) const {
        const int row0 = u.pm * BM + wr * 64 + fr, col0 = u.pn * BM + wc * 32 + 8 * fq;
        const LAS f32x2* tab = (const LAS f32x2*)(lds + STAGE_BYTES);
#pragma unroll
        for (int ai = 0; ai < 2; ++ai) {
            u32x4 gg[4][2];
#pragma unroll
            for (int m = 0; m < 4; ++m)
#pragma unroll
                for (int bj = 0; bj < 2; ++bj) gg[m][bj] = *(const u32x4*)(gates + (size_t)(row0 + ai * HALF + m * 16) * NGATE + 3 * DM + col0 + bj * HALF);
#pragma unroll
            for (int m = 0; m < 4; ++m) { const int row = row0 + ai * HALF + m * 16; const float r1 = tab[wr * 64 + fr + ai * HALF + m * 16][1];
#pragma unroll
                for (int bj = 0; bj < 2; ++bj) { float g[8]; unpack8(gg[m][bj], g); f32x4 v0 = acc[ai][bj][m][0], v1 = acc[ai][bj][m][1];
#pragma unroll
                    for (int j = 0; j < 4; ++j) { v0[j] *= g[j] * r1; v1[j] *= g[4 + j] * r1; }
                    store8(O + (size_t)row * DM + col0 + bj * HALF, v0, v1); } }
            asm volatile("" ::: "memory"); }
    }
};
}

struct Params {
    const float* x; const float* norm1_g; const float* w_in; const float* gate_b; const float* fox_f_b; const float* fox_qn_g; const float* fox_kn_g;
    const float* dsa_cq_g; const float* dsa_w_uq; const float* dsa_w_qidx; const float* dsa_qn_g; const float* dsa_kn_g; const float* rel_bias;
    const float* ssd_conv_w; const float* ssd_conv_b; const float* ssd_dt_bias; const float* ssd_a_log; const float* ssd_d; const float* ssd_norm_g;
    const float* w_br; const float* w_out; const float* norm2_g; const float* w_ff1; const float* w_ff2;
    float* out; unsigned char* ws;
    int ph_lo, ph_hi, rep, pad;
};
struct Ctx {
    ldsp lds; int tid, lane, wave, G, bid;
    gu32* ctl;
};
DI Ctx fresh(const Ctx& c0) { Ctx c = c0; int t = c0.tid; asm volatile("" : "+v"(t)); c.tid = t; c.lane = t & 63; c.wave = __builtin_amdgcn_readfirstlane(t >> 6); return c; }
DI Params freshp(const Params& p0) { Params p = p0; GAS unsigned char* w = (GAS unsigned char*)p0.ws; asm volatile("" : "+s"(w)); p.ws = (unsigned char*)w; return p; }
typedef __attribute__((address_space(4))) const Params* kargp;
DI Params loadp() {
#if defined(__HIP_DEVICE_COMPILE__)
    kargp k = (kargp)__builtin_amdgcn_kernarg_segment_ptr(); asm volatile("" : "+s"(k)); Params p = *k;
    GAS unsigned char* w = (GAS unsigned char*)p.ws; asm volatile("" : "+s"(w)); p.ws = (unsigned char*)w; return p;
#else
    return Params{};
#endif
}
DI bf16_t* wsb(const Params& p, size_t off) { return (bf16_t*)(p.ws + off); }
DI float*  wsf(const Params& p, size_t off) { return (float*)(p.ws + off); }

DI int next_unit(const Ctx& c, int layer, int q) {
    volatile LAS int* slot = (volatile LAS int*)(c.lds + LDS_MISC);
    __syncthreads();
    int qi = (layer * NQUEUE + q) * 64; asm volatile("" : "+s"(qi));
    if (c.tid == 0) *slot = (int)__hip_atomic_fetch_add((unsigned*)(c.ctl + CW_QUEUE + qi), 1u, __ATOMIC_RELAXED, __HIP_MEMORY_SCOPE_AGENT);
    __syncthreads();
    return *slot;
}

DI int in_dest_row(int n) {
    if (n < 3584) return n;
    if (n < 3588) return C_FF + (n - 3584);
    if (n < 4420) return n - 4;
    if (n < 4436) return C_IW + (n - 4420);
    if (n < 6996) return n - 20;
    if (n < 7012) return n - 4;
    const int g = n - 7012, i = g >> 11, ch = g & 2047, tp = ch >> 6, cl = ch & 63;
    return NMIX + 256 * tp + 128 * (i >> 1) + 32 * (cl >> 4) + 8 * (((cl >> 3) & 1) + 2 * ((cl >> 2) & 1)) + 4 * (i & 1) + (cl & 3);
}
template <int MAP>
DI void transpose_item(const float* W, int K, int N, bf16_t* WT, int ldk, int row_off, const float* kscale, LAS float* scr, int item, int lane) {
    const int nblk = (N + 63) / 64, kb = item / nblk, nb = item % nblk, k0 = 64 * kb, n0 = 64 * nb;
    const int nq = n0 + 4 * (lane & 15); const bool nok = nq < N;
    f32x4 v[16];
#pragma unroll
    for (int i = 0; i < 16; ++i) { const int kk = 4 * i + (lane >> 4); v[i] = nok ? *(const f32x4*)(W + (size_t)(k0 + kk) * N + nq) : (f32x4){0.f, 0.f, 0.f, 0.f}; }
    const int c = lane & 7;
    f32x4 s0 = {1.f, 1.f, 1.f, 1.f}, s1 = s0; if (kscale) { s0 = *(const f32x4*)(kscale + k0 + 8 * c); s1 = *(const f32x4*)(kscale + k0 + 8 * c + 4); }
#pragma unroll
    for (int i = 0; i < 16; ++i) { const int kk = 4 * i + (lane >> 4); LAS float* d = scr + kk * 65 + 4 * (lane & 15); d[0] = v[i][0]; d[1] = v[i][1]; d[2] = v[i][2]; d[3] = v[i][3]; }
    asm volatile("s_waitcnt lgkmcnt(0)" ::: "memory");
#pragma unroll
    for (int j = 0; j < 8; ++j) { const int n = (lane >> 3) + 8 * j; const LAS float* s = scr + (8 * c) * 65 + n;
        u32x4 o; o.x = pk2(s[0 * 65] * s0[0], s[1 * 65] * s0[1]); o.y = pk2(s[2 * 65] * s0[2], s[3 * 65] * s0[3]); o.z = pk2(s[4 * 65] * s1[0], s[5 * 65] * s1[1]); o.w = pk2(s[6 * 65] * s1[2], s[7 * 65] * s1[3]);
        if (n0 + n < N) { const int dr = MAP ? in_dest_row(n0 + n) : row_off + n0 + n; *(u32x4*)(WT + (size_t)dr * ldk + k0 + 8 * c) = o; } }
    asm volatile("s_waitcnt lgkmcnt(0)" ::: "memory");
}
constexpr int I_IN = (DM / 64) * ((IN_TOTAL + 63) / 64), I_UQ = (KUP / 64) * (512 / 64), I_QI = (KUP / 64) * (1024 / 64), I_BR = (KBR / 64) * (DM / 64),
              I_OUT = (DM / 64) * (DM / 64), I_F1 = (DM / 64) * (DFF / 64), I_F2 = (DFF / 64) * (DM / 64), PER_LAYER = I_IN + I_UQ + I_QI + I_BR + I_OUT + I_F1 + I_F2;
DI void convert_items(const Params& p0, const Ctx& c0, int l, int lo, int hi, int wv, int nw) {
    const Ctx c = fresh(c0); const Params p = freshp(p0);
    LAS float* scr = (LAS float*)(c.lds + c.wave * 16640);
    unsigned char* wl = p.ws + WS_W + (size_t)l * WL_SIZE;
    for (int it = lo + wv; it < hi; it += nw) {
        int r = it;
        if (r < I_IN) { transpose_item<1>(p.w_in + (size_t)l * DM * IN_TOTAL, DM, IN_TOTAL, (bf16_t*)(wl + WL_IN), DM, 0, p.norm1_g + l * DM, scr, r, c.lane); continue; } r -= I_IN;
        if (r < I_UQ) { transpose_item<0>(p.dsa_w_uq + (size_t)l * KUP * 512, KUP, 512, (bf16_t*)(wl + WL_UP), KUP, 0, p.dsa_cq_g + l * KUP, scr, r, c.lane); continue; } r -= I_UQ;
        if (r < I_QI) { transpose_item<0>(p.dsa_w_qidx + (size_t)l * KUP * 1024, KUP, 1024, (bf16_t*)(wl + WL_UP), KUP, 512, p.dsa_cq_g + l * KUP, scr, r, c.lane); continue; } r -= I_QI;
        if (r < I_BR) { transpose_item<0>(p.w_br + (size_t)l * KBR * DM, KBR, DM, (bf16_t*)(wl + WL_BR), KBR, 0, nullptr, scr, r, c.lane); continue; } r -= I_BR;
        if (r < I_OUT) { transpose_item<0>(p.w_out + (size_t)l * DM * DM, DM, DM, (bf16_t*)(wl + WL_OUT), DM, 0, nullptr, scr, r, c.lane); continue; } r -= I_OUT;
        if (r < I_F1) { transpose_item<0>(p.w_ff1 + (size_t)l * DM * DFF, DM, DFF, (bf16_t*)(wl + WL_FF1), DM, 0, p.norm2_g + l * DM, scr, r, c.lane); continue; } r -= I_F1;
        transpose_item<0>(p.w_ff2 + (size_t)l * DFF * DM, DFF, DM, (bf16_t*)(wl + WL_FF2), DFF, 0, nullptr, scr, r, c.lane);
    }
}
constexpr int CV_B = 3072;
DI void convert_on_idle(const Params& p, const Ctx& c, int l, int lo, int hi, int nunits) {
    const int first_idle = nunits % c.G;
    if (first_idle == 0) convert_items(p, c, l, lo, hi, c.bid * 8 + c.wave, c.G * 8);
    else if (c.bid >= first_idle) convert_items(p, c, l, lo, hi, (c.bid - first_idle) * 8 + c.wave, (c.G - first_idle) * 8);
}
DI void p0_prologue(const Params& p0, const Ctx& c0) {
    const Ctx c = fresh(c0); const Params p = freshp(p0);
    convert_items(p, c, 0, 0, I_IN, c.bid * 8 + c.wave, c.G * 8);
    if (c.bid == 0 && c.tid < 256) *(u32x4*)(wsb(p, WS_ONES) + 8 * c.tid) = (u32x4){0x3f803f80u, 0x3f803f80u, 0x3f803f80u, 0x3f803f80u};
    constexpr int PADROWS = NMIX - C_MIXEND, CH = DM / 8;
    for (int i = (c.bid * 512 + c.tid); i < DEPTH * PADROWS * CH; i += c.G * 512) { const int l = i / (PADROWS * CH), r = (i / CH) % PADROWS, ch = i % CH;
        *(u32x4*)((bf16_t*)(p.ws + WS_W + (size_t)l * WL_SIZE + WL_IN) + (size_t)(C_MIXEND + r) * DM + ch * 8) = (u32x4){0u, 0u, 0u, 0u}; }
}

DI float wave_sum(float v, int lane) {
#pragma unroll
    for (int o = 1; o < 64; o <<= 1) v += shx(v, o, lane);
    return v;
}
DI void xprep_phase(const Ctx& c0, const float* x, bf16_t* xb, float* ssp) {
    const Ctx c = fresh(c0);
    const int gw = c.bid * 8 + c.wave, NGW = c.G * 8;
    for (int m = gw; m < MTOK; m += NGW) {
        const f32x4* xr = (const f32x4*)(x + (size_t)m * DM) + c.lane;
        f32x4 v[8]; float s = 0.f;
#pragma unroll
        for (int j = 0; j < 8; ++j) { v[j] = xr[64 * j]; s += (v[j][0] * v[j][0] + v[j][1] * v[j][1]) + (v[j][2] * v[j][2] + v[j][3] * v[j][3]); }
        s = wave_sum(s, c.lane);
        u32x2* o = (u32x2*)(xb + (size_t)m * DM) + c.lane;
#pragma unroll
        for (int j = 0; j < 8; ++j) { u32x2 w; w.x = pk2(v[j][0], v[j][1]); w.y = pk2(v[j][2], v[j][3]); o[64 * j] = w; }
        if (c.lane < 8) ssp[(size_t)m * 8 + c.lane] = (c.lane == 0) ? s : 0.f;
    }
}

DI void scan_phase(const Params& p0, const Ctx& c0) {
    const Ctx c = fresh(c0); const Params p = freshp(p0);
    const float* kvs = wsf(p, WS_KVS); bf16_t* prevr = wsb(p, WS_PREVR); const float* st = wsf(p, WS_ST); bf16_t* prevs = wsb(p, WS_PREVS); const float* acs = wsf(p, WS_ACS);
    const int gt = c.bid * 512 + c.tid, NT = c.G * 512;
    for (int e = gt; e < 16 * 4096; e += NT) {
        const int bh = e / 4096, q = e % 4096, h = bh & 3;
        const float cd = __expf(128.f * log1pf(-exp2f(-5.f - (float)h)));
        f32x4 kv[16];
#pragma unroll
        for (int n = 0; n < 16; ++n) kv[n] = *(const f32x4*)(kvs + ((size_t)(bh * 16 + n) * 16384) + (size_t)q * 4);
        f32x4 s = {0.f, 0.f, 0.f, 0.f};
#pragma unroll
        for (int n = 0; n < 16; ++n) { const size_t o = ((size_t)(bh * 16 + n) * 16384) + (size_t)q * 4;
            u32x2 w; w.x = pk2(s[0], s[1]); w.y = pk2(s[2], s[3]); *(u32x2*)(prevr + o) = w; s = s * cd + kv[n]; }
    }
    for (int e = gt; e < 64 * 2048; e += NT) {
        const int bhd = e / 2048, q = e % 2048, b = bhd >> 4, hd = bhd & 15;
        f32x4 v[16]; float cd[16];
#pragma unroll
        for (int n = 0; n < 16; ++n) { v[n] = *(const f32x4*)(st + ((size_t)((b * 16 + n) * 16 + hd) * 8192) + (size_t)q * 4); cd[n] = acs[(size_t)(b * SEQ + 128 * n + 127) * 16 + hd]; }
        f32x4 s = {0.f, 0.f, 0.f, 0.f};
#pragma unroll
        for (int n = 0; n < 16; ++n) { const size_t o = ((size_t)((b * 16 + n) * 16 + hd) * 8192) + (size_t)q * 4;
            u32x2 w; w.x = pk2(s[0], s[1]); w.y = pk2(s[2], s[3]); *(u32x2*)(prevs + o) = w; s = s * __expf(cd[n]) + v[n]; }
    }
}

struct LaneIds { int r, h, blk, q, pp; };
DI LaneIds lane_ids(int lane) { LaneIds L; L.r = lane & 31; L.h = lane >> 5; L.blk = (lane >> 4) & 1; L.q = (lane & 15) >> 2; L.pp = lane & 3; return L; }
DI int tr_nat_off(const LaneIds& L, int st) { return (8 * L.h + L.q) * st + 32 * L.blk + 8 * L.pp; }
DI int tr_krow_off(const LaneIds& L, int st) { return (4 * L.h + L.q) * st + 32 * L.blk + 8 * L.pp; }
DI bf16x8 pack_half(const f32x16& x, int s) { return pack8(x[8 * s], x[8 * s + 1], x[8 * s + 2], x[8 * s + 3], x[8 * s + 4], x[8 * s + 5], x[8 * s + 6], x[8 * s + 7]); }
DI float softplusf_(float x) { return x > 20.f ? x : log1pf(__expf(x)); }

DI void ssdst_unit(const Params& p0, const Ctx& c0, int layer, int u) {
    const Ctx c = fresh(c0); const Params p = freshp(p0);
    const int b = u >> 6, n = (u >> 2) & 15, g = (u >> 1) & 1, half = u & 1, T0 = b * SEQ + 128 * n;
    const bf16_t* mix = wsb(p, WS_MIX); bf16_t* xbcc = wsb(p, WS_XBCC); float* acsg = wsf(p, WS_ACS); float* bsg = wsf(p, WS_BS); float* stg = wsf(p, WS_ST);
    ldsp Xt = c.lds, Bt = c.lds + 73728; LAS float* sdec = (LAS float*)(c.lds + 73728 + 40960);
    const LaneIds L = lane_ids(c.lane);
    if (c.wave < 4) {
        const int hd = g * 8 + half * 4 + c.wave; const float dtb = p.ssd_dt_bias[layer * 16 + hd], A = -__expf(p.ssd_a_log[layer * 16 + hd]);
        const int l0 = 2 * c.lane;
        const float dt0 = softplusf_(bf2f(mix[(size_t)(T0 + l0) * NMIX + C_SDT + hd]) + dtb), dt1 = softplusf_(bf2f(mix[(size_t)(T0 + l0 + 1) * NMIX + C_SDT + hd]) + dtb);
        const float a0 = dt0 * A, a1 = dt1 * A; float s = a0 + a1;
#pragma unroll
        for (int o = 1; o < 64; o <<= 1) { const float t = shidx(s, c.lane - o); if (c.lane >= o) s += t; }
        const float c1 = s, c0 = s - a1, last = shidx(s, 63);
        acsg[(size_t)(T0 + l0) * 16 + hd] = c0; acsg[(size_t)(T0 + l0 + 1) * 16 + hd] = c1;
        bsg[(size_t)(T0 + l0) * 16 + hd] = -c0 + __logf(dt0); bsg[(size_t)(T0 + l0 + 1) * 16 + hd] = -c1 + __logf(dt1);
        sdec[c.wave * 128 + l0] = dt0 * __expf(last - c0); sdec[c.wave * 128 + l0 + 1] = dt1 * __expf(last - c1);
    }
    __syncthreads();
    const int NCH = half ? 64 : 48;
    const float* cw = p.ssd_conv_w + (size_t)layer * 4 * 1536; const float* cb = p.ssd_conv_b + (size_t)layer * 1536;
    {
        const int cc = c.lane, l0 = 16 * c.wave;
        if (cc < NCH) {
            int ch; if (cc < 32) ch = g * 512 + half * 256 + 8 * cc; else if (cc < 48) ch = 1024 + g * 128 + 8 * (cc - 32); else ch = 1280 + g * 128 + 8 * (cc - 48);
            const int mcol = C_SX + ch;
            u32x4 xr[19];
#pragma unroll
            for (int i = 0; i < 19; ++i) { const int tl = 128 * n + l0 - 3 + i; xr[i] = (tl >= 0) ? *(const u32x4*)(mix + (size_t)(b * SEQ + tl) * NMIX + mcol) : (u32x4){0u, 0u, 0u, 0u}; }
            float w[4][8], bs8[8];
#pragma unroll
            for (int j = 0; j < 4; ++j) { const f32x4 w0 = *(const f32x4*)(cw + j * 1536 + ch), w1 = *(const f32x4*)(cw + j * 1536 + ch + 4);
                w[j][0] = w0[0]; w[j][1] = w0[1]; w[j][2] = w0[2]; w[j][3] = w0[3]; w[j][4] = w1[0]; w[j][5] = w1[1]; w[j][6] = w1[2]; w[j][7] = w1[3]; }
            { const f32x4 b0 = *(const f32x4*)(cb + ch), b1 = *(const f32x4*)(cb + ch + 4); bs8[0] = b0[0]; bs8[1] = b0[1]; bs8[2] = b0[2]; bs8[3] = b0[3]; bs8[4] = b1[0]; bs8[5] = b1[1]; bs8[6] = b1[2]; bs8[7] = b1[3]; }
#pragma unroll
            for (int i = 0; i < 16; ++i) { const int l = l0 + i; float a[8];
#pragma unroll
                for (int e = 0; e < 8; ++e) a[e] = bs8[e];
#pragma unroll
                for (int j = 0; j < 4; ++j) { float xv[8]; unpack8(xr[i + j], xv);
#pragma unroll
                    for (int e = 0; e < 8; ++e) a[e] += w[j][e] * xv[e]; }
#pragma unroll
                for (int e = 0; e < 8; ++e) a[e] = siluf_(a[e]);
                const bf16x8 v = pack8(a[0], a[1], a[2], a[3], a[4], a[5], a[6], a[7]);
                if (cc < 32) { *(bf16x8*)(xbcc + (size_t)(T0 + l) * 1536 + ch) = v; const float sc = sdec[(cc >> 3) * 128 + l];
                    *(LAS bf16x8*)(Xt + l * 576 + cc * 16) = pack8(a[0] * sc, a[1] * sc, a[2] * sc, a[3] * sc, a[4] * sc, a[5] * sc, a[6] * sc, a[7] * sc); }
                else if (cc < 48) { if (half == 0) *(bf16x8*)(xbcc + (size_t)(T0 + l) * 1536 + ch) = v; *(LAS bf16x8*)(Bt + l * 320 + (cc - 32) * 16) = v; }
                else *(bf16x8*)(xbcc + (size_t)(T0 + l) * 1536 + ch) = v;
            }
        }
    }
    __syncthreads();
    {
        const int hq = c.wave & 3, kh = c.wave >> 2, hd = g * 8 + half * 4 + hq;
        f32x16 acc[2][2]; for (int i = 0; i < 2; ++i) for (int j = 0; j < 2; ++j) acc[i][j] = zero16();
        ldsp xa = Xt + tr_nat_off(L, 576) + hq * 128, ba = Bt + tr_nat_off(L, 320) + kh * 128;
#pragma unroll
        for (int ks = 0; ks < 8; ++ks) {
            bf16x8 A[2], Bf[2];
#pragma unroll
            for (int t = 0; t < 2; ++t) { A[t] = tr_pair(xa + ks * 16 * 576 + t * 64, 4 * 576); Bf[t] = tr_pair(ba + ks * 16 * 320 + t * 64, 4 * 320); }
#pragma unroll
            for (int pt = 0; pt < 2; ++pt)
#pragma unroll
                for (int kt = 0; kt < 2; ++kt) acc[pt][kt] = MFMA32(A[pt], Bf[kt], acc[pt][kt]);
        }
        float* o = stg + (size_t)((b * 16 + n) * 16 + hd) * 8192;
#pragma unroll
        for (int pt = 0; pt < 2; ++pt)
#pragma unroll
            for (int kt = 0; kt < 2; ++kt)
#pragma unroll
                for (int i = 0; i < 16; ++i) o[(32 * pt + crow(i, L.h)) * 128 + kh * 64 + 32 * kt + L.r] = acc[pt][kt][i];
    }
}
DI void ssdo_unit(const Params& p0, const Ctx& c0, int layer, int u) {
    const Ctx c = fresh(c0); const Params p = freshp(p0);
    const int b = u >> 6, n = (u >> 2) & 15, g = (u >> 1) & 1, half = u & 1, T0 = b * SEQ + 128 * n;
    const bf16_t* mix = wsb(p, WS_MIX); const bf16_t* xbcc = wsb(p, WS_XBCC); const float* acsg = wsf(p, WS_ACS); const float* bsg = wsf(p, WS_BS);
    const bf16_t* prevs = wsb(p, WS_PREVS); bf16_t* oall = wsb(p, WS_OALL); float* ssqh = wsf(p, WS_SSQH);
    ldsp XS = c.lds, BC = c.lds + 73728; LAS float* tacs = (LAS float*)(c.lds + 73728 + 34816); LAS float* tbs = tacs + 512;
    const LaneIds L = lane_ids(c.lane);
    const int hq = c.wave & 3, pr = c.wave >> 2, hd = g * 8 + half * 4 + hq;
    const bf16_t* prv = prevs + (size_t)((b * 16 + n) * 16 + hd) * 8192;
    u32x4 xs8[8], bc4[4];
#pragma unroll
    for (int i = 0; i < 8; ++i) { const int it = c.tid + 512 * i, l = it >> 5, cc = it & 31; xs8[i] = *(const u32x4*)(xbcc + (size_t)(T0 + l) * 1536 + g * 512 + half * 256 + 8 * cc); }
#pragma unroll
    for (int i = 0; i < 4; ++i) { const int it = c.tid + 512 * i, l = it >> 4, cc = it & 15; bc4[i] = *(const u32x4*)(xbcc + (size_t)(T0 + l) * 1536 + 1024 + g * 128 + 8 * cc); }
    const float ta = acsg[(size_t)(T0 + (c.tid & 127)) * 16 + g * 8 + half * 4 + (c.tid >> 7)], tb = bsg[(size_t)(T0 + (c.tid & 127)) * 16 + g * 8 + half * 4 + (c.tid >> 7)];
    bf16x8 Ap[2][8];
#pragma unroll
    for (int pt = 0; pt < 2; ++pt)
#pragma unroll
        for (int ks = 0; ks < 8; ++ks) Ap[pt][ks] = *(const bf16x8*)(prv + (32 * pt + L.r) * 128 + 16 * ks + 8 * L.h);
#pragma unroll
    for (int i = 0; i < 8; ++i) { const int it = c.tid + 512 * i, l = it >> 5, cc = it & 31; *(LAS u32x4*)(XS + l * 576 + cc * 16) = xs8[i]; }
#pragma unroll
    for (int i = 0; i < 4; ++i) { const int it = c.tid + 512 * i, l = it >> 4, cc = it & 15; *(LAS u32x4*)(BC + l * 272 + cc * 16) = bc4[i]; }
    tacs[c.tid] = ta; tbs[c.tid] = tb;
    __syncthreads();
    const float Dsk = p.ssd_d[layer * 16 + hd];
    const float* ng = p.ssd_norm_g + (size_t)layer * 1024 + g * 512 + half * 256 + hq * 64;
#pragma unroll
    for (int li = 0; li < 2; ++li) {
        const int lt = pr == 0 ? (li == 0 ? 0 : 3) : (li == 0 ? 1 : 2);
        const int l = 32 * lt + L.r; const size_t tok = (size_t)(T0 + l);
        bf16x8 Cf[8];
#pragma unroll
        for (int ks = 0; ks < 8; ++ks) Cf[ks] = *(const bf16x8*)(xbcc + tok * 1536 + 1280 + g * 128 + 16 * ks + 8 * L.h);
        u32x2 zw8[2][4];
#pragma unroll
        for (int pt = 0; pt < 2; ++pt)
#pragma unroll
            for (int gq = 0; gq < 4; ++gq) zw8[pt][gq] = *(const u32x2*)(mix + tok * NMIX + C_SZ + g * 512 + half * 256 + hq * 64 + 32 * pt + 8 * gq + 4 * L.h);
        f32x16 O[2]; O[0] = zero16(); O[1] = zero16();
#pragma unroll
        for (int pt = 0; pt < 2; ++pt)
#pragma unroll
            for (int ks = 0; ks < 8; ++ks) { O[pt] = MFMA32(Ap[pt][ks], Cf[ks], O[pt]); }

        const float acl = tacs[hq * 128 + l], eA = __expf(acl);
#pragma unroll
        for (int pt = 0; pt < 2; ++pt)
#pragma unroll
            for (int i = 0; i < 16; ++i) O[pt][i] *= eA;
#pragma unroll 1
        for (int st = 0; st <= lt; ++st) {
            f32x16 mt = zero16();
#pragma unroll
            for (int ks = 0; ks < 8; ++ks) { const bf16x8 A = *(const LAS bf16x8*)(BC + (32 * st + L.r) * 272 + (16 * ks + 8 * L.h) * 2); mt = MFMA32(A, Cf[ks], mt); }
#pragma unroll
            for (int gq = 0; gq < 4; ++gq) { const f32x4 bv = *(const LAS f32x4*)(tbs + hq * 128 + 32 * st + 8 * gq + 4 * L.h);
#pragma unroll
                for (int e = 0; e < 4; ++e) { const int s = 32 * st + 8 * gq + 4 * L.h + e; const float w = __expf(acl + bv[e]); mt[4 * gq + e] = (l >= s) ? mt[4 * gq + e] * w : 0.f; } }
            const bf16x8 pk0 = pack_half(mt, 0), pk1 = pack_half(mt, 1);
            ldsp xa = XS + tr_krow_off(L, 576) + (32 * st) * 576 + hq * 128;
#pragma unroll
            for (int pt = 0; pt < 2; ++pt) { O[pt] = MFMA32(tr_pair(xa + pt * 64, 8 * 576), pk0, O[pt]); O[pt] = MFMA32(tr_pair(xa + 16 * 576 + pt * 64, 8 * 576), pk1, O[pt]); }
        }
        float ssq = 0.f;
#pragma unroll
        for (int pt = 0; pt < 2; ++pt) { u32x2 w4[4];
#pragma unroll
            for (int gq = 0; gq < 4; ++gq) { const int pch = 32 * pt + 8 * gq + 4 * L.h;
                const u32x2 xw = *(const LAS u32x2*)(XS + l * 576 + (hq * 64 + pch) * 2);
                const u32x2 zw = zw8[pt][gq];
                const f32x4 gn = *(const f32x4*)(ng + pch);
                const float xv[4] = {bflo(xw.x), bfhi(xw.x), bflo(xw.y), bfhi(xw.y)}, zv[4] = {bflo(zw.x), bfhi(zw.x), bflo(zw.y), bfhi(zw.y)};
                float o[4];
#pragma unroll
                for (int e = 0; e < 4; ++e) { const float y = O[pt][4 * gq + e] + Dsk * xv[e]; const float gt = y * siluf_(zv[e]); ssq += gt * gt; o[e] = gt * gn[e]; }
                w4[gq].x = pk2(o[0], o[1]); w4[gq].y = pk2(o[2], o[3]); }
            bf16_t* rowp = oall + tok * KBR + O_SSD + g * 512 + half * 256 + hq * 64 + 32 * pt;
            store_pair_t21(rowp, 0, w4[0], w4[1], L.h); store_pair_t21(rowp, 2, w4[2], w4[3], L.h); }
        ssq += shx(ssq, 32, c.lane);
        if (L.h == 0) ssqh[tok * 16 + hd] = ssq;
    }
}

DI float ret_loggamma(int h) { return log1pf(-exp2f(-5.f - (float)h)); }
struct RetKV { u32x4 ka[2], kb[2], v[4]; };
DI void ret_load_kv(RetKV& r, const Ctx& c, const bf16_t* mix, int T0, int h) {
#pragma unroll
    for (int i = 0; i < 2; ++i) { const int it = c.tid + 512 * i, j = it >> 3, cc = it & 7; const bf16_t* row = mix + (size_t)(T0 + j) * NMIX + C_RK + h * 128;
        r.ka[i] = *(const u32x4*)(row + 8 * cc); r.kb[i] = *(const u32x4*)(row + 64 + 8 * cc); }
#pragma unroll
    for (int i = 0; i < 4; ++i) { const int it = c.tid + 512 * i, j = it >> 4, cc = it & 15; r.v[i] = *(const u32x4*)(mix + (size_t)(T0 + j) * NMIX + C_RV + h * 128 + 8 * cc); }
}
DI void ret_write_kv(const RetKV& r, const Ctx& c, int n, int h, ldsp Kt, int st, bool with_decay, ldsp Vt) {
    const float lg = ret_loggamma(h);
#pragma unroll
    for (int i = 0; i < 2; ++i) {
        const int it = c.tid + 512 * i, j = it >> 3, cc = it & 7; float x1[8], x2[8]; unpack8(r.ka[i], x1); unpack8(r.kb[i], x2);
        const float sc = 0.08838834764831845f * (with_decay ? __expf(lg * (float)(127 - j)) : 1.f), pos = (float)(128 * n + j);
        float o1[8], o2[8];
#pragma unroll
        for (int e = 0; e < 8; ++e) { const float inv = __builtin_amdgcn_exp2f(-(float)(8 * cc + e) * 0.20762050593046014f); const float ang = __fmul_rn(pos, inv); float rev = ang * 0.15915494309189535f; rev = __builtin_amdgcn_fractf(rev);
            const float sn = __builtin_amdgcn_sinf(rev), cs = __builtin_amdgcn_cosf(rev); o1[e] = (x1[e] * cs - x2[e] * sn) * sc; o2[e] = (x1[e] * sn + x2[e] * cs) * sc; }
        *(LAS bf16x8*)(Kt + j * st + cc * 16) = pack8(o1[0], o1[1], o1[2], o1[3], o1[4], o1[5], o1[6], o1[7]);
        *(LAS bf16x8*)(Kt + j * st + 128 + cc * 16) = pack8(o2[0], o2[1], o2[2], o2[3], o2[4], o2[5], o2[6], o2[7]);
    }
#pragma unroll
    for (int i = 0; i < 4; ++i) { const int it = c.tid + 512 * i, j = it >> 4, cc = it & 15; *(LAS u32x4*)(Vt + j * 320 + cc * 16) = r.v[i]; }
}
DI void retkv_unit(const Params& p0, const Ctx& c0, int u) {
    const Ctx c = fresh(c0); const Params p = freshp(p0);
    const int b = u >> 6, h = (u >> 4) & 3, n = u & 15, T0 = b * SEQ + 128 * n;
    const bf16_t* mix = wsb(p, WS_MIX); float* kvs = wsf(p, WS_KVS) + (size_t)u * 16384;
    ldsp Kt = c.lds, Vt = c.lds + 40960; const LaneIds L = lane_ids(c.lane);
    { RetKV r; ret_load_kv(r, c, mix, T0, h); ret_write_kv(r, c, n, h, Kt, 320, true, Vt); }
    __syncthreads();
    const int rt = c.wave >> 1, chh = c.wave & 1;
    f32x16 acc[2]; acc[0] = zero16(); acc[1] = zero16();
    ldsp va = Vt + tr_nat_off(L, 320) + rt * 64, ka = Kt + tr_nat_off(L, 320) + chh * 128;
#pragma unroll
    for (int ks = 0; ks < 8; ++ks) { const bf16x8 A = tr_pair(va + ks * 16 * 320, 4 * 320);
#pragma unroll
        for (int t = 0; t < 2; ++t) acc[t] = MFMA32(A, tr_pair(ka + ks * 16 * 320 + t * 64, 4 * 320), acc[t]); }
#pragma unroll
    for (int t = 0; t < 2; ++t)
#pragma unroll
        for (int i = 0; i < 16; ++i) kvs[(32 * rt + crow(i, L.h)) * 128 + chh * 64 + 32 * t + L.r] = acc[t][i];
}
DI void reto_unit(const Params& p0, const Ctx& c0, int u) {
    const Ctx c = fresh(c0); const Params p = freshp(p0);
    const int b = u >> 6, h = (u >> 4) & 3, n = u & 15, T0 = b * SEQ + 128 * n;
    const bf16_t* mix = wsb(p, WS_MIX); const bf16_t* prv = wsb(p, WS_PREVR) + (size_t)u * 16384; bf16_t* oall = wsb(p, WS_OALL);
    ldsp Kt = c.lds, Vt = c.lds + 34816; LAS float* exch = (LAS float*)(c.lds + 34816 + 40960); const LaneIds L = lane_ids(c.lane);
    const int qg = c.wave & 3, dvh = c.wave >> 2, il = 32 * qg + L.r; const size_t tok = (size_t)(T0 + il);
    const float lg = ret_loggamma(h);
    RetKV rkv; ret_load_kv(rkv, c, mix, T0, h);
    u32x4 qraw[8]; { const bf16_t* row = mix + tok * NMIX + C_RQ + h * 128;
#pragma unroll
      for (int s = 0; s < 4; ++s) { qraw[s] = *(const u32x4*)(row + 16 * s + 8 * L.h); qraw[s + 4] = *(const u32x4*)(row + 64 + 16 * s + 8 * L.h); } }
    bf16x8 Ap[2][8];
#pragma unroll
    for (int dl = 0; dl < 2; ++dl)
#pragma unroll
        for (int s = 0; s < 8; ++s) Ap[dl][s] = *(const bf16x8*)(prv + (32 * (2 * dvh + dl) + L.r) * 128 + 16 * s + 8 * L.h);
    u32x2 gwv[2][4];
#pragma unroll
    for (int dl = 0; dl < 2; ++dl)
#pragma unroll
        for (int gq = 0; gq < 4; ++gq) gwv[dl][gq] = *(const u32x2*)(mix + tok * NMIX + C_RG + h * 128 + 32 * (2 * dvh + dl) + 8 * gq + 4 * L.h);
    ret_write_kv(rkv, c, n, h, Kt, 272, false, Vt);
    bf16x8 Qf[8];
    { const float pos = (float)(128 * n + il);
#pragma unroll
      for (int s = 0; s < 4; ++s) { float x1[8], x2[8], o1[8], o2[8]; unpack8(qraw[s], x1); unpack8(qraw[s + 4], x2);
#pragma unroll
          for (int e = 0; e < 8; ++e) { const float inv = __builtin_amdgcn_exp2f(-(float)(16 * s + 8 * L.h + e) * 0.20762050593046014f); const float ang = __fmul_rn(pos, inv); float rev = ang * 0.15915494309189535f; rev = __builtin_amdgcn_fractf(rev);
              const float sn = __builtin_amdgcn_sinf(rev), cs = __builtin_amdgcn_cosf(rev); o1[e] = x1[e] * cs - x2[e] * sn; o2[e] = x1[e] * sn + x2[e] * cs; }
          Qf[s] = pack8(o1[0], o1[1], o1[2], o1[3], o1[4], o1[5], o1[6], o1[7]); Qf[s + 4] = pack8(o2[0], o2[1], o2[2], o2[3], o2[4], o2[5], o2[6], o2[7]); } }
    f32x16 O[2]; O[0] = zero16(); O[1] = zero16();
#pragma unroll
    for (int dl = 0; dl < 2; ++dl)
#pragma unroll
        for (int s = 0; s < 8; ++s) { O[dl] = MFMA32(Ap[dl][s], Qf[s], O[dl]); }

    { const float qd = __expf(lg * (float)(il + 1));
#pragma unroll
      for (int dl = 0; dl < 2; ++dl)
#pragma unroll
          for (int i = 0; i < 16; ++i) O[dl][i] *= qd; }
    __syncthreads();
#pragma unroll 1
    for (int rt = 0; rt <= qg; ++rt) {
        f32x16 st = zero16();
#pragma unroll
        for (int s = 0; s < 8; ++s) { const bf16x8 A = *(const LAS bf16x8*)(Kt + (32 * rt + L.r) * 272 + (16 * s + 8 * L.h) * 2); st = MFMA32(A, Qf[s], st); }
#pragma unroll
        for (int i = 0; i < 16; ++i) { const int j = 32 * rt + crow(i, L.h); st[i] = (il >= j) ? st[i] * __expf(lg * (float)(il - j)) : 0.f; }
        const bf16x8 pk0 = pack_half(st, 0), pk1 = pack_half(st, 1);
        ldsp va = Vt + tr_krow_off(L, 320) + (32 * rt) * 320 + dvh * 128;
#pragma unroll
        for (int dl = 0; dl < 2; ++dl) { O[dl] = MFMA32(tr_pair(va + dl * 64, 8 * 320), pk0, O[dl]); O[dl] = MFMA32(tr_pair(va + 16 * 320 + dl * 64, 8 * 320), pk1, O[dl]); }
    }
    float s1 = 0.f, s2 = 0.f;
#pragma unroll
    for (int dl = 0; dl < 2; ++dl)
#pragma unroll
        for (int i = 0; i < 16; ++i) { s1 += O[dl][i]; s2 += O[dl][i] * O[dl][i]; }
    s1 += shx(s1, 32, c.lane); s2 += shx(s2, 32, c.lane);
    if (L.h == 0) { exch[(dvh * 128 + il) * 2] = s1; exch[(dvh * 128 + il) * 2 + 1] = s2; }
    __syncthreads();
    const float t1 = exch[il * 2] + exch[(128 + il) * 2], t2 = exch[il * 2 + 1] + exch[(128 + il) * 2 + 1];
    const float mean = t1 * (1.f / 128.f), var = fmaxf(t2 * (1.f / 128.f) - mean * mean, 0.f), rstd = __builtin_amdgcn_rsqf(var + EPS);
#pragma unroll
    for (int dl = 0; dl < 2; ++dl) { u32x2 w4[4];
#pragma unroll
        for (int gq = 0; gq < 4; ++gq) { const u32x2 gw = gwv[dl][gq]; const float gv[4] = {bflo(gw.x), bfhi(gw.x), bflo(gw.y), bfhi(gw.y)}; float o[4];
#pragma unroll
            for (int e = 0; e < 4; ++e) o[e] = siluf_(gv[e]) * (O[dl][4 * gq + e] - mean) * rstd;
            w4[gq].x = pk2(o[0], o[1]); w4[gq].y = pk2(o[2], o[3]); }
        bf16_t* rowp = oall + tok * KBR + O_RET + h * 128 + 32 * (2 * dvh + dl);
        store_pair_t21(rowp, 0, w4[0], w4[1], L.h); store_pair_t21(rowp, 2, w4[2], w4[3], L.h); }
}

constexpr int KT_PITCH = 272, VT_PITCH = 320, KT_BYTES = 64 * KT_PITCH, VT_BYTES = 64 * VT_PITCH;
struct KvStage { u32x4 k[2], v[2]; };
DI void kv_load(KvStage& s, const bf16_t* kbase, int kp, const bf16_t* vbase, int vp, int row0, int tid) {
    const int key = tid >> 3, cp = tid & 7; const size_t rk = (size_t)(row0 + key) * kp, rv = (size_t)(row0 + key) * vp;
    s.k[0] = *(const u32x4*)(kbase + rk + 8 * cp); s.k[1] = *(const u32x4*)(kbase + rk + 64 + 8 * cp);
    s.v[0] = *(const u32x4*)(vbase + rv + 8 * cp); s.v[1] = *(const u32x4*)(vbase + rv + 64 + 8 * cp);
}
DI void kv_write(const KvStage& s, ldsp Kt, ldsp Vt, int tid) {
    const int key = tid >> 3, cp = tid & 7;
    *(LAS u32x4*)(Kt + key * KT_PITCH + cp * 16) = s.k[0]; *(LAS u32x4*)(Kt + key * KT_PITCH + 128 + cp * 16) = s.k[1];
    *(LAS u32x4*)(Vt + key * VT_PITCH + cp * 16) = s.v[0]; *(LAS u32x4*)(Vt + key * VT_PITCH + 128 + cp * 16) = s.v[1];
}
struct AttnState { f32x16 O[4]; float m, l; };
DI void attn_qk(f32x16 (&st)[2], ldsp Kt, const bf16x8 (&Qf)[8], const LaneIds& L) {
    st[0] = zero16(); st[1] = zero16();
#pragma unroll
    for (int rt = 0; rt < 2; ++rt)
#pragma unroll
        for (int s = 0; s < 8; ++s) st[rt] = MFMA32(*(const LAS bf16x8*)(Kt + (32 * rt + L.r) * KT_PITCH + (16 * s + 8 * L.h) * 2), Qf[s], st[rt]);
}
template <bool MASKW>
DI void attn_softmax_pv(AttnState& A, f32x16 (&st)[2], ldsp Vt, const LaneIds& L, unsigned mw0 = 0u, unsigned mw1 = 0u) {
    float mx = st[0][0];
#pragma unroll
    for (int rt = 0; rt < 2; ++rt)
#pragma unroll
        for (int i = 0; i < 16; ++i) mx = fmaxf(mx, st[rt][i]);
    mx = fmaxf(mx, shx(mx, 32, L.r + 32 * L.h));
    const float mn = fmaxf(A.m, mx);
    float rs = 0.f;
#pragma unroll
    for (int rt = 0; rt < 2; ++rt)
#pragma unroll
        for (int i = 0; i < 16; ++i) { float pv = __builtin_amdgcn_exp2f(st[rt][i] - mn);
            if (MASKW) { const int cr_ = (i & 3) + 8 * (i >> 2); pv = __uint_as_float(__float_as_uint(pv) & (unsigned)__builtin_amdgcn_sbfe((int)(rt ? mw1 : mw0), cr_, 1)); }
            st[rt][i] = pv; rs += pv; }
    rs += shx(rs, 32, L.r + 32 * L.h);
    if (__builtin_amdgcn_ballot_w64(mn > A.m) != 0ull) {
        const float alpha = __builtin_amdgcn_exp2f(A.m - mn);
        A.l *= alpha; A.m = mn;
#pragma unroll
        for (int dt = 0; dt < 4; ++dt)
#pragma unroll
            for (int i = 0; i < 16; ++i) A.O[dt][i] *= alpha;
    }
    A.l += rs;
    ldsp va = Vt + tr_krow_off(L, VT_PITCH);
#pragma unroll
    for (int rt = 0; rt < 2; ++rt)
#pragma unroll
        for (int s2 = 0; s2 < 2; ++s2) { const bf16x8 pk = pack_half(st[rt], s2);
#pragma unroll
            for (int dt = 0; dt < 4; ++dt) A.O[dt] = MFMA32(tr_pair(va + (32 * rt + 16 * s2) * VT_PITCH + dt * 64, 8 * VT_PITCH), pk, A.O[dt]); }
}
DI void attn_store(const AttnState& A, bf16_t* orow, const LaneIds& L) {
    const float inv = 1.f / A.l;
#pragma unroll
    for (int dt = 0; dt < 4; ++dt)
#pragma unroll
        for (int gq = 0; gq < 4; gq += 2) { u32x2 a, b;
            a.x = pk2(A.O[dt][4 * gq] * inv, A.O[dt][4 * gq + 1] * inv); a.y = pk2(A.O[dt][4 * gq + 2] * inv, A.O[dt][4 * gq + 3] * inv);
            b.x = pk2(A.O[dt][4 * gq + 4] * inv, A.O[dt][4 * gq + 5] * inv); b.y = pk2(A.O[dt][4 * gq + 6] * inv, A.O[dt][4 * gq + 7] * inv);
            store_pair_t21(orow, 4 * dt + gq, a, b, L.h); }
}
DI void attn_load_q(bf16x8 (&Qf)[8], const bf16_t* qrow, const float* g, float pre, float scale, const LaneIds& L) {
    float x[8][8]; float ss = 0.f;
#pragma unroll
    for (int s = 0; s < 8; ++s) { unpack8(*(const u32x4*)(qrow + 16 * s + 8 * L.h), x[s]);
#pragma unroll
        for (int e = 0; e < 8; ++e) { x[s][e] *= pre; ss += x[s][e] * x[s][e]; } }
    ss += shx(ss, 32, L.r + 32 * L.h);
    const float f = scale * __builtin_amdgcn_rsqf(ss * (1.f / 128.f) + EPS);
#pragma unroll
    for (int s = 0; s < 8; ++s) { const f32x4 g0 = *(const f32x4*)(g + 16 * s + 8 * L.h), g1 = *(const f32x4*)(g + 16 * s + 8 * L.h + 4);
        Qf[s] = pack8(x[s][0] * f * g0[0], x[s][1] * f * g0[1], x[s][2] * f * g0[2], x[s][3] * f * g0[3], x[s][4] * f * g1[0], x[s][5] * f * g1[1], x[s][6] * f * g1[2], x[s][7] * f * g1[3]); }
}

DI void fox_unit(const Params& p0, const Ctx& c0, int layer, int u) {
    const Ctx c = fresh(c0); const Params p = freshp(p0);
    const int qb = 7 - (u >> 4), bh = u & 15, b = bh >> 2, hd = bh & 3, t0 = 256 * qb;
    const bf16_t* mix = wsb(p, WS_MIX); bf16_t* oall = wsb(p, WS_OALL);
    LAS float* Fs = (LAS float*)c.lds; LAS float* wtot = Fs + 2048; ldsp KV = c.lds + 8192 + 64;
    const LaneIds L = lane_ids(c.lane);
    {
        const float fb = p.fox_f_b[layer * 4 + hd]; float v[4];
#pragma unroll
        for (int e = 0; e < 4; ++e) { const float x = bf2f(mix[(size_t)(b * SEQ + 4 * c.tid + e) * NMIX + C_FF + hd]) + fb; v[e] = (fminf(x, 0.f) - log1pf(__expf(-fabsf(x)))) * LOG2E; }
        v[1] += v[0]; v[2] += v[1]; v[3] += v[2];
        float s = v[3];
#pragma unroll
        for (int o = 1; o < 64; o <<= 1) { const float t = shidx(s, c.lane - o); if (c.lane >= o) s += t; }
        if (c.lane == 63) wtot[c.wave] = s;
        __syncthreads();
        float base = s - v[3];
        for (int w = 0; w < c.wave; ++w) base += wtot[w];
        *(LAS f32x4*)(Fs + 4 * c.tid) = (f32x4){base + v[0], base + v[1], base + v[2], base + v[3]};
    }
    const int tq = t0 + 32 * c.wave + L.r;
    bf16x8 Qf[8];
    attn_load_q(Qf, mix + (size_t)(b * SEQ + tq) * NMIX + C_FQ + hd * 128, p.fox_qn_g + layer * 128, 1.f, 0.08838834764831845f * LOG2E, L);
    AttnState A; for (int i = 0; i < 4; ++i) A.O[i] = zero16(); A.m = -1e30f; A.l = 0.f;
    const bf16_t* kbase = wsb(p, WS_FOXKN) + hd * 128; const bf16_t* vbase = mix + C_FV + hd * 128;
    const int nt = (t0 + 256) / 64;
    KvStage sg; kv_load(sg, kbase, 512, vbase, NMIX, b * SEQ, c.tid); kv_write(sg, KV, KV + KT_BYTES, c.tid);
    __syncthreads();
#pragma unroll 1
    for (int j = 0; j < nt; ++j) {
        const int kb = 64 * j; ldsp Kt = KV + (j & 1) * (KT_BYTES + VT_BYTES), Vt = Kt + KT_BYTES;
        if (j + 1 < nt) kv_load(sg, kbase, 512, vbase, NMIX, b * SEQ + kb + 64, c.tid);
        if (kb <= t0 + 32 * c.wave + 31) {
            f32x16 st[2]; attn_qk(st, Kt, Qf, L);
            const bool diag = kb + 63 > t0 + 32 * c.wave;
#pragma unroll
            for (int rt = 0; rt < 2; ++rt)
#pragma unroll
                for (int gq = 0; gq < 4; ++gq) { const f32x4 fv = *(const LAS f32x4*)(Fs + kb + 32 * rt + 8 * gq + 4 * L.h);
#pragma unroll
                    for (int e = 0; e < 4; ++e) { float sv = st[rt][4 * gq + e] - fv[e]; if (diag && (kb + 32 * rt + 8 * gq + 4 * L.h + e > tq)) sv = -__builtin_inff(); st[rt][4 * gq + e] = sv; } }
            attn_softmax_pv<false>(A, st, Vt, L);
        }
        if (j + 1 < nt) { ldsp Kn = KV + ((j + 1) & 1) * (KT_BYTES + VT_BYTES); kv_write(sg, Kn, Kn + KT_BYTES, c.tid); }
        __syncthreads();
    }
    attn_store(A, oall + (size_t)(b * SEQ + tq) * KBR + O_FOX + hd * 128, L);
}

DI void idx_unit(const Params& p0, const Ctx& c0, int u) {
    const Ctx c = fresh(c0); const Params p = freshp(p0);
    const int qb = 63 - (u >> 2), b = u & 3, t0 = 32 * qb;
    const bf16_t* mix = wsb(p, WS_MIX); const bf16_t* qup = wsb(p, WS_QUP); float* scores = wsf(p, WS_SCORES);
    ldsp KI = c.lds; const LaneIds L = lane_ids(c.lane);
    bf16x8 Af[2][4]; float Wr[2][16];
#pragma unroll
    for (int pp = 0; pp < 2; ++pp) {
        const int tqa = t0 + 4 * c.wave + 2 * pp + ((L.r >> 2) & 1), head = 4 * (L.r >> 3) + (L.r & 3);
#pragma unroll
        for (int s = 0; s < 4; ++s) Af[pp][s] = *(const bf16x8*)(qup + (size_t)(b * SEQ + tqa) * NUP + 512 + head * 64 + 16 * s + 8 * L.h);
        const bf16_t* wrow = mix + (size_t)(b * SEQ + t0 + 4 * c.wave + 2 * pp + L.h) * NMIX + C_IW; float w0[8], w1[8]; unpack8(*(const u32x4*)wrow, w0); unpack8(*(const u32x4*)(wrow + 8), w1);
#pragma unroll
        for (int i = 0; i < 8; ++i) { Wr[pp][i] = w0[i]; Wr[pp][8 + i] = w1[i]; }
    }
    const int nsup = (t0 + 31) / 256 + 1;
    u32x4 sg[4];
#pragma unroll
    for (int i = 0; i < 4; ++i) { const int it = c.tid + 512 * i; sg[i] = *(const u32x4*)(mix + (size_t)(b * SEQ + (it >> 3)) * NMIX + C_IK + 8 * (it & 7)); }
#pragma unroll
    for (int i = 0; i < 4; ++i) { const int it = c.tid + 512 * i; *(LAS u32x4*)(KI + (it >> 3) * 144 + (it & 7) * 16) = sg[i]; }
    __syncthreads();
#pragma unroll 1
    for (int js = 0; js < nsup; ++js) {
        ldsp Kc = KI + (js & 1) * 36864;
        if (js + 1 < nsup) {
#pragma unroll
            for (int i = 0; i < 4; ++i) { const int it = c.tid + 512 * i; sg[i] = *(const u32x4*)(mix + (size_t)(b * SEQ + 256 * (js + 1) + (it >> 3)) * NMIX + C_IK + 8 * (it & 7)); } }
#pragma unroll 1
        for (int kt = 0; kt < 8; ++kt) {
            const int kb = 256 * js + 32 * kt; if (kb > t0 + 31) break;
            bf16x8 Bf[4];
#pragma unroll
            for (int s = 0; s < 4; ++s) Bf[s] = *(const LAS bf16x8*)(Kc + (32 * kt + L.r) * 144 + (16 * s + 8 * L.h) * 2);
#pragma unroll
            for (int pp = 0; pp < 2; ++pp) { f32x16 acc = zero16();
#pragma unroll
                for (int s = 0; s < 4; ++s) acc = MFMA32(Af[pp][s], Bf[s], acc);
                float sc = 0.f;
#pragma unroll
                for (int i = 0; i < 16; ++i) sc += Wr[pp][i] * fmaxf(acc[i], 0.f);
                scores[(size_t)(b * SEQ + t0 + 4 * c.wave + 2 * pp + L.h) * SEQ + kb + L.r] = sc; }
        }
        if (js + 1 < nsup) { ldsp Kn = KI + ((js + 1) & 1) * 36864;
#pragma unroll
            for (int i = 0; i < 4; ++i) { const int it = c.tid + 512 * i; *(LAS u32x4*)(Kn + (it >> 3) * 144 + (it & 7) * 16) = sg[i]; } }
        __syncthreads();
    }
}

template <int NJ>
DI void sel_query(const float* row, unsigned* mrow, int t, int lane) {
    unsigned x[NJ];
#pragma unroll
    for (int j = 0; j < NJ; ++j) { const int key = 64 * j + lane; const unsigned bits = __float_as_uint(row[key]);
        const unsigned uu = (bits & 0x80000000u) ? ~bits : (bits | 0x80000000u); x[j] = (key <= t) ? uu : 0u; }
    unsigned T = 1u; bool exact = (t + 1 <= 256);
    if (!exact) {
#define SEL_COUNT(dst, thr) do { int _c = 0; _Pragma("unroll") for (int j = 0; j < NJ; ++j) _c += __popcll(__ballot(x[j] >= (thr))); dst = _c; } while (0)
        const float ex = 16384.f / (float)(t + 1), mg = 3.f * sqrtf(ex) + 2.f; const int k_hi0 = (int)floorf(ex - mg), k_hi = k_hi0 < 1 ? 1 : k_hi0, k_lo = (int)ceilf(ex + mg);
        unsigned lo = 1u, hi = 0xffffffffu;
        if (k_lo <= 64) { unsigned v = 0u;
#pragma unroll 1
            for (int bit = 31; bit >= 0; --bit) { const unsigned cand = v | (1u << bit); if (__popcll(__ballot(x[0] >= cand)) >= k_lo) v = cand; }
            int cc; SEL_COUNT(cc, v); if (cc >= 256) { lo = v; if (cc == 256) { T = v; exact = true; } } else hi = v; }
        if (!exact) { unsigned v = 0u;
#pragma unroll 1
            for (int bit = 31; bit >= 0; --bit) { const unsigned cand = v | (1u << bit); if (__popcll(__ballot(x[0] >= cand)) >= k_hi) v = cand; }
            int cc; SEL_COUNT(cc, v);
            if (cc == 256) { T = v; exact = true; } else if (cc < 256) { if (v < hi) hi = v; } else if (v > lo) lo = v; }
        if (!exact) {
#pragma unroll 1
            while (hi - lo > 1u) { const unsigned mid = lo + ((hi - lo) >> 1); int cc; SEL_COUNT(cc, mid);
                if (cc == 256) { T = mid; exact = true; break; }
                if (cc > 256) lo = mid; else hi = mid; }
            if (!exact) T = lo;
        }
#undef SEL_COUNT
    }
    if (exact) {
#pragma unroll
        for (int j = 0; j < NJ; ++j) { const unsigned long long bal = __ballot(x[j] >= T); if (lane == 0) { mrow[2 * j] = (unsigned)bal; mrow[2 * j + 1] = (unsigned)(bal >> 32); } }
    } else {
        int gt = 0;
#pragma unroll
        for (int j = 0; j < NJ; ++j) gt += __popcll(__ballot(x[j] > T));
        int need = 256 - gt, run = 0;
#pragma unroll
        for (int j = 0; j < NJ; ++j) { const bool eq = x[j] == T; const unsigned long long be = __ballot(eq); const int below = __popcll(be & ((1ull << lane) - 1ull));
            const bool sel = (x[j] > T) || (eq && (run + below < need)); run += __popcll(be);
            const unsigned long long bal = __ballot(sel); if (lane == 0) { mrow[2 * j] = (unsigned)bal; mrow[2 * j + 1] = (unsigned)(bal >> 32); } }
    }
    if (lane < 2 * (32 - NJ)) mrow[2 * NJ + lane] = 0u;
}
DI void sel_unit(const Params& p0, const Ctx& c0, int u) {
    const Ctx c = fresh(c0); const Params p = freshp(p0);
    const int qb = 127 - (u >> 2), b = u & 3, t0 = 16 * qb;
    const float* scores = wsf(p, WS_SCORES); unsigned* msk = (unsigned*)(p.ws + WS_MSK);
    const int grp = (t0 + 15) >> 9;
#pragma unroll 1
    for (int qi = 0; qi < 2; ++qi) {
        const int t = t0 + 2 * c.wave + qi; const float* row = scores + (size_t)(b * SEQ + t) * SEQ; unsigned* mrow = msk + (size_t)(b * SEQ + t) * 64;
        if (grp == 0) sel_query<8>(row, mrow, t, c.lane); else if (grp == 1) sel_query<16>(row, mrow, t, c.lane); else if (grp == 2) sel_query<24>(row, mrow, t, c.lane); else sel_query<32>(row, mrow, t, c.lane);
    }
}
DI void knorm_unit(const Params& p0, const Ctx& c0, int layer, int u) {
    const Ctx c = fresh(c0); const Params p = freshp(p0);
    const bf16_t* mix = wsb(p, WS_MIX); bf16_t* fk = wsb(p, WS_FOXKN); bf16_t* dk = wsb(p, WS_DSAKN);
    const int ch = c.tid & 15, tok = 32 * u + (c.tid >> 4);
    u32x4 raw[5];
#pragma unroll
    for (int hh = 0; hh < 5; ++hh) raw[hh] = *(const u32x4*)(mix + (size_t)tok * NMIX + (hh < 4 ? C_FK + hh * 128 : C_DK) + 8 * ch);
    const f32x4 f0 = *(const f32x4*)(p.fox_kn_g + layer * 128 + 8 * ch), f1 = *(const f32x4*)(p.fox_kn_g + layer * 128 + 8 * ch + 4);
    const f32x4 d0 = *(const f32x4*)(p.dsa_kn_g + layer * 128 + 8 * ch), d1 = *(const f32x4*)(p.dsa_kn_g + layer * 128 + 8 * ch + 4);
#pragma unroll
    for (int hh = 0; hh < 5; ++hh) {
        float a[8]; unpack8(raw[hh], a); float ss = 0.f;
#pragma unroll
        for (int e = 0; e < 8; ++e) ss += a[e] * a[e];
        ss += shx(ss, 1, c.lane); ss += shx(ss, 2, c.lane); ss += shx(ss, 4, c.lane); ss += shx(ss, 8, c.lane);
        const float rstd = __builtin_amdgcn_rsqf(ss * (1.f / 128.f) + EPS); const f32x4 g0 = hh < 4 ? f0 : d0, g1 = hh < 4 ? f1 : d1;
        const bf16x8 o = pack8(a[0] * rstd * g0[0], a[1] * rstd * g0[1], a[2] * rstd * g0[2], a[3] * rstd * g0[3], a[4] * rstd * g1[0], a[5] * rstd * g1[1], a[6] * rstd * g1[2], a[7] * rstd * g1[3]);
        if (hh < 4) *(bf16x8*)(fk + (size_t)tok * 512 + hh * 128 + 8 * ch) = o; else *(bf16x8*)(dk + (size_t)tok * 128 + 8 * ch) = o; }
}
DI void dsa_unit(const Params& p0, const Ctx& c0, int layer, int u) {
    const Ctx c = fresh(c0); const Params p = freshp(p0);
    const int qb = 31 - (u >> 2), b = u & 3, t0 = 64 * qb;
    const bf16_t* mix = wsb(p, WS_MIX); const bf16_t* qup = wsb(p, WS_QUP); bf16_t* oall = wsb(p, WS_OALL); const unsigned* msk = (const unsigned*)(p.ws + WS_MSK);
    LAS unsigned* Msk = (LAS unsigned*)c.lds; LAS float* Bl = (LAS float*)(c.lds + 16640); ldsp KV = c.lds + 16640 + 2048;
    const LaneIds L = lane_ids(c.lane);
    const int hd = c.wave >> 1, qg = c.wave & 1, ql = 32 * qg + L.r, tq = t0 + ql; const size_t tok = (size_t)(b * SEQ + tq);
    const float b31 = p.rel_bias[31 * 4 + hd] * LOG2E;
    if (c.tid < 128) {
        const int d = c.tid; int bk = d;
        if (d >= 16) { bk = 16 + (int)(__logf((float)d * (1.f / 16.f)) * (16.f / 2.0794415416798357f)); bk = bk > 31 ? 31 : bk; }
#pragma unroll
        for (int hh = 0; hh < 4; ++hh) Bl[d * 4 + hh] = (p.rel_bias[bk * 4 + hh] - p.rel_bias[31 * 4 + hh]) * LOG2E;
    }
#pragma unroll
    for (int i = 0; i < 8; ++i) { const int it = c.tid + 512 * i, q = it >> 6, w = it & 63; Msk[q * 65 + w] = msk[(size_t)(b * SEQ + t0 + q) * 64 + w]; }
    (void)b31;
    float rc;
    { float ss = 0.f; const bf16_t* cr = mix + tok * NMIX + C_DCQ + 256 * L.h;
#pragma unroll 4
      for (int i = 0; i < 32; ++i) { float f[8]; unpack8(*(const u32x4*)(cr + 8 * i), f);
#pragma unroll
          for (int e = 0; e < 8; ++e) ss += f[e] * f[e]; }
      ss += shx(ss, 32, L.r + 32 * L.h); rc = __builtin_amdgcn_rsqf(ss * (1.f / 512.f) + EPS); }
    bf16x8 Qf[8];
    attn_load_q(Qf, qup + tok * NUP + hd * 128, p.dsa_qn_g + layer * 128, rc, 0.08838834764831845f * LOG2E, L);
    AttnState A; for (int i = 0; i < 4; ++i) A.O[i] = zero16(); A.m = -1e30f; A.l = 0.f;
    const bf16_t* kbase = wsb(p, WS_DSAKN); const bf16_t* vbase = mix + C_DV;
    const int nt = qb + 1;
    KvStage sg; kv_load(sg, kbase, 128, vbase, NMIX, b * SEQ, c.tid); kv_write(sg, KV, KV + KT_BYTES, c.tid);
    __syncthreads();
#pragma unroll 1
    for (int j = 0; j < nt; ++j) {
        const int kb = 64 * j; ldsp Kt = KV + (j & 1) * (KT_BYTES + VT_BYTES), Vt = Kt + KT_BYTES;
        if (j + 1 < nt) kv_load(sg, kbase, 128, vbase, NMIX, b * SEQ + kb + 64, c.tid);
        {
            f32x16 st[2]; attn_qk(st, Kt, Qf, L);
            const unsigned mw0 = Msk[ql * 65 + 2 * j] >> (4 * L.h), mw1 = Msk[ql * 65 + 2 * j + 1] >> (4 * L.h);
            if (kb + 63 + 128 > t0 + 32 * qg) {
#pragma unroll
                for (int rt = 0; rt < 2; ++rt)
#pragma unroll
                    for (int i = 0; i < 16; ++i) { const int cr_ = (i & 3) + 8 * (i >> 2); const int d = tq - (kb + 32 * rt + cr_ + 4 * L.h);
                        if (d < 128) st[rt][i] += Bl[(d < 0 ? 0 : d) * 4 + hd]; }
            }
            attn_softmax_pv<true>(A, st, Vt, L, mw0, mw1);
        }
        if (j + 1 < nt) { ldsp Kn = KV + ((j + 1) & 1) * (KT_BYTES + VT_BYTES); kv_write(sg, Kn, Kn + KT_BYTES, c.tid); }
        __syncthreads();
    }
    attn_store(A, oall + tok * KBR + O_DSA + hd * 128, L);
}

constexpr int NPH = 9, NPHASES = 1 + DEPTH * NPH;
enum { Q_IDX = 0, Q_SSDST = 1, Q_RETKV = 2, Q_FOX = 3, Q_DSA = 4, Q_SSDO = 5, Q_RETO = 6, Q_SEL = 7 };
#ifndef LB2
#define LB2 2
#endif
__global__ void __launch_bounds__(512, LB2) fwd(Params pk) {
    extern __shared__ __attribute__((aligned(16))) unsigned char lds_raw[];
    Ctx c; c.lds = (ldsp)lds_raw; c.tid = threadIdx.x; c.lane = c.tid & 63; c.wave = __builtin_amdgcn_readfirstlane(c.tid >> 6); c.G = gridDim.x; c.bid = blockIdx.x;
    c.ctl = (gu32*)(pk.ws + WS_CTL);
    if (c.tid < 64) ((LAS unsigned*)(c.lds + LDS_MISC))[c.tid] = 0u;
    __syncthreads();
#if MK_PER_PHASE
#define GRID_BAR() do { } while (0)
#else
    XcdBarrier bar = xcd_barrier_post((unsigned*)(c.ctl + CW_BAR), (volatile LAS unsigned*)(c.lds + LDS_MISC) + 8);
#define GRID_BAR() xcd_barrier(bar)
#endif
    const int lo = pk.ph_lo, hi = pk.ph_hi, rep = pk.rep;
#define IN(k) (lo <= (k) && (k) < hi)
#define SEAM(k) do { if (IN((k) + 1)) GRID_BAR(); } while (0)
#define PHASE(k, ...) if (PH_ON((k) + 1) && IN(pb + (k))) { const Params p = loadp(); unsigned char* wl = p.ws + WS_W + (size_t)l * WL_SIZE; (void)wl; __VA_ARGS__ SEAM(pb + (k)); }
    if (PH_ON(0) && IN(0)) { const Params p = loadp(); p0_prologue(p, c); xprep_phase(c, p.x, wsb(p, WS_HN), wsf(p, WS_SSP)); SEAM(0); }
#pragma unroll 1
    for (int l = 0; l < DEPTH; ++l) {
        const int pb = 1 + l * NPH;
        PHASE(0, {
            pg8::Gemm g{wsb(p, WS_HN), (const bf16_t*)(wl + WL_IN), MTOK, NIN, DM, DM, DM}; pg8::StaticOrder S; S.init(MTOK, NIN, c.G, c.bid);
            pg8::EpiIn E{wsb(p, WS_MIX), wsb(p, WS_GATES), p.gate_b + (size_t)l * NGATE, wsf(p, WS_SSP)};
            pg8::gemm_phase(c.lds, g, S, E);
            convert_on_idle(p, c, l, I_IN, PER_LAYER, (MTOK / 256) * (NIN / 256)); })
        PHASE(1, {
            pg8::Gemm g{wsb(p, WS_MIX) + C_DCQ, (const bf16_t*)(wl + WL_UP), MTOK, NUP, KUP, NMIX, KUP}; pg8::StaticOrder S; S.init(MTOK, NUP, c.G, c.bid);
            pg8::EpiBf16<0> E{wsb(p, WS_QUP), NUP, nullptr};
            pg8::gemm_phase(c.lds, g, S, E);
            if (l + 1 < DEPTH) convert_on_idle(p, c, l + 1, 0, CV_B, (MTOK / 256) * (NUP / 256)); })
        PHASE(2, {
            if (rep == 0 || ((REP_UM >> Q_IDX) & 1)) for (int u; (u = next_unit(c, l, Q_IDX + 8 * rep)) < 256;) idx_unit(p, c, u);
            if (rep == 0 || ((REP_UM >> Q_SSDST) & 1)) for (int u; (u = next_unit(c, l, Q_SSDST + 8 * rep)) < 256;) ssdst_unit(p, c, l, u);
            if (rep == 0 || ((REP_UM >> Q_RETKV) & 1)) for (int u; (u = next_unit(c, l, Q_RETKV + 8 * rep)) < 256;) retkv_unit(p, c, u);
            for (int u = c.bid; u < 256; u += c.G) { knorm_unit(p, c, l, u); } })
        PHASE(3, {
            for (int u; (u = next_unit(c, l, Q_SEL + 8 * rep)) < 512;) sel_unit(p, c, u);
            scan_phase(p, c); })
        PHASE(4, {
            if (rep == 0 || ((REP_UM >> Q_DSA) & 1)) for (int u; (u = next_unit(c, l, Q_DSA + 8 * rep)) < 128;) dsa_unit(p, c, l, u);
            if (rep == 0 || ((REP_UM >> Q_FOX) & 1)) for (int u; (u = next_unit(c, l, Q_FOX + 8 * rep)) < 128;) fox_unit(p, c, l, u);
            if (rep == 0 || ((REP_UM >> Q_SSDO) & 1)) for (int u; (u = next_unit(c, l, Q_SSDO + 8 * rep)) < 256;) ssdo_unit(p, c, l, u);
            if (rep == 0 || ((REP_UM >> Q_RETO) & 1)) for (int u; (u = next_unit(c, l, Q_RETO + 8 * rep)) < 256;) reto_unit(p, c, u);
            if (l + 1 < DEPTH) { __syncthreads(); convert_items(p, c, l + 1, CV_B, I_IN, c.bid * 8 + c.wave, c.G * 8); } })
        PHASE(5, {
            pg8::Gemm g{wsb(p, WS_OALL), (const bf16_t*)(wl + WL_BR), MTOK, DM, KBR, KBR, KBR}; pg8::StaticOrder S; S.init(MTOK, DM, c.G, c.bid);
            pg8::EpiMerge E{wsb(p, WS_MERGED), wsb(p, WS_GATES), wsf(p, WS_SSQH), wsb(p, WS_ONES)};
            pg8::gemm_phase(c.lds, g, S, E); })
        PHASE(6, {
            pg8::Gemm g{wsb(p, WS_MERGED), (const bf16_t*)(wl + WL_OUT), MTOK, DM, DM, DM, DM}; pg8::StaticOrder S; S.init(MTOK, DM, c.G, c.bid);
            pg8::EpiResid<1, 0> E{wsb(p, WS_HN), nullptr, wsb(p, WS_XRES), wsf(p, WS_SSP), DM};
            pg8::gemm_phase(c.lds, g, S, E); })
        PHASE(7, {
            pg8::Gemm g{wsb(p, WS_XRES), (const bf16_t*)(wl + WL_FF1), MTOK, DFF, DM, DM, DM}; pg8::StaticOrder S; S.init(MTOK, DFF, c.G, c.bid);
            pg8::EpiBf16<1> E{wsb(p, WS_FFH), DFF, wsf(p, WS_SSP)};
            pg8::gemm_phase(c.lds, g, S, E); })
        if (l < DEPTH - 1) {
            PHASE(8, {
                pg8::Gemm g{wsb(p, WS_FFH), (const bf16_t*)(wl + WL_FF2), MTOK, DM, DFF, DFF, DFF}; pg8::StaticOrder S; S.init(MTOK, DM, c.G, c.bid);
                pg8::EpiResid<1, 0> E{wsb(p, WS_XRES), nullptr, wsb(p, WS_HN), wsf(p, WS_SSP), DM};
                pg8::gemm_phase(c.lds, g, S, E); })
        } else {
            PHASE(8, {
                pg8::Gemm g{wsb(p, WS_FFH), (const bf16_t*)(wl + WL_FF2), MTOK, DM, DFF, DFF, DFF}; pg8::StaticOrder S; S.init(MTOK, DM, c.G, c.bid);
                pg8::EpiResid<1, 1> E{wsb(p, WS_XRES), p.out, nullptr, nullptr, DM};
                pg8::gemm_phase(c.lds, g, S, E); })
        }
    }
#undef PHASE
#undef IN
#undef SEAM
}

extern "C" void kernel_launch(void* const* d_in, const int* in_sizes, int n_in, void* d_out, int out_size, void* d_ws, size_t ws_size, hipStream_t stream) {
    static int grid = 0;
    if (grid == 0) {
        if (n_in != 24 || in_sizes[0] != MTOK * DM || out_size != MTOK * DM || ws_size < WS_END) {
            fprintf(stderr, "kernel_launch: unexpected problem (n_in %d, in0 %d, out %d, ws %zu < %zu?); nothing launched\n", n_in, n_in > 0 ? in_sizes[0] : -1, out_size, ws_size, (size_t)WS_END); grid = -1; return; }
        int dev = 0, cus = 0;
        if (hipGetDevice(&dev) != hipSuccess || hipDeviceGetAttribute(&cus, hipDeviceAttributeMultiprocessorCount, dev) != hipSuccess) { grid = -1; return; }
        if (hipFuncSetAttribute((const void*)fwd, hipFuncAttributeMaxDynamicSharedMemorySize, LDS_BYTES) != hipSuccess) { fprintf(stderr, "kernel_launch: hipFuncSetAttribute failed\n"); grid = -1; return; }
        int per_cu = 0;
        if (hipOccupancyMaxActiveBlocksPerMultiprocessor(&per_cu, (const void*)fwd, 512, LDS_BYTES) != hipSuccess || per_cu < 1) { fprintf(stderr, "kernel_launch: occupancy query says %d blocks per CU\n", per_cu); }
        (void)hipGetLastError();
        grid = cus;
    }
    if (grid < 0) return;
    (void)hipMemsetAsync((char*)d_ws + WS_CTL, 0, CTL_ZERO_BYTES, stream);
    Params p{};
    const float** pin = (const float**)&p;
    for (int i = 0; i < 24; ++i) pin[i] = (const float*)d_in[i];
    p.out = (float*)d_out; p.ws = (unsigned char*)d_ws;
#if MK_PER_PHASE
    for (int ph = 0; ph < NPHASES; ++ph) { p.ph_lo = ph; p.ph_hi = ph + 1; p.rep = 0; hipLaunchKernelGGL(fwd, dim3(grid), dim3(512), LDS_BYTES, stream, p);
        if ((ph >= 1 && (ph - 1) % NPH == REPEAT_PH) || (ph == 0 && REPEAT_PH == 100)) { p.rep = 1; hipLaunchKernelGGL(fwd, dim3(grid), dim3(512), LDS_BYTES, stream, p); } }
#else
    p.ph_lo = 0; p.ph_hi = NPHASES; hipLaunchKernelGGL(fwd, dim3(grid), dim3(512), LDS_BYTES, stream, p);
#endif
    const hipError_t le = hipPeekAtLastError();
    if (le != hipSuccess) fprintf(stderr, "kernel_launch: launch failed: %s\n", hipGetErrorName(le));
}
```

```cpp
#include <hip/hip_runtime.h>
#include <cstdio>
#include <cstdint>

#ifndef MK_PER_PHASE
#define MK_PER_PHASE 0
#endif
#ifndef REPEAT_PH
#define REPEAT_PH -1
#endif
#ifndef REP_UM
#define REP_UM 0xFF
#endif
#ifndef PHMASK
#define PHMASK 0xFFFFu
#endif
#define PH_ON(k) ((PHMASK >> (k)) & 1u)
#ifndef UM
#define UM 0xFF
#endif

#define DI __device__ __forceinline__
#define LAS __attribute__((address_space(3)))
#define GAS __attribute__((address_space(1)))
typedef unsigned short bf16_t;
typedef short bf16x8 __attribute__((ext_vector_type(8)));
typedef short s16x4 __attribute__((ext_vector_type(4)));
typedef float f32x2 __attribute__((ext_vector_type(2)));
typedef float f32x4 __attribute__((ext_vector_type(4)));
typedef float f32x16 __attribute__((ext_vector_type(16)));
typedef unsigned u32x2 __attribute__((ext_vector_type(2)));
typedef unsigned u32x4 __attribute__((ext_vector_type(4)));
typedef __bf16 bf16x2_t __attribute__((ext_vector_type(2)));
typedef GAS unsigned gu32;
typedef LAS unsigned char* ldsp;

constexpr int NB = 4, SEQ = 2048, DM = 2048, DEPTH = 4, MTOK = NB * SEQ;
constexpr int DFF = 8192, IN_TOTAL = 15204;
constexpr int NMIX = 7168, NGATE = 8192, NIN = NMIX + NGATE;
constexpr int NUP = 1536, KUP = 512, KBR = 2560;
constexpr float EPS = 1e-6f;
constexpr float LOG2E = 1.4426950408889634f;
constexpr int C_RQ = 0, C_RK = 512, C_RV = 1024, C_RG = 1536, C_FQ = 2048, C_FK = 2560, C_FV = 3072, C_DCQ = 3584, C_DK = 4096, C_DV = 4224,
              C_IK = 4352, C_SZ = 4416, C_SX = 5440, C_SB = 6464, C_SC = 6720, C_IW = 6976, C_SDT = 6992, C_FF = 7008, C_MIXEND = 7012;
constexpr int O_RET = 0, O_FOX = 512, O_DSA = 1024, O_SSD = 1536;

constexpr size_t MiB = 1u << 20;
constexpr size_t WS_CTL = 0, CTL_ZERO_BYTES = 1 * MiB;
constexpr size_t WL_IN = 0, WL_UP = WL_IN + (size_t)NIN * DM * 2, WL_BR = WL_UP + (size_t)NUP * KUP * 2, WL_OUT = WL_BR + (size_t)DM * KBR * 2,
                 WL_FF1 = WL_OUT + (size_t)DM * DM * 2, WL_FF2 = WL_FF1 + (size_t)DFF * DM * 2, WL_SIZE = WL_FF2 + (size_t)DM * DFF * 2;
constexpr size_t WS_W = 2 * MiB;
constexpr size_t WS_ACT = ((WS_W + DEPTH * WL_SIZE + MiB - 1) / MiB) * MiB;
constexpr size_t WS_XRES = WS_ACT, WS_X1 = WS_XRES + 64 * MiB, WS_HN = WS_X1 + 64 * MiB, WS_MIX = WS_HN + 32 * MiB, WS_GATES = WS_MIX + 112 * MiB,
                 WS_QUP = WS_GATES + 128 * MiB, WS_OALL = WS_QUP + 24 * MiB, WS_MERGED = WS_OALL + 40 * MiB, WS_FFH = WS_MERGED + 32 * MiB,
                 WS_SCORES = WS_FFH + 128 * MiB, WS_KVS = WS_SCORES + 64 * MiB, WS_PREVR = WS_KVS + 16 * MiB, WS_ST = WS_PREVR + 8 * MiB,
                 WS_PREVS = WS_ST + 32 * MiB, WS_XBCC = WS_PREVS + 16 * MiB, WS_ACS = WS_XBCC + 24 * MiB, WS_BS = WS_ACS + 1 * MiB, WS_SSQH = WS_BS + 1 * MiB, WS_SSP = WS_SSQH + 1 * MiB, WS_FOXKN = WS_SSP + 1 * MiB, WS_DSAKN = WS_FOXKN + 8 * MiB, WS_MSK = WS_DSAKN + 2 * MiB,
                 WS_ONES = WS_MSK + 2 * MiB, WS_END = WS_ONES + 1 * MiB;
constexpr int CW_BAR = 4096;
constexpr int CW_QUEUE = 16384;
constexpr int NQUEUE = 16;

constexpr int LDS_BYTES = 147456;
constexpr int LDS_WORK = 143360;
constexpr int LDS_MISC = LDS_WORK;

DI float bf2f(unsigned short b) { return __uint_as_float(((unsigned)b) << 16); }
DI float bflo(unsigned u) { return __uint_as_float(u << 16); }
DI float bfhi(unsigned u) { return __uint_as_float(u & 0xffff0000u); }
DI unsigned pk2(float lo, float hi) { f32x2 v = {lo, hi}; bf16x2_t b = __builtin_convertvector(v, bf16x2_t); return __builtin_bit_cast(unsigned, b); }
DI unsigned short f2bf(float f) { return (unsigned short)(pk2(f, 0.f) & 0xffffu); }
DI bf16x8 pack8(float a0, float a1, float a2, float a3, float a4, float a5, float a6, float a7) {
    u32x4 p; p.x = pk2(a0, a1); p.y = pk2(a2, a3); p.z = pk2(a4, a5); p.w = pk2(a6, a7); return __builtin_bit_cast(bf16x8, p); }
DI void unpack8(const u32x4 v, float (&f)[8]) { f[0] = bflo(v.x); f[1] = bfhi(v.x); f[2] = bflo(v.y); f[3] = bfhi(v.y); f[4] = bflo(v.z); f[5] = bfhi(v.z); f[6] = bflo(v.w); f[7] = bfhi(v.w); }
DI float sigmoidf_(float x) { return __builtin_amdgcn_rcpf(1.f + __builtin_amdgcn_exp2f(-LOG2E * x)); }
DI float siluf_(float x) { return x * __builtin_amdgcn_rcpf(1.f + __builtin_amdgcn_exp2f(-LOG2E * x)); }
#define MFMA32(a, b, c) __builtin_amdgcn_mfma_f32_32x32x16_bf16((a), (b), (c), 0, 0, 0)
DI int crow(int i, int h) { return (i & 3) + 8 * (i >> 2) + 4 * h; }
DI s16x4 trrd(ldsp p) { return __builtin_bit_cast(s16x4, __builtin_amdgcn_ds_read_tr16_b64_v4i16((LAS s16x4*)p)); }
DI bf16x8 tr_pair(ldsp p, int off2) { s16x4 lo = trrd(p), hi = trrd(p + off2); return __builtin_shufflevector(lo, hi, 0, 1, 2, 3, 4, 5, 6, 7); }
DI float shidx(float v, int src) { return __int_as_float(__builtin_amdgcn_ds_bpermute(src << 2, __float_as_int(v))); }
DI float shx(float v, int m, int lane) { return shidx(v, lane ^ m); }
DI void store_pair_t21(bf16_t* rowp, int k, u32x2 a, u32x2 b, int h) {
    const auto rx = __builtin_amdgcn_permlane32_swap(a.x, b.x, false, false), ry = __builtin_amdgcn_permlane32_swap(a.y, b.y, false, false);
    u32x4 w; w.x = rx[0]; w.y = ry[0]; w.z = rx[1]; w.w = ry[1];
    *(u32x4*)(rowp + 8 * k + (h ? 8 : 0)) = w;
}
DI f32x16 zero16() { f32x16 z; for (int i = 0; i < 16; ++i) z[i] = 0.f; return z; }

#define XB_TMO      128
#define XB_XCNT(j)  (256  + 64 * (j))
#define XB_XSUB(j)  (1280 + 64 * (j))
#define XB_XGEN(j)  (2304 + 64 * (j))
#define XB_TOP      3328
#define XB_TOPGEN   3392
#define XCD_BAR_WORDS 3456
#define XB_SPIN_CAP (1u << 18)
DI unsigned xb_ld(unsigned* p)              { return __hip_atomic_load(p, __ATOMIC_RELAXED, __HIP_MEMORY_SCOPE_AGENT); }
DI unsigned xb_add(unsigned* p, unsigned v) { return __hip_atomic_fetch_add(p, v, __ATOMIC_RELAXED, __HIP_MEMORY_SCOPE_AGENT); }
DI unsigned xb_xcc_id() { return (unsigned)__builtin_amdgcn_s_getreg((3 << 11) | 20) & 0xFu; }
#define XB_SPIN(cond, bar) do { unsigned _sp = 0; while (cond) { __builtin_amdgcn_s_sleep(1); \
    if ((++_sp & 255u) == 0u) { if (xb_ld(&(bar)[XB_TMO])) break; if (_sp > XB_SPIN_CAP) { atomicAdd(&(bar)[XB_TMO], 1u); break; } } } } while (0)
struct XcdBarrier { unsigned* bar; unsigned x; volatile LAS unsigned* st; };
DI XcdBarrier xcd_barrier_post(unsigned* bar, volatile LAS unsigned* st) {
    XcdBarrier b; b.bar = bar; b.x = xb_xcc_id(); b.st = st;
    if (threadIdx.x == 0) (void)xb_add(&bar[XB_XCNT(b.x)], 1u);
    return b;
}
DI void xcd_barrier_complete(unsigned* bar, unsigned x, unsigned& nloc, unsigned& nx) {
    const unsigned G = gridDim.x * gridDim.y * gridDim.z;
    unsigned sum, cnt, mine, sp = 0u;
    for (;;) {
        sum = 0u; cnt = 0u; mine = 0u;
#pragma unroll
        for (unsigned j = 0; j < 16; ++j) { const unsigned c = xb_ld(&bar[XB_XCNT(j)]); sum += c; cnt += (c > 0u) ? 1u : 0u; mine = (j == x) ? c : mine; }
        if (sum == G) break;
        __builtin_amdgcn_s_sleep(1);
        if ((++sp & 255u) == 0u) { if (xb_ld(&bar[XB_TMO])) break; if (sp > XB_SPIN_CAP) { atomicAdd(&bar[XB_TMO], 1u); break; } }
    }
    nloc = mine > 0u ? mine : 1u; nx = cnt > 0u ? cnt : 1u;
}
DI void xcd_barrier(const XcdBarrier& b) {
    asm volatile("s_waitcnt vmcnt(0)" ::: "memory");
    __syncthreads();
    if (threadIdx.x == 0) {
        unsigned* bar = b.bar; { GAS unsigned* w = (GAS unsigned*)bar; asm volatile("" : "+s"(w)); bar = (unsigned*)w; }
        __builtin_amdgcn_s_waitcnt(0);
        unsigned nloc = b.st[0], nx = b.st[1];
        if (nloc == 0u) { xcd_barrier_complete(bar, b.x, nloc, nx); b.st[0] = nloc; b.st[1] = nx; }
        const unsigned old = xb_add(&bar[XB_XSUB(b.x)], 1u);
        const unsigned gen = old / nloc;
        if (old + 1u == (gen + 1u) * nloc) {
            __builtin_amdgcn_fence(__ATOMIC_RELEASE, "agent");
            asm volatile("s_waitcnt vmcnt(0)" ::: "memory");
            const unsigned og = xb_add(&bar[XB_TOP], 1u);
            const unsigned tg = og / nx;
            if (og + 1u == (tg + 1u) * nx) xb_add(&bar[XB_TOPGEN], 1u);
            else XB_SPIN(xb_ld(&bar[XB_TOPGEN]) == tg, bar);
            __builtin_amdgcn_fence(__ATOMIC_ACQUIRE, "agent");
            xb_add(&bar[XB_XGEN(b.x)], 1u);
            asm volatile("s_waitcnt vmcnt(0)" ::: "memory");
        } else {
            XB_SPIN(xb_ld(&bar[XB_XGEN(b.x)]) == gen, bar);
            __builtin_amdgcn_fence(__ATOMIC_ACQUIRE, "agent");
            asm volatile("s_waitcnt vmcnt(0)" ::: "memory");
        }
    }
    __syncthreads();
}

namespace pg8 {
constexpr int BM = 256, BK = 64, HALF = 128, HTB = HALF * BK * 2, STAGE_BYTES = 8 * HTB, NXCD = 8, WGM = 8;
__host__ __device__ __forceinline__ int lds_byte(int r, int c) { const int st = (r >> 4) * 2 + (c >> 5), rr = r & 15, cc = c & 31, ob = rr * 64 + cc * 2; return st * 1024 + (ob ^ (((ob >> 9) & 1) << 5)); }
__host__ __device__ __forceinline__ void stage_rc(int b, int& R, int& C) { const int st = b / 1024, sb = b % 1024, swz = sb ^ (((sb >> 9) & 1) << 5); R = (st >> 1) * 16 + swz / 64; C = (st & 1) * 32 + (swz % 64) / 2; }
__host__ __device__ __forceinline__ int perm32(int rho) { const int n = rho >> 4, i = rho & 15; return 8 * (i >> 2) + 4 * n + (i & 3); }
struct Unit { int pm, pn; };
struct Gemm { const bf16_t* A; const bf16_t* Bt; int M, N, K, lda, ldb; };
struct StaticOrder {
    int nM, nN, nwg, G, c;
    __host__ __device__ void init(int M, int N, int G_, int c_) { nM = M / BM; nN = N / BM; nwg = nM * nN; G = G_; c = c_; }
    __host__ __device__ bool next(int i, Unit& u) const {
        const long L = (long)i * G + c; if (L >= nwg) return false;
        int wgid = (int)L; { const int q = nwg / NXCD, r = nwg % NXCD, xcd = wgid % NXCD, off = wgid / NXCD; wgid = (xcd < r ? xcd * (q + 1) : r * (q + 1) + (xcd - r) * q) + off; }
        const int nig = WGM * nN, gid = wgid / nig, fm = gid * WGM, gsz = (nM - fm) < WGM ? (nM - fm) : WGM;
        u.pm = fm + ((wgid % nig) % gsz); u.pn = (wgid % nig) / gsz; return true;
    }
};
typedef f32x4 Acc[2][2][4][2];

template <class Epi>
DI void gemm_phase(ldsp lds, const Gemm g, const StaticOrder& S, const Epi& E) {
    int tid = threadIdx.x; asm volatile("" : "+v"(tid));
    const int wid = __builtin_amdgcn_readfirstlane(tid >> 6), lane = tid & 63, wr = wid >> 2, wc = wid & 3, fr = lane & 15, fq = lane >> 4;
    const int K = g.K, nt = K / BK;
    unsigned voffA[2], voffB[2];
#pragma unroll
    for (int i = 0; i < 2; ++i) { int R, C; stage_rc(tid * 16 + i * 8192, R, C); const int Rb = Epi::PERM ? ((R & ~31) + perm32(R & 31)) : R;
        voffA[i] = (unsigned)(R * g.lda + C) * 2u; voffB[i] = (unsigned)(Rb * g.ldb + C) * 2u; }
    const size_t kstep = (size_t)(BK * 2);
    const size_t hstepA = (size_t)HALF * g.lda * 2, hstepB = (size_t)HALF * g.ldb * 2;
    const size_t tstepA = 2 * hstepA, tstepB = 2 * hstepB;
    const unsigned ldsw = (unsigned)wid * 1024u;
    const int aoff = lds_byte(wr * 64 + fr, fq * 8), boff = lds_byte(wc * 32 + fr, fq * 8);
#define PG8_SA(b, h) (((b) * 2 + (h)) * HTB)
#define PG8_SB(b, h) ((4 + (b) * 2 + (h)) * HTB)
#define PG8_STAGE(bufoff, gbase, voff) do { _Pragma("unroll") for (int _i = 0; _i < 2; ++_i) \
        __builtin_amdgcn_global_load_lds((const unsigned*)((const char*)(gbase) + (voff)[_i]), (LAS unsigned*)(lds + (bufoff) + ldsw + _i * 8192), 16, 0, 0); } while (0)
#define PG8_LDA(dst, b, h) do { _Pragma("unroll") for (int m = 0; m < 4; ++m) _Pragma("unroll") for (int k = 0; k < 2; ++k) dst[m][k] = *(const LAS bf16x8*)(lds + PG8_SA(b, h) + aoff + m * 2048 + k * 1024); } while (0)
#define PG8_LDB(dst, b, h) do { _Pragma("unroll") for (int n = 0; n < 2; ++n) _Pragma("unroll") for (int k = 0; k < 2; ++k) dst[n][k] = *(const LAS bf16x8*)(lds + PG8_SB(b, h) + boff + n * 2048 + k * 1024); } while (0)
#define PG8_MMA(ai, bj, At, Bt) do { __builtin_amdgcn_s_setprio(1); _Pragma("unroll") for (int m = 0; m < 4; ++m) _Pragma("unroll") for (int n = 0; n < 2; ++n) _Pragma("unroll") for (int k = 0; k < 2; ++k) \
        acc[ai][bj][m][n] = __builtin_amdgcn_mfma_f32_16x16x32_bf16(Bt[n][k], At[m][k], acc[ai][bj][m][n], 0, 0, 0); __builtin_amdgcn_s_setprio(0); } while (0)
#define PG8_WAIT_V(n) asm volatile("s_waitcnt vmcnt(" #n ")" ::: "memory")
#define PG8_WAIT_L(n) asm volatile("s_waitcnt lgkmcnt(" #n ")" ::: "memory")
#define PG8_BAR __builtin_amdgcn_s_barrier()
#define PG8_SCHED __builtin_amdgcn_sched_barrier(0)
    Unit cur, nxt; int ui = 0;
    if (!S.next(0, cur)) return;
    if constexpr (Epi::HAS_MID) { E.prep(lds, cur, tid); __syncthreads(); }
    Acc acc;
#pragma unroll
    for (int a = 0; a < 2; ++a)
#pragma unroll
        for (int b = 0; b < 2; ++b)
#pragma unroll
            for (int m = 0; m < 4; ++m)
#pragma unroll
                for (int n = 0; n < 2; ++n) acc[a][b][m][n] = (f32x4){0.f, 0.f, 0.f, 0.f};
    bf16x8 At[4][2], B0[2][2], B1[2][2];
    f32x4 rsA = {0.f, 0.f, 0.f, 0.f}, rsB = rsA;
    const char* cA = (const char*)g.A + (size_t)cur.pm * tstepA; const char* cB = (const char*)g.Bt + (size_t)cur.pn * tstepB;
    PG8_STAGE(PG8_SB(0, 0), cB, voffB); PG8_STAGE(PG8_SB(0, 1), cB + hstepB, voffB); PG8_STAGE(PG8_SA(0, 0), cA, voffA); PG8_STAGE(PG8_SA(0, 1), cA + hstepA, voffA);
    if (wr == 1) PG8_BAR;
    PG8_WAIT_V(2); PG8_BAR;
    PG8_STAGE(PG8_SB(1, 0), cB + kstep, voffB); PG8_STAGE(PG8_SA(1, 0), cA + kstep, voffA); PG8_STAGE(PG8_SB(1, 1), cB + hstepB + kstep, voffB);
    PG8_WAIT_V(6); PG8_BAR;
    for (;;) {
        const bool has_next = S.next(ui + 1, nxt);
        const char* nA = has_next ? (const char*)g.A + (size_t)nxt.pm * tstepA : cA; const char* nB = has_next ? (const char*)g.Bt + (size_t)nxt.pn * tstepB : cB;
        for (int t = 0; t < nt; t += 2) {
            const bool last = (t == nt - 2);
            const char* a1 = cA + (size_t)(t + 1) * kstep;
            const char* a2 = last ? nA : cA + (size_t)(t + 2) * kstep; const char* b2 = last ? nB : cB + (size_t)(t + 2) * kstep;
            const char* a3 = a2 + kstep; const char* b3 = b2 + kstep;
            if constexpr (Epi::HAS_MID) { if (E.is_mid(t)) { E.mid(acc, cur, t, wr, wc, fr, fq, lds); PG8_SCHED; } }
            if constexpr (Epi::ROWSCALE) { if (last && tid < 256) { const f32x4* sp = (const f32x4*)(E.ssp + (size_t)(cur.pm * BM + tid) * 8); rsA = sp[0]; rsB = sp[1]; } }
            PG8_LDB(B0, 0, 0); PG8_LDB(B1, 0, 1); PG8_SCHED; PG8_LDA(At, 0, 0); PG8_STAGE(PG8_SA(1, 1), a1 + hstepA, voffA);
            PG8_WAIT_V(8); PG8_WAIT_L(0); PG8_BAR; PG8_MMA(0, 0, At, B0); PG8_MMA(0, 1, At, B1); PG8_BAR; PG8_SCHED;
            PG8_LDA(At, 0, 1); PG8_STAGE(PG8_SB(0, 0), b2, voffB); PG8_STAGE(PG8_SB(0, 1), b2 + hstepB, voffB); PG8_STAGE(PG8_SA(0, 0), a2, voffA);
            PG8_WAIT_V(8); PG8_WAIT_L(0); PG8_BAR; PG8_MMA(1, 0, At, B0); PG8_MMA(1, 1, At, B1); PG8_BAR; PG8_SCHED;
            PG8_LDB(B0, 1, 0); PG8_LDB(B1, 1, 1); PG8_SCHED; PG8_LDA(At, 1, 0); PG8_STAGE(PG8_SA(0, 1), a2 + hstepA, voffA);
            PG8_WAIT_V(8); PG8_WAIT_L(0); PG8_BAR; PG8_MMA(0, 0, At, B0); PG8_MMA(0, 1, At, B1); PG8_BAR; PG8_SCHED;
            PG8_LDA(At, 1, 1); PG8_STAGE(PG8_SB(1, 0), b3, voffB); PG8_STAGE(PG8_SB(1, 1), b3 + hstepB, voffB); PG8_STAGE(PG8_SA(1, 0), a3, voffA);
            PG8_WAIT_V(8); PG8_WAIT_L(0); PG8_BAR; PG8_MMA(1, 0, At, B0); PG8_MMA(1, 1, At, B1); PG8_BAR; PG8_SCHED;
        }
        if (wr == 0) PG8_BAR;
        if constexpr (Epi::ROWSCALE) {
            LAS float* tab = (LAS float*)(lds + STAGE_BYTES);
            if (tid < 256) { const float t = ((rsA[0] + rsA[1]) + (rsA[2] + rsA[3])) + ((rsB[0] + rsB[1]) + (rsB[2] + rsB[3])); tab[tid] = __builtin_amdgcn_rsqf(t * (1.f / (float)DM) + EPS); }
            PG8_WAIT_L(0); PG8_BAR; asm volatile("" ::: "memory");
        }
        E(acc, cur, wr, wc, fr, fq, lds);
        if (!has_next) break;
#pragma unroll
        for (int a = 0; a < 2; ++a)
#pragma unroll
            for (int b = 0; b < 2; ++b)
#pragma unroll
                for (int m = 0; m < 4; ++m)
#pragma unroll
                    for (int n = 0; n < 2; ++n) acc[a][b][m][n] = (f32x4){0.f, 0.f, 0.f, 0.f};
        cur = nxt; cA = nA; cB = nB; ++ui;
        if constexpr (Epi::HAS_MID) { PG8_BAR; E.prep(lds, cur, tid); PG8_WAIT_L(0); PG8_BAR; }
        if (wr == 1) PG8_BAR;
    }
    PG8_WAIT_V(0);
    PG8_BAR;
#undef PG8_SA
#undef PG8_SB
#undef PG8_STAGE
#undef PG8_LDA
#undef PG8_LDB
#undef PG8_MMA
#undef PG8_WAIT_V
#undef PG8_WAIT_L
#undef PG8_BAR
#undef PG8_SCHED
}

DI void store8(bf16_t* p, const f32x4 v0, const f32x4 v1) { u32x4 w; w.x = pk2(v0[0], v0[1]); w.y = pk2(v0[2], v0[3]); w.z = pk2(v1[0], v1[1]); w.w = pk2(v1[2], v1[3]); *(u32x4*)p = w; }
struct EpiIn {
    static constexpr bool PERM = true, HAS_MID = false, ROWSCALE = true;
    bf16_t* mix; bf16_t* gates; const float* gate_b; const float* ssp;
    DI void operator()(const Acc& acc, const Unit& u, int wr, int wc, int fr, int fq, ldsp lds) const {
        const int row0 = u.pm * BM + wr * 64 + fr; const LAS float* tab = (const LAS float*)(lds + STAGE_BYTES);
        if (u.pn < NMIX / BM) {
            const int col0 = u.pn * BM + wc * 32 + 8 * fq;
#pragma unroll
            for (int ai = 0; ai < 2; ++ai)
#pragma unroll
                for (int m = 0; m < 4; ++m) { const float rs = tab[wr * 64 + fr + ai * HALF + m * 16]; bf16_t* rowp = mix + (size_t)(row0 + ai * HALF + m * 16) * NMIX + col0;
#pragma unroll
                    for (int bj = 0; bj < 2; ++bj) store8(rowp + bj * HALF, acc[ai][bj][m][0] * rs, acc[ai][bj][m][1] * rs); }
        } else {
            const int ch8 = (u.pn - NMIX / BM) * 64 + wc * 16 + 8 * (fq & 1), ch0 = ch8 + 4 * (fq >> 1), h = fq >> 1;
            f32x4 bv[4];
#pragma unroll
            for (int i = 0; i < 4; ++i) bv[i] = *(const f32x4*)(gate_b + i * DM + ch0);
#pragma unroll
            for (int ai = 0; ai < 2; ++ai)
#pragma unroll
                for (int m = 0; m < 4; ++m) { const float rs = tab[wr * 64 + fr + ai * HALF + m * 16]; bf16_t* rowp = gates + (size_t)(row0 + ai * HALF + m * 16) * NGATE + ch8;
                    f32x4 d[4], e[4];
#pragma unroll
                    for (int i = 0; i < 4; ++i) { const f32x4 x = acc[ai][i >> 1][m][i & 1] * rs + bv[i];
#pragma unroll
                        for (int j = 0; j < 4; ++j) { d[i][j] = fminf(1.f + __builtin_amdgcn_exp2f(-LOG2E * x[j]), 1e20f); e[i][j] = __builtin_amdgcn_rcpf(d[i][j]); } }
#pragma unroll
                    for (int k = 0; k < 4; k += 2) { const f32x4 ra = e[k] * d[k + 1], rb = (k + 1 < 3) ? e[k + 1] * d[k + 1 < 3 ? k + 2 : 3] : e[3];
                        const auto rx = __builtin_amdgcn_permlane32_swap(pk2(ra[0], ra[1]), pk2(rb[0], rb[1]), false, false), ry = __builtin_amdgcn_permlane32_swap(pk2(ra[2], ra[3]), pk2(rb[2], rb[3]), false, false);
                        u32x4 w; w.x = rx[0]; w.y = ry[0]; w.z = rx[1]; w.w = ry[1];
                        *(u32x4*)(rowp + (k + h) * DM) = w; } }
        }
    }
};
template <int ACT  > struct EpiBf16 {
    static constexpr bool PERM = true, HAS_MID = false, ROWSCALE = (ACT == 1);
    bf16_t* O; int ldc; const float* ssp;
    DI void operator()(const Acc& acc, const Unit& u, int wr, int wc, int fr, int fq, ldsp lds) const {
        const int row0 = u.pm * BM + wr * 64 + fr, col0 = u.pn * BM + wc * 32 + 8 * fq; const LAS float* tab = (const LAS float*)(lds + STAGE_BYTES);
#pragma unroll
        for (int ai = 0; ai < 2; ++ai)
#pragma unroll
            for (int m = 0; m < 4; ++m) { bf16_t* rowp = O + (size_t)(row0 + ai * HALF + m * 16) * ldc + col0;
                float rs2 = 1.f; if (ACT == 1) { const float rs = tab[wr * 64 + fr + ai * HALF + m * 16]; rs2 = rs * rs; }
#pragma unroll
                for (int bj = 0; bj < 2; ++bj) { f32x4 v0 = acc[ai][bj][m][0], v1 = acc[ai][bj][m][1];
                    if (ACT == 1) {
#pragma unroll
                        for (int j = 0; j < 4; ++j) { const float a = fmaxf(v0[j], 0.f), b = fmaxf(v1[j], 0.f); v0[j] = a * a * rs2; v1[j] = b * b * rs2; } }
                    store8(rowp + bj * HALF, v0, v1); } }
    }
};
template <int RES, int OUTF> struct EpiResid {
    static constexpr bool PERM = true, HAS_MID = false, ROWSCALE = false;
    const void* resid; float* out; bf16_t* xb; float* ssp; int ldc;
    DI void operator()(const Acc& acc, const Unit& u, int wr, int wc, int fr, int fq, ldsp lds) const {
        const int row0 = u.pm * BM + wr * 64 + fr, col0 = u.pn * BM + wc * 32 + 8 * fq;
#pragma unroll
        for (int ai = 0; ai < 2; ++ai) {
            f32x4 rf[RES == 0 ? 4 : 1][2][2]; u32x4 rw[RES == 1 ? 4 : 1][2];
#pragma unroll
            for (int m = 0; m < 4; ++m) { const size_t off = (size_t)(row0 + ai * HALF + m * 16) * ldc + col0;
#pragma unroll
                for (int bj = 0; bj < 2; ++bj) {
                    if (RES == 0) { rf[RES == 0 ? m : 0][bj][0] = *(const f32x4*)((const float*)resid + off + bj * HALF); rf[RES == 0 ? m : 0][bj][1] = *(const f32x4*)((const float*)resid + off + bj * HALF + 4); }
                    else rw[RES == 1 ? m : 0][bj] = *(const u32x4*)((const bf16_t*)resid + off + bj * HALF); } }
#pragma unroll
            for (int m = 0; m < 4; ++m) { const int row = row0 + ai * HALF + m * 16; const size_t off = (size_t)row * ldc + col0; float ss = 0.f;
#pragma unroll
                for (int bj = 0; bj < 2; ++bj) { f32x4 r0, r1;
                    if (RES == 0) { r0 = rf[RES == 0 ? m : 0][bj][0]; r1 = rf[RES == 0 ? m : 0][bj][1]; }
                    else { float f[8]; unpack8(rw[RES == 1 ? m : 0][bj], f); r0 = (f32x4){f[0], f[1], f[2], f[3]}; r1 = (f32x4){f[4], f[5], f[6], f[7]}; }
                    const f32x4 o0 = r0 + acc[ai][bj][m][0], o1 = r1 + acc[ai][bj][m][1];
                    if (OUTF) { *(f32x4*)(out + off + bj * HALF) = o0; *(f32x4*)(out + off + bj * HALF + 4) = o1; }
                    else { ss += ((o0[0] * o0[0] + o0[1] * o0[1]) + (o0[2] * o0[2] + o0[3] * o0[3])) + ((o1[0] * o1[0] + o1[1] * o1[1]) + (o1[2] * o1[2] + o1[3] * o1[3])); store8(xb + off + bj * HALF, o0, o1); } }
                if (!OUTF) { ss += shx(ss, 16, fr + 16 * fq); ss += shx(ss, 32, fr + 16 * fq); if (fq == 0) ((LAS float*)(lds + STAGE_BYTES))[(wr * 64 + fr + ai * HALF + m * 16) * 4 + wc] = ss; } } }
        if (!OUTF) {
            asm volatile("s_waitcnt lgkmcnt(0)" ::: "memory"); __builtin_amdgcn_s_barrier(); asm volatile("" ::: "memory");
            const int t = 64 * (4 * wr + wc) + fr + 16 * fq;
            if (t < 256) { const f32x4 q = *(const LAS f32x4*)(lds + STAGE_BYTES + t * 16); ssp[(size_t)(u.pm * BM + t) * 8 + u.pn] = (q[0] + q[1]) + (q[2] + q[3]); }
        }
    }
};
struct EpiMerge {
    static constexpr bool PERM = true, HAS_MID = true, ROWSCALE = false;
    bf16_t* O; const bf16_t* gates; const float* ssqh; const bf16_t* ones;
    DI bool is_mid(int t) const { return t == 8 || t == 16 || t == 24 || t == 32; }
    DI void prep(ldsp lds, const Unit& u, int tid) const {
        if (tid < 256) { const f32x4* p = (const f32x4*)(ssqh + (size_t)(u.pm * BM + tid) * 16); const f32x4 a = p[0], b = p[1], c = p[2], d = p[3];
            const float s0 = ((a[0] + a[1]) + (a[2] + a[3])) + ((b[0] + b[1]) + (b[2] + b[3])), s1 = ((c[0] + c[1]) + (c[2] + c[3])) + ((d[0] + d[1]) + (d[2] + d[3]));
            LAS float* tab = (LAS float*)(lds + STAGE_BYTES) + 2 * tid; tab[0] = __builtin_amdgcn_rsqf(s0 * (1.f / 512.f) + EPS); tab[1] = __builtin_amdgcn_rsqf(s1 * (1.f / 512.f) + EPS); }
    }
    DI void ld8(const bf16_t* p, float (&f)[8]) const { unpack8(*(const u32x4*)p, f); }
    DI void ldb(u32x4 (&g)[2][2], const bf16_t* pl, size_t pitch, int row0, int b) const {
#pragma unroll
        for (int m2 = 0; m2 < 2; ++m2)
#pragma unroll
            for (int bj = 0; bj < 2; ++bj) g[m2][bj] = *(const u32x4*)(pl + (size_t)(row0 + (b >> 1) * HALF + (2 * (b & 1) + m2) * 16) * pitch + bj * HALF);
    }
    DI void mid(Acc& acc, const Unit& u, int t, int wr, int wc, int fr, int fq, ldsp lds) const {
        int row0 = u.pm * BM + wr * 64 + fr; asm volatile("" : "+v"(row0));
        const int col0 = u.pn * BM + wc * 32 + 8 * fq;
        const int seg = t >> 3;
        const bf16_t* pl = (seg < 4 ? gates + (seg - 1) * DM : ones) + col0; const size_t pitch = seg < 4 ? (size_t)NGATE : (size_t)0;
        const unsigned m3 = (seg == 3) ? 0xffffffffu : 0u, m4 = (seg == 4) ? 0xffffffffu : 0u, one = 0x3f800000u;
        const LAS f32x2* tab = (const LAS f32x2*)(lds + STAGE_BYTES);
        u32x4 gb[2][2][2];
        ldb(gb[0], pl, pitch, row0, 0);
#pragma unroll
        for (int b = 0; b < 4; ++b) { const int ai = b >> 1, mh = b & 1;
            if (b + 1 < 4) ldb(gb[(b + 1) & 1], pl, pitch, row0, b + 1);
#pragma unroll
            for (int m2 = 0; m2 < 2; ++m2) { const int m = 2 * mh + m2; const f32x2 r = tab[wr * 64 + fr + ai * HALF + m * 16];
                const unsigned u0 = __float_as_uint(r[0]), u1 = __float_as_uint(r[1]);
                const float sa = __uint_as_float((u0 & m4) | (one & ~m4)), sb = __uint_as_float((u0 & m3) | (u1 & m4) | (one & ~(m3 | m4)));
                const float rr = sa * __builtin_amdgcn_rcpf(sb);
#pragma unroll
                for (int bj = 0; bj < 2; ++bj) { float q[8]; unpack8(gb[b & 1][m2][bj], q);
#pragma unroll
                    for (int j = 0; j < 4; ++j) { acc[ai][bj][m][0][j] *= q[j] * rr; acc[ai][bj][m][1][j] *= q[4 + j] * rr; } } }
            asm volatile("" ::: "memory"); }
    }
    DI void operator()(const Acc& acc, const Unit& u, int wr, int wc, int fr, int fq, ldsp lds) const {
        const int row0 = u.pm * BM + wr * 64 + fr, col0 = u.pn * BM + wc * 32 + 8 * fq;
        const LAS f32x2* tab = (const LAS f32x2*)(lds + STAGE_BYTES);
#pragma unroll
        for (int ai = 0; ai < 2; ++ai) {
            u32x4 gg[4][2];
#pragma unroll
            for (int m = 0; m < 4; ++m)
#pragma unroll
                for (int bj = 0; bj < 2; ++bj) gg[m][bj] = *(const u32x4*)(gates + (size_t)(row0 + ai * HALF + m * 16) * NGATE + 3 * DM + col0 + bj * HALF);
#pragma unroll
            for (int m = 0; m < 4; ++m) { const int row = row0 + ai * HALF + m * 16; const float r1 = tab[wr * 64 + fr + ai * HALF + m * 16][1];
#pragma unroll
                for (int bj = 0; bj < 2; ++bj) { float g[8]; unpack8(gg[m][bj], g); f32x4 v0 = acc[ai][bj][m][0], v1 = acc[ai][bj][m][1];
#pragma unroll
                    for (int j = 0; j < 4; ++j) { v0[j] *= g[j] * r1; v1[j] *= g[4 + j] * r1; }
                    store8(O + (size_t)row * DM + col0 + bj * HALF, v0, v1); } }
            asm volatile("" ::: "memory"); }
    }
};
}

struct Params {
    const float* x; const float* norm1_g; const float* w_in; const float* gate_b; const float* fox_f_b; const float* fox_qn_g; const float* fox_kn_g;
    const float* dsa_cq_g; const float* dsa_w_uq; const float* dsa_w_qidx; const float* dsa_qn_g; const float* dsa_kn_g; const float* rel_bias;
    const float* ssd_conv_w; const float* ssd_conv_b; const float* ssd_dt_bias; const float* ssd_a_log; const float* ssd_d; const float* ssd_norm_g;
    const float* w_br; const float* w_out; const float* norm2_g; const float* w_ff1; const float* w_ff2;
    float* out; unsigned char* ws;
    int ph_lo, ph_hi, rep, pad;
};
struct Ctx {
    ldsp lds; int tid, lane, wave, G, bid;
    gu32* ctl;
};
DI Ctx fresh(const Ctx& c0) { Ctx c = c0; int t = c0.tid; asm volatile("" : "+v"(t)); c.tid = t; c.lane = t & 63; c.wave = __builtin_amdgcn_readfirstlane(t >> 6); return c; }
DI Params freshp(const Params& p0) { Params p = p0; GAS unsigned char* w = (GAS unsigned char*)p0.ws; asm volatile("" : "+s"(w)); p.ws = (unsigned char*)w; return p; }
typedef __attribute__((address_space(4))) const Params* kargp;
DI Params loadp() {
#if defined(__HIP_DEVICE_COMPILE__)
    kargp k = (kargp)__builtin_amdgcn_kernarg_segment_ptr(); asm volatile("" : "+s"(k)); Params p = *k;
    GAS unsigned char* w = (GAS unsigned char*)p.ws; asm volatile("" : "+s"(w)); p.ws = (unsigned char*)w; return p;
#else
    return Params{};
#endif
}
DI bf16_t* wsb(const Params& p, size_t off) { return (bf16_t*)(p.ws + off); }
DI float*  wsf(const Params& p, size_t off) { return (float*)(p.ws + off); }

DI int next_unit(const Ctx& c, int layer, int q) {
    volatile LAS int* slot = (volatile LAS int*)(c.lds + LDS_MISC);
    __syncthreads();
    int qi = (layer * NQUEUE + q) * 64; asm volatile("" : "+s"(qi));
    if (c.tid == 0) *slot = (int)__hip_atomic_fetch_add((unsigned*)(c.ctl + CW_QUEUE + qi), 1u, __ATOMIC_RELAXED, __HIP_MEMORY_SCOPE_AGENT);
    __syncthreads();
    return *slot;
}

DI int in_dest_row(int n) {
    if (n < 3584) return n;
    if (n < 3588) return C_FF + (n - 3584);
    if (n < 4420) return n - 4;
    if (n < 4436) return C_IW + (n - 4420);
    if (n < 6996) return n - 20;
    if (n < 7012) return n - 4;
    const int g = n - 7012, i = g >> 11, ch = g & 2047, tp = ch >> 6, cl = ch & 63;
    return NMIX + 256 * tp + 128 * (i >> 1) + 32 * (cl >> 4) + 8 * (((cl >> 3) & 1) + 2 * ((cl >> 2) & 1)) + 4 * (i & 1) + (cl & 3);
}
template <int MAP>
DI void transpose_item(const float* W, int K, int N, bf16_t* WT, int ldk, int row_off, const float* kscale, LAS float* scr, int item, int lane) {
    const int nblk = (N + 63) / 64, kb = item / nblk, nb = item % nblk, k0 = 64 * kb, n0 = 64 * nb;
    const int nq = n0 + 4 * (lane & 15); const bool nok = nq < N;
    f32x4 v[16];
#pragma unroll
    for (int i = 0; i < 16; ++i) { const int kk = 4 * i + (lane >> 4); v[i] = nok ? *(const f32x4*)(W + (size_t)(k0 + kk) * N + nq) : (f32x4){0.f, 0.f, 0.f, 0.f}; }
    const int c = lane & 7;
    f32x4 s0 = {1.f, 1.f, 1.f, 1.f}, s1 = s0; if (kscale) { s0 = *(const f32x4*)(kscale + k0 + 8 * c); s1 = *(const f32x4*)(kscale + k0 + 8 * c + 4); }
#pragma unroll
    for (int i = 0; i < 16; ++i) { const int kk = 4 * i + (lane >> 4); LAS float* d = scr + kk * 65 + 4 * (lane & 15); d[0] = v[i][0]; d[1] = v[i][1]; d[2] = v[i][2]; d[3] = v[i][3]; }
    asm volatile("s_waitcnt lgkmcnt(0)" ::: "memory");
#pragma unroll
    for (int j = 0; j < 8; ++j) { const int n = (lane >> 3) + 8 * j; const LAS float* s = scr + (8 * c) * 65 + n;
        u32x4 o; o.x = pk2(s[0 * 65] * s0[0], s[1 * 65] * s0[1]); o.y = pk2(s[2 * 65] * s0[2], s[3 * 65] * s0[3]); o.z = pk2(s[4 * 65] * s1[0], s[5 * 65] * s1[1]); o.w = pk2(s[6 * 65] * s1[2], s[7 * 65] * s1[3]);
        if (n0 + n < N) { const int dr = MAP ? in_dest_row(n0 + n) : row_off + n0 + n; *(u32x4*)(WT + (size_t)dr * ldk + k0 + 8 * c) = o; } }
    asm volatile("s_waitcnt lgkmcnt(0)" ::: "memory");
}
constexpr int I_IN = (DM / 64) * ((IN_TOTAL + 63) / 64), I_UQ = (KUP / 64) * (512 / 64), I_QI = (KUP / 64) * (1024 / 64), I_BR = (KBR / 64) * (DM / 64),
              I_OUT = (DM / 64) * (DM / 64), I_F1 = (DM / 64) * (DFF / 64), I_F2 = (DFF / 64) * (DM / 64), PER_LAYER = I_IN + I_UQ + I_QI + I_BR + I_OUT + I_F1 + I_F2;
DI void convert_items(const Params& p0, const Ctx& c0, int l, int lo, int hi, int wv, int nw) {
    const Ctx c = fresh(c0); const Params p = freshp(p0);
    LAS float* scr = (LAS float*)(c.lds + c.wave * 16640);
    unsigned char* wl = p.ws + WS_W + (size_t)l * WL_SIZE;
    for (int it = lo + wv; it < hi; it += nw) {
        int r = it;
        if (r < I_IN) { transpose_item<1>(p.w_in + (size_t)l * DM * IN_TOTAL, DM, IN_TOTAL, (bf16_t*)(wl + WL_IN), DM, 0, p.norm1_g + l * DM, scr, r, c.lane); continue; } r -= I_IN;
        if (r < I_UQ) { transpose_item<0>(p.dsa_w_uq + (size_t)l * KUP * 512, KUP, 512, (bf16_t*)(wl + WL_UP), KUP, 0, p.dsa_cq_g + l * KUP, scr, r, c.lane); continue; } r -= I_UQ;
        if (r < I_QI) { transpose_item<0>(p.dsa_w_qidx + (size_t)l * KUP * 1024, KUP, 1024, (bf16_t*)(wl + WL_UP), KUP, 512, p.dsa_cq_g + l * KUP, scr, r, c.lane); continue; } r -= I_QI;
        if (r < I_BR) { transpose_item<0>(p.w_br + (size_t)l * KBR * DM, KBR, DM, (bf16_t*)(wl + WL_BR), KBR, 0, nullptr, scr, r, c.lane); continue; } r -= I_BR;
        if (r < I_OUT) { transpose_item<0>(p.w_out + (size_t)l * DM * DM, DM, DM, (bf16_t*)(wl + WL_OUT), DM, 0, nullptr, scr, r, c.lane); continue; } r -= I_OUT;
        if (r < I_F1) { transpose_item<0>(p.w_ff1 + (size_t)l * DM * DFF, DM, DFF, (bf16_t*)(wl + WL_FF1), DM, 0, p.norm2_g + l * DM, scr, r, c.lane); continue; } r -= I_F1;
        transpose_item<0>(p.w_ff2 + (size_t)l * DFF * DM, DFF, DM, (bf16_t*)(wl + WL_FF2), DFF, 0, nullptr, scr, r, c.lane);
    }
}
constexpr int CV_B = 3072;
DI void convert_on_idle(const Params& p, const Ctx& c, int l, int lo, int hi, int nunits) {
    const int first_idle = nunits % c.G;
    if (first_idle == 0) convert_items(p, c, l, lo, hi, c.bid * 8 + c.wave, c.G * 8);
    else if (c.bid >= first_idle) convert_items(p, c, l, lo, hi, (c.bid - first_idle) * 8 + c.wave, (c.G - first_idle) * 8);
}
DI void p0_prologue(const Params& p0, const Ctx& c0) {
    const Ctx c = fresh(c0); const Params p = freshp(p0);
    convert_items(p, c, 0, 0, I_IN, c.bid * 8 + c.wave, c.G * 8);
    if (c.bid == 0 && c.tid < 256) *(u32x4*)(wsb(p, WS_ONES) + 8 * c.tid) = (u32x4){0x3f803f80u, 0x3f803f80u, 0x3f803f80u, 0x3f803f80u};
    constexpr int PADROWS = NMIX - C_MIXEND, CH = DM / 8;
    for (int i = (c.bid * 512 + c.tid); i < DEPTH * PADROWS * CH; i += c.G * 512) { const int l = i / (PADROWS * CH), r = (i / CH) % PADROWS, ch = i % CH;
        *(u32x4*)((bf16_t*)(p.ws + WS_W + (size_t)l * WL_SIZE + WL_IN) + (size_t)(C_MIXEND + r) * DM + ch * 8) = (u32x4){0u, 0u, 0u, 0u}; }
}

DI float wave_sum(float v, int lane) {
#pragma unroll
    for (int o = 1; o < 64; o <<= 1) v += shx(v, o, lane);
    return v;
}
DI void xprep_phase(const Ctx& c0, const float* x, bf16_t* xb, float* ssp) {
    const Ctx c = fresh(c0);
    const int gw = c.bid * 8 + c.wave, NGW = c.G * 8;
    for (int m = gw; m < MTOK; m += NGW) {
        const f32x4* xr = (const f32x4*)(x + (size_t)m * DM) + c.lane;
        f32x4 v[8]; float s = 0.f;
#pragma unroll
        for (int j = 0; j < 8; ++j) { v[j] = xr[64 * j]; s += (v[j][0] * v[j][0] + v[j][1] * v[j][1]) + (v[j][2] * v[j][2] + v[j][3] * v[j][3]); }
        s = wave_sum(s, c.lane);
        u32x2* o = (u32x2*)(xb + (size_t)m * DM) + c.lane;
#pragma unroll
        for (int j = 0; j < 8; ++j) { u32x2 w; w.x = pk2(v[j][0], v[j][1]); w.y = pk2(v[j][2], v[j][3]); o[64 * j] = w; }
        if (c.lane < 8) ssp[(size_t)m * 8 + c.lane] = (c.lane == 0) ? s : 0.f;
    }
}

DI void scan_phase(const Params& p0, const Ctx& c0) {
    const Ctx c = fresh(c0); const Params p = freshp(p0);
    const float* kvs = wsf(p, WS_KVS); bf16_t* prevr = wsb(p, WS_PREVR); const float* st = wsf(p, WS_ST); bf16_t* prevs = wsb(p, WS_PREVS); const float* acs = wsf(p, WS_ACS);
    const int gt = c.bid * 512 + c.tid, NT = c.G * 512;
    for (int e = gt; e < 16 * 4096; e += NT) {
        const int bh = e / 4096, q = e % 4096, h = bh & 3;
        const float cd = __expf(128.f * log1pf(-exp2f(-5.f - (float)h)));
        f32x4 kv[16];
#pragma unroll
        for (int n = 0; n < 16; ++n) kv[n] = *(const f32x4*)(kvs + ((size_t)(bh * 16 + n) * 16384) + (size_t)q * 4);
        f32x4 s = {0.f, 0.f, 0.f, 0.f};
#pragma unroll
        for (int n = 0; n < 16; ++n) { const size_t o = ((size_t)(bh * 16 + n) * 16384) + (size_t)q * 4;
            u32x2 w; w.x = pk2(s[0], s[1]); w.y = pk2(s[2], s[3]); *(u32x2*)(prevr + o) = w; s = s * cd + kv[n]; }
    }
    for (int e = gt; e < 64 * 2048; e += NT) {
        const int bhd = e / 2048, q = e % 2048, b = bhd >> 4, hd = bhd & 15;
        f32x4 v[16]; float cd[16];
#pragma unroll
        for (int n = 0; n < 16; ++n) { v[n] = *(const f32x4*)(st + ((size_t)((b * 16 + n) * 16 + hd) * 8192) + (size_t)q * 4); cd[n] = acs[(size_t)(b * SEQ + 128 * n + 127) * 16 + hd]; }
        f32x4 s = {0.f, 0.f, 0.f, 0.f};
#pragma unroll
        for (int n = 0; n < 16; ++n) { const size_t o = ((size_t)((b * 16 + n) * 16 + hd) * 8192) + (size_t)q * 4;
            u32x2 w; w.x = pk2(s[0], s[1]); w.y = pk2(s[2], s[3]); *(u32x2*)(prevs + o) = w; s = s * __expf(cd[n]) + v[n]; }
    }
}

struct LaneIds { int r, h, blk, q, pp; };
DI LaneIds lane_ids(int lane) { LaneIds L; L.r = lane & 31; L.h = lane >> 5; L.blk = (lane >> 4) & 1; L.q = (lane & 15) >> 2; L.pp = lane & 3; return L; }
DI int tr_nat_off(const LaneIds& L, int st) { return (8 * L.h + L.q) * st + 32 * L.blk + 8 * L.pp; }
DI int tr_krow_off(const LaneIds& L, int st) { return (4 * L.h + L.q) * st + 32 * L.blk + 8 * L.pp; }
DI bf16x8 pack_half(const f32x16& x, int s) { return pack8(x[8 * s], x[8 * s + 1], x[8 * s + 2], x[8 * s + 3], x[8 * s + 4], x[8 * s + 5], x[8 * s + 6], x[8 * s + 7]); }
DI float softplusf_(float x) { return x > 20.f ? x : log1pf(__expf(x)); }

DI void ssdst_unit(const Params& p0, const Ctx& c0, int layer, int u) {
    const Ctx c = fresh(c0); const Params p = freshp(p0);
    const int b = u >> 6, n = (u >> 2) & 15, g = (u >> 1) & 1, half = u & 1, T0 = b * SEQ + 128 * n;
    const bf16_t* mix = wsb(p, WS_MIX); bf16_t* xbcc = wsb(p, WS_XBCC); float* acsg = wsf(p, WS_ACS); float* bsg = wsf(p, WS_BS); float* stg = wsf(p, WS_ST);
    ldsp Xt = c.lds, Bt = c.lds + 73728; LAS float* sdec = (LAS float*)(c.lds + 73728 + 40960);
    const LaneIds L = lane_ids(c.lane);
    if (c.wave < 4) {
        const int hd = g * 8 + half * 4 + c.wave; const float dtb = p.ssd_dt_bias[layer * 16 + hd], A = -__expf(p.ssd_a_log[layer * 16 + hd]);
        const int l0 = 2 * c.lane;
        const float dt0 = softplusf_(bf2f(mix[(size_t)(T0 + l0) * NMIX + C_SDT + hd]) + dtb), dt1 = softplusf_(bf2f(mix[(size_t)(T0 + l0 + 1) * NMIX + C_SDT + hd]) + dtb);
        const float a0 = dt0 * A, a1 = dt1 * A; float s = a0 + a1;
#pragma unroll
        for (int o = 1; o < 64; o <<= 1) { const float t = shidx(s, c.lane - o); if (c.lane >= o) s += t; }
        const float c1 = s, c0 = s - a1, last = shidx(s, 63);
        acsg[(size_t)(T0 + l0) * 16 + hd] = c0; acsg[(size_t)(T0 + l0 + 1) * 16 + hd] = c1;
        bsg[(size_t)(T0 + l0) * 16 + hd] = -c0 + __logf(dt0); bsg[(size_t)(T0 + l0 + 1) * 16 + hd] = -c1 + __logf(dt1);
        sdec[c.wave * 128 + l0] = dt0 * __expf(last - c0); sdec[c.wave * 128 + l0 + 1] = dt1 * __expf(last - c1);
    }
    __syncthreads();
    const int NCH = half ? 64 : 48;
    const float* cw = p.ssd_conv_w + (size_t)layer * 4 * 1536; const float* cb = p.ssd_conv_b + (size_t)layer * 1536;
    {
        const int cc = c.lane, l0 = 16 * c.wave;
        if (cc < NCH) {
            int ch; if (cc < 32) ch = g * 512 + half * 256 + 8 * cc; else if (cc < 48) ch = 1024 + g * 128 + 8 * (cc - 32); else ch = 1280 + g * 128 + 8 * (cc - 48);
            const int mcol = C_SX + ch;
            u32x4 xr[19];
#pragma unroll
            for (int i = 0; i < 19; ++i) { const int tl = 128 * n + l0 - 3 + i; xr[i] = (tl >= 0) ? *(const u32x4*)(mix + (size_t)(b * SEQ + tl) * NMIX + mcol) : (u32x4){0u, 0u, 0u, 0u}; }
            float w[4][8], bs8[8];
#pragma unroll
            for (int j = 0; j < 4; ++j) { const f32x4 w0 = *(const f32x4*)(cw + j * 1536 + ch), w1 = *(const f32x4*)(cw + j * 1536 + ch + 4);
                w[j][0] = w0[0]; w[j][1] = w0[1]; w[j][2] = w0[2]; w[j][3] = w0[3]; w[j][4] = w1[0]; w[j][5] = w1[1]; w[j][6] = w1[2]; w[j][7] = w1[3]; }
            { const f32x4 b0 = *(const f32x4*)(cb + ch), b1 = *(const f32x4*)(cb + ch + 4); bs8[0] = b0[0]; bs8[1] = b0[1]; bs8[2] = b0[2]; bs8[3] = b0[3]; bs8[4] = b1[0]; bs8[5] = b1[1]; bs8[6] = b1[2]; bs8[7] = b1[3]; }
#pragma unroll
            for (int i = 0; i < 16; ++i) { const int l = l0 + i; float a[8];
#pragma unroll
                for (int e = 0; e < 8; ++e) a[e] = bs8[e];
#pragma unroll
                for (int j = 0; j < 4; ++j) { float xv[8]; unpack8(xr[i + j], xv);
#pragma unroll
                    for (int e = 0; e < 8; ++e) a[e] += w[j][e] * xv[e]; }
#pragma unroll
                for (int e = 0; e < 8; ++e) a[e] = siluf_(a[e]);
                const bf16x8 v = pack8(a[0], a[1], a[2], a[3], a[4], a[5], a[6], a[7]);
                if (cc < 32) { *(bf16x8*)(xbcc + (size_t)(T0 + l) * 1536 + ch) = v; const float sc = sdec[(cc >> 3) * 128 + l];
                    *(LAS bf16x8*)(Xt + l * 576 + cc * 16) = pack8(a[0] * sc, a[1] * sc, a[2] * sc, a[3] * sc, a[4] * sc, a[5] * sc, a[6] * sc, a[7] * sc); }
                else if (cc < 48) { if (half == 0) *(bf16x8*)(xbcc + (size_t)(T0 + l) * 1536 + ch) = v; *(LAS bf16x8*)(Bt + l * 320 + (cc - 32) * 16) = v; }
                else *(bf16x8*)(xbcc + (size_t)(T0 + l) * 1536 + ch) = v;
            }
        }
    }
    __syncthreads();
    {
        const int hq = c.wave & 3, kh = c.wave >> 2, hd = g * 8 + half * 4 + hq;
        f32x16 acc[2][2]; for (int i = 0; i < 2; ++i) for (int j = 0; j < 2; ++j) acc[i][j] = zero16();
        ldsp xa = Xt + tr_nat_off(L, 576) + hq * 128, ba = Bt + tr_nat_off(L, 320) + kh * 128;
#pragma unroll
        for (int ks = 0; ks < 8; ++ks) {
            bf16x8 A[2], Bf[2];
#pragma unroll
            for (int t = 0; t < 2; ++t) { A[t] = tr_pair(xa + ks * 16 * 576 + t * 64, 4 * 576); Bf[t] = tr_pair(ba + ks * 16 * 320 + t * 64, 4 * 320); }
#pragma unroll
            for (int pt = 0; pt < 2; ++pt)
#pragma unroll
                for (int kt = 0; kt < 2; ++kt) acc[pt][kt] = MFMA32(A[pt], Bf[kt], acc[pt][kt]);
        }
        float* o = stg + (size_t)((b * 16 + n) * 16 + hd) * 8192;
#pragma unroll
        for (int pt = 0; pt < 2; ++pt)
#pragma unroll
            for (int kt = 0; kt < 2; ++kt)
#pragma unroll
                for (int i = 0; i < 16; ++i) o[(32 * pt + crow(i, L.h)) * 128 + kh * 64 + 32 * kt + L.r] = acc[pt][kt][i];
    }
}
DI void ssdo_unit(const Params& p0, const Ctx& c0, int layer, int u) {
    const Ctx c = fresh(c0); const Params p = freshp(p0);
    const int b = u >> 6, n = (u >> 2) & 15, g = (u >> 1) & 1, half = u & 1, T0 = b * SEQ + 128 * n;
    const bf16_t* mix = wsb(p, WS_MIX); const bf16_t* xbcc = wsb(p, WS_XBCC); const float* acsg = wsf(p, WS_ACS); const float* bsg = wsf(p, WS_BS);
    const bf16_t* prevs = wsb(p, WS_PREVS); bf16_t* oall = wsb(p, WS_OALL); float* ssqh = wsf(p, WS_SSQH);
    ldsp XS = c.lds, BC = c.lds + 73728; LAS float* tacs = (LAS float*)(c.lds + 73728 + 34816); LAS float* tbs = tacs + 512;
    const LaneIds L = lane_ids(c.lane);
    const int hq = c.wave & 3, pr = c.wave >> 2, hd = g * 8 + half * 4 + hq;
    const bf16_t* prv = prevs + (size_t)((b * 16 + n) * 16 + hd) * 8192;
    u32x4 xs8[8], bc4[4];
#pragma unroll
    for (int i = 0; i < 8; ++i) { const int it = c.tid + 512 * i, l = it >> 5, cc = it & 31; xs8[i] = *(const u32x4*)(xbcc + (size_t)(T0 + l) * 1536 + g * 512 + half * 256 + 8 * cc); }
#pragma unroll
    for (int i = 0; i < 4; ++i) { const int it = c.tid + 512 * i, l = it >> 4, cc = it & 15; bc4[i] = *(const u32x4*)(xbcc + (size_t)(T0 + l) * 1536 + 1024 + g * 128 + 8 * cc); }
    const float ta = acsg[(size_t)(T0 + (c.tid & 127)) * 16 + g * 8 + half * 4 + (c.tid >> 7)], tb = bsg[(size_t)(T0 + (c.tid & 127)) * 16 + g * 8 + half * 4 + (c.tid >> 7)];
    bf16x8 Ap[2][8];
#pragma unroll
    for (int pt = 0; pt < 2; ++pt)
#pragma unroll
        for (int ks = 0; ks < 8; ++ks) Ap[pt][ks] = *(const bf16x8*)(prv + (32 * pt + L.r) * 128 + 16 * ks + 8 * L.h);
#pragma unroll
    for (int i = 0; i < 8; ++i) { const int it = c.tid + 512 * i, l = it >> 5, cc = it & 31; *(LAS u32x4*)(XS + l * 576 + cc * 16) = xs8[i]; }
#pragma unroll
    for (int i = 0; i < 4; ++i) { const int it = c.tid + 512 * i, l = it >> 4, cc = it & 15; *(LAS u32x4*)(BC + l * 272 + cc * 16) = bc4[i]; }
    tacs[c.tid] = ta; tbs[c.tid] = tb;
    __syncthreads();
    const float Dsk = p.ssd_d[layer * 16 + hd];
    const float* ng = p.ssd_norm_g + (size_t)layer * 1024 + g * 512 + half * 256 + hq * 64;
#pragma unroll
    for (int li = 0; li < 2; ++li) {
        const int lt = pr == 0 ? (li == 0 ? 0 : 3) : (li == 0 ? 1 : 2);
        const int l = 32 * lt + L.r; const size_t tok = (size_t)(T0 + l);
        bf16x8 Cf[8];
#pragma unroll
        for (int ks = 0; ks < 8; ++ks) Cf[ks] = *(const bf16x8*)(xbcc + tok * 1536 + 1280 + g * 128 + 16 * ks + 8 * L.h);
        u32x2 zw8[2][4];
#pragma unroll
        for (int pt = 0; pt < 2; ++pt)
#pragma unroll
            for (int gq = 0; gq < 4; ++gq) zw8[pt][gq] = *(const u32x2*)(mix + tok * NMIX + C_SZ + g * 512 + half * 256 + hq * 64 + 32 * pt + 8 * gq + 4 * L.h);
        f32x16 O[2]; O[0] = zero16(); O[1] = zero16();
#pragma unroll
        for (int pt = 0; pt < 2; ++pt)
#pragma unroll
            for (int ks = 0; ks < 8; ++ks) { O[pt] = MFMA32(Ap[pt][ks], Cf[ks], O[pt]); }

        const float acl = tacs[hq * 128 + l], eA = __expf(acl);
#pragma unroll
        for (int pt = 0; pt < 2; ++pt)
#pragma unroll
            for (int i = 0; i < 16; ++i) O[pt][i] *= eA;
#pragma unroll 1
        for (int st = 0; st <= lt; ++st) {
            f32x16 mt = zero16();
#pragma unroll
            for (int ks = 0; ks < 8; ++ks) { const bf16x8 A = *(const LAS bf16x8*)(BC + (32 * st + L.r) * 272 + (16 * ks + 8 * L.h) * 2); mt = MFMA32(A, Cf[ks], mt); }
#pragma unroll
            for (int gq = 0; gq < 4; ++gq) { const f32x4 bv = *(const LAS f32x4*)(tbs + hq * 128 + 32 * st + 8 * gq + 4 * L.h);
#pragma unroll
                for (int e = 0; e < 4; ++e) { const int s = 32 * st + 8 * gq + 4 * L.h + e; const float w = __expf(acl + bv[e]); mt[4 * gq + e] = (l >= s) ? mt[4 * gq + e] * w : 0.f; } }
            const bf16x8 pk0 = pack_half(mt, 0), pk1 = pack_half(mt, 1);
            ldsp xa = XS + tr_krow_off(L, 576) + (32 * st) * 576 + hq * 128;
#pragma unroll
            for (int pt = 0; pt < 2; ++pt) { O[pt] = MFMA32(tr_pair(xa + pt * 64, 8 * 576), pk0, O[pt]); O[pt] = MFMA32(tr_pair(xa + 16 * 576 + pt * 64, 8 * 576), pk1, O[pt]); }
        }
        float ssq = 0.f;
#pragma unroll
        for (int pt = 0; pt < 2; ++pt) { u32x2 w4[4];
#pragma unroll
            for (int gq = 0; gq < 4; ++gq) { const int pch = 32 * pt + 8 * gq + 4 * L.h;
                const u32x2 xw = *(const LAS u32x2*)(XS + l * 576 + (hq * 64 + pch) * 2);
                const u32x2 zw = zw8[pt][gq];
                const f32x4 gn = *(const f32x4*)(ng + pch);
                const float xv[4] = {bflo(xw.x), bfhi(xw.x), bflo(xw.y), bfhi(xw.y)}, zv[4] = {bflo(zw.x), bfhi(zw.x), bflo(zw.y), bfhi(zw.y)};
                float o[4];
#pragma unroll
                for (int e = 0; e < 4; ++e) { const float y = O[pt][4 * gq + e] + Dsk * xv[e]; const float gt = y * siluf_(zv[e]); ssq += gt * gt; o[e] = gt * gn[e]; }
                w4[gq].x = pk2(o[0], o[1]); w4[gq].y = pk2(o[2], o[3]); }
            bf16_t* rowp = oall + tok * KBR + O_SSD + g * 512 + half * 256 + hq * 64 + 32 * pt;
            store_pair_t21(rowp, 0, w4[0], w4[1], L.h); store_pair_t21(rowp, 2, w4[2], w4[3], L.h); }
        ssq += shx(ssq, 32, c.lane);
        if (L.h == 0) ssqh[tok * 16 + hd] = ssq;
    }
}

DI float ret_loggamma(int h) { return log1pf(-exp2f(-5.f - (float)h)); }
struct RetKV { u32x4 ka[2], kb[2], v[4]; };
DI void ret_load_kv(RetKV& r, const Ctx& c, const bf16_t* mix, int T0, int h) {
#pragma unroll
    for (int i = 0; i < 2; ++i) { const int it = c.tid + 512 * i, j = it >> 3, cc = it & 7; const bf16_t* row = mix + (size_t)(T0 + j) * NMIX + C_RK + h * 128;
        r.ka[i] = *(const u32x4*)(row + 8 * cc); r.kb[i] = *(const u32x4*)(row + 64 + 8 * cc); }
#pragma unroll
    for (int i = 0; i < 4; ++i) { const int it = c.tid + 512 * i, j = it >> 4, cc = it & 15; r.v[i] = *(const u32x4*)(mix + (size_t)(T0 + j) * NMIX + C_RV + h * 128 + 8 * cc); }
}
DI void ret_write_kv(const RetKV& r, const Ctx& c, int n, int h, ldsp Kt, int st, bool with_decay, ldsp Vt) {
    const float lg = ret_loggamma(h);
#pragma unroll
    for (int i = 0; i < 2; ++i) {
        const int it = c.tid + 512 * i, j = it >> 3, cc = it & 7; float x1[8], x2[8]; unpack8(r.ka[i], x1); unpack8(r.kb[i], x2);
        const float sc = 0.08838834764831845f * (with_decay ? __expf(lg * (float)(127 - j)) : 1.f), pos = (float)(128 * n + j);
        float o1[8], o2[8];
#pragma unroll
        for (int e = 0; e < 8; ++e) { const float inv = __builtin_amdgcn_exp2f(-(float)(8 * cc + e) * 0.20762050593046014f); const float ang = __fmul_rn(pos, inv); float rev = ang * 0.15915494309189535f; rev = __builtin_amdgcn_fractf(rev);
            const float sn = __builtin_amdgcn_sinf(rev), cs = __builtin_amdgcn_cosf(rev); o1[e] = (x1[e] * cs - x2[e] * sn) * sc; o2[e] = (x1[e] * sn + x2[e] * cs) * sc; }
        *(LAS bf16x8*)(Kt + j * st + cc * 16) = pack8(o1[0], o1[1], o1[2], o1[3], o1[4], o1[5], o1[6], o1[7]);
        *(LAS bf16x8*)(Kt + j * st + 128 + cc * 16) = pack8(o2[0], o2[1], o2[2], o2[3], o2[4], o2[5], o2[6], o2[7]);
    }
#pragma unroll
    for (int i = 0; i < 4; ++i) { const int it = c.tid + 512 * i, j = it >> 4, cc = it & 15; *(LAS u32x4*)(Vt + j * 320 + cc * 16) = r.v[i]; }
}
DI void retkv_unit(const Params& p0, const Ctx& c0, int u) {
    const Ctx c = fresh(c0); const Params p = freshp(p0);
    const int b = u >> 6, h = (u >> 4) & 3, n = u & 15, T0 = b * SEQ + 128 * n;
    const bf16_t* mix = wsb(p, WS_MIX); float* kvs = wsf(p, WS_KVS) + (size_t)u * 16384;
    ldsp Kt = c.lds, Vt = c.lds + 40960; const LaneIds L = lane_ids(c.lane);
    { RetKV r; ret_load_kv(r, c, mix, T0, h); ret_write_kv(r, c, n, h, Kt, 320, true, Vt); }
    __syncthreads();
    const int rt = c.wave >> 1, chh = c.wave & 1;
    f32x16 acc[2]; acc[0] = zero16(); acc[1] = zero16();
    ldsp va = Vt + tr_nat_off(L, 320) + rt * 64, ka = Kt + tr_nat_off(L, 320) + chh * 128;
#pragma unroll
    for (int ks = 0; ks < 8; ++ks) { const bf16x8 A = tr_pair(va + ks * 16 * 320, 4 * 320);
#pragma unroll
        for (int t = 0; t < 2; ++t) acc[t] = MFMA32(A, tr_pair(ka + ks * 16 * 320 + t * 64, 4 * 320), acc[t]); }
#pragma unroll
    for (int t = 0; t < 2; ++t)
#pragma unroll
        for (int i = 0; i < 16; ++i) kvs[(32 * rt + crow(i, L.h)) * 128 + chh * 64 + 32 * t + L.r] = acc[t][i];
}
DI void reto_unit(const Params& p0, const Ctx& c0, int u) {
    const Ctx c = fresh(c0); const Params p = freshp(p0);
    const int b = u >> 6, h = (u >> 4) & 3, n = u & 15, T0 = b * SEQ + 128 * n;
    const bf16_t* mix = wsb(p, WS_MIX); const bf16_t* prv = wsb(p, WS_PREVR) + (size_t)u * 16384; bf16_t* oall = wsb(p, WS_OALL);
    ldsp Kt = c.lds, Vt = c.lds + 34816; LAS float* exch = (LAS float*)(c.lds + 34816 + 40960); const LaneIds L = lane_ids(c.lane);
    const int qg = c.wave & 3, dvh = c.wave >> 2, il = 32 * qg + L.r; const size_t tok = (size_t)(T0 + il);
    const float lg = ret_loggamma(h);
    RetKV rkv; ret_load_kv(rkv, c, mix, T0, h);
    u32x4 qraw[8]; { const bf16_t* row = mix + tok * NMIX + C_RQ + h * 128;
#pragma unroll
      for (int s = 0; s < 4; ++s) { qraw[s] = *(const u32x4*)(row + 16 * s + 8 * L.h); qraw[s + 4] = *(const u32x4*)(row + 64 + 16 * s + 8 * L.h); } }
    bf16x8 Ap[2][8];
#pragma unroll
    for (int dl = 0; dl < 2; ++dl)
#pragma unroll
        for (int s = 0; s < 8; ++s) Ap[dl][s] = *(const bf16x8*)(prv + (32 * (2 * dvh + dl) + L.r) * 128 + 16 * s + 8 * L.h);
    u32x2 gwv[2][4];
#pragma unroll
    for (int dl = 0; dl < 2; ++dl)
#pragma unroll
        for (int gq = 0; gq < 4; ++gq) gwv[dl][gq] = *(const u32x2*)(mix + tok * NMIX + C_RG + h * 128 + 32 * (2 * dvh + dl) + 8 * gq + 4 * L.h);
    ret_write_kv(rkv, c, n, h, Kt, 272, false, Vt);
    bf16x8 Qf[8];
    { const float pos = (float)(128 * n + il);
#pragma unroll
      for (int s = 0; s < 4; ++s) { float x1[8], x2[8], o1[8], o2[8]; unpack8(qraw[s], x1); unpack8(qraw[s + 4], x2);
#pragma unroll
          for (int e = 0; e < 8; ++e) { const float inv = __builtin_amdgcn_exp2f(-(float)(16 * s + 8 * L.h + e) * 0.20762050593046014f); const float ang = __fmul_rn(pos, inv); float rev = ang * 0.15915494309189535f; rev = __builtin_amdgcn_fractf(rev);
              const float sn = __builtin_amdgcn_sinf(rev), cs = __builtin_amdgcn_cosf(rev); o1[e] = x1[e] * cs - x2[e] * sn; o2[e] = x1[e] * sn + x2[e] * cs; }
          Qf[s] = pack8(o1[0], o1[1], o1[2], o1[3], o1[4], o1[5], o1[6], o1[7]); Qf[s + 4] = pack8(o2[0], o2[1], o2[2], o2[3], o2[4], o2[5], o2[6], o2[7]); } }
    f32x16 O[2]; O[0] = zero16(); O[1] = zero16();
#pragma unroll
    for (int dl = 0; dl < 2; ++dl)
#pragma unroll
        for (int s = 0; s < 8; ++s) { O[dl] = MFMA32(Ap[dl][s], Qf[s], O[dl]); }

    { const float qd = __expf(lg * (float)(il + 1));
#pragma unroll
      for (int dl = 0; dl < 2; ++dl)
#pragma unroll
          for (int i = 0; i < 16; ++i) O[dl][i] *= qd; }
    __syncthreads();
#pragma unroll 1
    for (int rt = 0; rt <= qg; ++rt) {
        f32x16 st = zero16();
#pragma unroll
        for (int s = 0; s < 8; ++s) { const bf16x8 A = *(const LAS bf16x8*)(Kt + (32 * rt + L.r) * 272 + (16 * s + 8 * L.h) * 2); st = MFMA32(A, Qf[s], st); }
#pragma unroll
        for (int i = 0; i < 16; ++i) { const int j = 32 * rt + crow(i, L.h); st[i] = (il >= j) ? st[i] * __expf(lg * (float)(il - j)) : 0.f; }
        const bf16x8 pk0 = pack_half(st, 0), pk1 = pack_half(st, 1);
        ldsp va = Vt + tr_krow_off(L, 320) + (32 * rt) * 320 + dvh * 128;
#pragma unroll
        for (int dl = 0; dl < 2; ++dl) { O[dl] = MFMA32(tr_pair(va + dl * 64, 8 * 320), pk0, O[dl]); O[dl] = MFMA32(tr_pair(va + 16 * 320 + dl * 64, 8 * 320), pk1, O[dl]); }
    }
    float s1 = 0.f, s2 = 0.f;
#pragma unroll
    for (int dl = 0; dl < 2; ++dl)
#pragma unroll
        for (int i = 0; i < 16; ++i) { s1 += O[dl][i]; s2 += O[dl][i] * O[dl][i]; }
    s1 += shx(s1, 32, c.lane); s2 += shx(s2, 32, c.lane);
    if (L.h == 0) { exch[(dvh * 128 + il) * 2] = s1; exch[(dvh * 128 + il) * 2 + 1] = s2; }
    __syncthreads();
    const float t1 = exch[il * 2] + exch[(128 + il) * 2], t2 = exch[il * 2 + 1] + exch[(128 + il) * 2 + 1];
    const float mean = t1 * (1.f / 128.f), var = fmaxf(t2 * (1.f / 128.f) - mean * mean, 0.f), rstd = __builtin_amdgcn_rsqf(var + EPS);
#pragma unroll
    for (int dl = 0; dl < 2; ++dl) { u32x2 w4[4];
#pragma unroll
        for (int gq = 0; gq < 4; ++gq) { const u32x2 gw = gwv[dl][gq]; const float gv[4] = {bflo(gw.x), bfhi(gw.x), bflo(gw.y), bfhi(gw.y)}; float o[4];
#pragma unroll
            for (int e = 0; e < 4; ++e) o[e] = siluf_(gv[e]) * (O[dl][4 * gq + e] - mean) * rstd;
            w4[gq].x = pk2(o[0], o[1]); w4[gq].y = pk2(o[2], o[3]); }
        bf16_t* rowp = oall + tok * KBR + O_RET + h * 128 + 32 * (2 * dvh + dl);
        store_pair_t21(rowp, 0, w4[0], w4[1], L.h); store_pair_t21(rowp, 2, w4[2], w4[3], L.h); }
}

constexpr int KT_PITCH = 272, VT_PITCH = 320, KT_BYTES = 64 * KT_PITCH, VT_BYTES = 64 * VT_PITCH;
struct KvStage { u32x4 k[2], v[2]; };
DI void kv_load(KvStage& s, const bf16_t* kbase, int kp, const bf16_t* vbase, int vp, int row0, int tid) {
    const int key = tid >> 3, cp = tid & 7; const size_t rk = (size_t)(row0 + key) * kp, rv = (size_t)(row0 + key) * vp;
    s.k[0] = *(const u32x4*)(kbase + rk + 8 * cp); s.k[1] = *(const u32x4*)(kbase + rk + 64 + 8 * cp);
    s.v[0] = *(const u32x4*)(vbase + rv + 8 * cp); s.v[1] = *(const u32x4*)(vbase + rv + 64 + 8 * cp);
}
DI void kv_write(const KvStage& s, ldsp Kt, ldsp Vt, int tid) {
    const int key = tid >> 3, cp = tid & 7;
    *(LAS u32x4*)(Kt + key * KT_PITCH + cp * 16) = s.k[0]; *(LAS u32x4*)(Kt + key * KT_PITCH + 128 + cp * 16) = s.k[1];
    *(LAS u32x4*)(Vt + key * VT_PITCH + cp * 16) = s.v[0]; *(LAS u32x4*)(Vt + key * VT_PITCH + 128 + cp * 16) = s.v[1];
}
struct AttnState { f32x16 O[4]; float m, l; };
DI void attn_qk(f32x16 (&st)[2], ldsp Kt, const bf16x8 (&Qf)[8], const LaneIds& L) {
    st[0] = zero16(); st[1] = zero16();
#pragma unroll
    for (int rt = 0; rt < 2; ++rt)
#pragma unroll
        for (int s = 0; s < 8; ++s) st[rt] = MFMA32(*(const LAS bf16x8*)(Kt + (32 * rt + L.r) * KT_PITCH + (16 * s + 8 * L.h) * 2), Qf[s], st[rt]);
}
template <bool MASKW>
DI void attn_softmax_pv(AttnState& A, f32x16 (&st)[2], ldsp Vt, const LaneIds& L, unsigned mw0 = 0u, unsigned mw1 = 0u) {
    float mx = st[0][0];
#pragma unroll
    for (int rt = 0; rt < 2; ++rt)
#pragma unroll
        for (int i = 0; i < 16; ++i) mx = fmaxf(mx, st[rt][i]);
    mx = fmaxf(mx, shx(mx, 32, L.r + 32 * L.h));
    const float mn = fmaxf(A.m, mx);
    float rs = 0.f;
#pragma unroll
    for (int rt = 0; rt < 2; ++rt)
#pragma unroll
        for (int i = 0; i < 16; ++i) { float pv = __builtin_amdgcn_exp2f(st[rt][i] - mn);
            if (MASKW) { const int cr_ = (i & 3) + 8 * (i >> 2); pv = __uint_as_float(__float_as_uint(pv) & (unsigned)__builtin_amdgcn_sbfe((int)(rt ? mw1 : mw0), cr_, 1)); }
            st[rt][i] = pv; rs += pv; }
    rs += shx(rs, 32, L.r + 32 * L.h);
    if (__builtin_amdgcn_ballot_w64(mn > A.m) != 0ull) {
        const float alpha = __builtin_amdgcn_exp2f(A.m - mn);
        A.l *= alpha; A.m = mn;
#pragma unroll
        for (int dt = 0; dt < 4; ++dt)
#pragma unroll
            for (int i = 0; i < 16; ++i) A.O[dt][i] *= alpha;
    }
    A.l += rs;
    ldsp va = Vt + tr_krow_off(L, VT_PITCH);
#pragma unroll
    for (int rt = 0; rt < 2; ++rt)
#pragma unroll
        for (int s2 = 0; s2 < 2; ++s2) { const bf16x8 pk = pack_half(st[rt], s2);
#pragma unroll
            for (int dt = 0; dt < 4; ++dt) A.O[dt] = MFMA32(tr_pair(va + (32 * rt + 16 * s2) * VT_PITCH + dt * 64, 8 * VT_PITCH), pk, A.O[dt]); }
}
DI void attn_store(const AttnState& A, bf16_t* orow, const LaneIds& L) {
    const float inv = 1.f / A.l;
#pragma unroll
    for (int dt = 0; dt < 4; ++dt)
#pragma unroll
        for (int gq = 0; gq < 4; gq += 2) { u32x2 a, b;
            a.x = pk2(A.O[dt][4 * gq] * inv, A.O[dt][4 * gq + 1] * inv); a.y = pk2(A.O[dt][4 * gq + 2] * inv, A.O[dt][4 * gq + 3] * inv);
            b.x = pk2(A.O[dt][4 * gq + 4] * inv, A.O[dt][4 * gq + 5] * inv); b.y = pk2(A.O[dt][4 * gq + 6] * inv, A.O[dt][4 * gq + 7] * inv);
            store_pair_t21(orow, 4 * dt + gq, a, b, L.h); }
}
DI void attn_load_q(bf16x8 (&Qf)[8], const bf16_t* qrow, const float* g, float pre, float scale, const LaneIds& L) {
    float x[8][8]; float ss = 0.f;
#pragma unroll
    for (int s = 0; s < 8; ++s) { unpack8(*(const u32x4*)(qrow + 16 * s + 8 * L.h), x[s]);
#pragma unroll
        for (int e = 0; e < 8; ++e) { x[s][e] *= pre; ss += x[s][e] * x[s][e]; } }
    ss += shx(ss, 32, L.r + 32 * L.h);
    const float f = scale * __builtin_amdgcn_rsqf(ss * (1.f / 128.f) + EPS);
#pragma unroll
    for (int s = 0; s < 8; ++s) { const f32x4 g0 = *(const f32x4*)(g + 16 * s + 8 * L.h), g1 = *(const f32x4*)(g + 16 * s + 8 * L.h + 4);
        Qf[s] = pack8(x[s][0] * f * g0[0], x[s][1] * f * g0[1], x[s][2] * f * g0[2], x[s][3] * f * g0[3], x[s][4] * f * g1[0], x[s][5] * f * g1[1], x[s][6] * f * g1[2], x[s][7] * f * g1[3]); }
}

DI void fox_unit(const Params& p0, const Ctx& c0, int layer, int u) {
    const Ctx c = fresh(c0); const Params p = freshp(p0);
    const int qb = 7 - (u >> 4), bh = u & 15, b = bh >> 2, hd = bh & 3, t0 = 256 * qb;
    const bf16_t* mix = wsb(p, WS_MIX); bf16_t* oall = wsb(p, WS_OALL);
    LAS float* Fs = (LAS float*)c.lds; LAS float* wtot = Fs + 2048; ldsp KV = c.lds + 8192 + 64;
    const LaneIds L = lane_ids(c.lane);
    {
        const float fb = p.fox_f_b[layer * 4 + hd]; float v[4];
#pragma unroll
        for (int e = 0; e < 4; ++e) { const float x = bf2f(mix[(size_t)(b * SEQ + 4 * c.tid + e) * NMIX + C_FF + hd]) + fb; v[e] = (fminf(x, 0.f) - log1pf(__expf(-fabsf(x)))) * LOG2E; }
        v[1] += v[0]; v[2] += v[1]; v[3] += v[2];
        float s = v[3];
#pragma unroll
        for (int o = 1; o < 64; o <<= 1) { const float t = shidx(s, c.lane - o); if (c.lane >= o) s += t; }
        if (c.lane == 63) wtot[c.wave] = s;
        __syncthreads();
        float base = s - v[3];
        for (int w = 0; w < c.wave; ++w) base += wtot[w];
        *(LAS f32x4*)(Fs + 4 * c.tid) = (f32x4){base + v[0], base + v[1], base + v[2], base + v[3]};
    }
    const int tq = t0 + 32 * c.wave + L.r;
    bf16x8 Qf[8];
    attn_load_q(Qf, mix + (size_t)(b * SEQ + tq) * NMIX + C_FQ + hd * 128, p.fox_qn_g + layer * 128, 1.f, 0.08838834764831845f * LOG2E, L);
    AttnState A; for (int i = 0; i < 4; ++i) A.O[i] = zero16(); A.m = -1e30f; A.l = 0.f;
    const bf16_t* kbase = wsb(p, WS_FOXKN) + hd * 128; const bf16_t* vbase = mix + C_FV + hd * 128;
    const int nt = (t0 + 256) / 64;
    KvStage sg; kv_load(sg, kbase, 512, vbase, NMIX, b * SEQ, c.tid); kv_write(sg, KV, KV + KT_BYTES, c.tid);
    __syncthreads();
#pragma unroll 1
    for (int j = 0; j < nt; ++j) {
        const int kb = 64 * j; ldsp Kt = KV + (j & 1) * (KT_BYTES + VT_BYTES), Vt = Kt + KT_BYTES;
        if (j + 1 < nt) kv_load(sg, kbase, 512, vbase, NMIX, b * SEQ + kb + 64, c.tid);
        if (kb <= t0 + 32 * c.wave + 31) {
            f32x16 st[2]; attn_qk(st, Kt, Qf, L);
            const bool diag = kb + 63 > t0 + 32 * c.wave;
#pragma unroll
            for (int rt = 0; rt < 2; ++rt)
#pragma unroll
                for (int gq = 0; gq < 4; ++gq) { const f32x4 fv = *(const LAS f32x4*)(Fs + kb + 32 * rt + 8 * gq + 4 * L.h);
#pragma unroll
                    for (int e = 0; e < 4; ++e) { float sv = st[rt][4 * gq + e] - fv[e]; if (diag && (kb + 32 * rt + 8 * gq + 4 * L.h + e > tq)) sv = -__builtin_inff(); st[rt][4 * gq + e] = sv; } }
            attn_softmax_pv<false>(A, st, Vt, L);
        }
        if (j + 1 < nt) { ldsp Kn = KV + ((j + 1) & 1) * (KT_BYTES + VT_BYTES); kv_write(sg, Kn, Kn + KT_BYTES, c.tid); }
        __syncthreads();
    }
    attn_store(A, oall + (size_t)(b * SEQ + tq) * KBR + O_FOX + hd * 128, L);
}

DI void idx_unit(const Params& p0, const Ctx& c0, int u) {
    const Ctx c = fresh(c0); const Params p = freshp(p0);
    const int qb = 63 - (u >> 2), b = u & 3, t0 = 32 * qb;
    const bf16_t* mix = wsb(p, WS_MIX); const bf16_t* qup = wsb(p, WS_QUP); float* scores = wsf(p, WS_SCORES);
    ldsp KI = c.lds; const LaneIds L = lane_ids(c.lane);
    bf16x8 Af[2][4]; float Wr[2][16];
#pragma unroll
    for (int pp = 0; pp < 2; ++pp) {
        const int tqa = t0 + 4 * c.wave + 2 * pp + ((L.r >> 2) & 1), head = 4 * (L.r >> 3) + (L.r & 3);
#pragma unroll
        for (int s = 0; s < 4; ++s) Af[pp][s] = *(const bf16x8*)(qup + (size_t)(b * SEQ + tqa) * NUP + 512 + head * 64 + 16 * s + 8 * L.h);
        const bf16_t* wrow = mix + (size_t)(b * SEQ + t0 + 4 * c.wave + 2 * pp + L.h) * NMIX + C_IW; float w0[8], w1[8]; unpack8(*(const u32x4*)wrow, w0); unpack8(*(const u32x4*)(wrow + 8), w1);
#pragma unroll
        for (int i = 0; i < 8; ++i) { Wr[pp][i] = w0[i]; Wr[pp][8 + i] = w1[i]; }
    }
    const int nsup = (t0 + 31) / 256 + 1;
    u32x4 sg[4];
#pragma unroll
    for (int i = 0; i < 4; ++i) { const int it = c.tid + 512 * i; sg[i] = *(const u32x4*)(mix + (size_t)(b * SEQ + (it >> 3)) * NMIX + C_IK + 8 * (it & 7)); }
#pragma unroll
    for (int i = 0; i < 4; ++i) { const int it = c.tid + 512 * i; *(LAS u32x4*)(KI + (it >> 3) * 144 + (it & 7) * 16) = sg[i]; }
    __syncthreads();
#pragma unroll 1
    for (int js = 0; js < nsup; ++js) {
        ldsp Kc = KI + (js & 1) * 36864;
        if (js + 1 < nsup) {
#pragma unroll
            for (int i = 0; i < 4; ++i) { const int it = c.tid + 512 * i; sg[i] = *(const u32x4*)(mix + (size_t)(b * SEQ + 256 * (js + 1) + (it >> 3)) * NMIX + C_IK + 8 * (it & 7)); } }
#pragma unroll 1
        for (int kt = 0; kt < 8; ++kt) {
            const int kb = 256 * js + 32 * kt; if (kb > t0 + 31) break;
            bf16x8 Bf[4];
#pragma unroll
            for (int s = 0; s < 4; ++s) Bf[s] = *(const LAS bf16x8*)(Kc + (32 * kt + L.r) * 144 + (16 * s + 8 * L.h) * 2);
#pragma unroll
            for (int pp = 0; pp < 2; ++pp) { f32x16 acc = zero16();
#pragma unroll
                for (int s = 0; s < 4; ++s) acc = MFMA32(Af[pp][s], Bf[s], acc);
                float sc = 0.f;
#pragma unroll
                for (int i = 0; i < 16; ++i) sc += Wr[pp][i] * fmaxf(acc[i], 0.f);
                scores[(size_t)(b * SEQ + t0 + 4 * c.wave + 2 * pp + L.h) * SEQ + kb + L.r] = sc; }
        }
        if (js + 1 < nsup) { ldsp Kn = KI + ((js + 1) & 1) * 36864;
#pragma unroll
            for (int i = 0; i < 4; ++i) { const int it = c.tid + 512 * i; *(LAS u32x4*)(Kn + (it >> 3) * 144 + (it & 7) * 16) = sg[i]; } }
        __syncthreads();
    }
}

template <int NJ>
DI void sel_load(const float* row, int lane, unsigned (&raw)[NJ]) {
#pragma unroll
    for (int j = 0; j < NJ; ++j) raw[j] = __float_as_uint(row[64 * j + lane]);
}
template <int NJ>
DI void sel_select(const unsigned (&raw)[NJ], unsigned* mrow, int t, int lane) {
    unsigned x[NJ];
#pragma unroll
    for (int j = 0; j < NJ; ++j) { const int key = 64 * j + lane; const unsigned bits = raw[j];
        const unsigned uu = (bits & 0x80000000u) ? ~bits : (bits | 0x80000000u); x[j] = (key <= t) ? uu : 0u; }
    unsigned T = 1u; bool exact = (t + 1 <= 256);
    if (!exact) {
#define SEL_COUNT(dst, thr) do { int _c = 0; _Pragma("unroll") for (int j = 0; j < NJ; ++j) _c += __popcll(__ballot(x[j] >= (thr))); dst = _c; } while (0)
        const float ex = 16384.f / (float)(t + 1), mg = 3.f * sqrtf(ex) + 2.f; const int k_hi0 = (int)floorf(ex - mg), k_hi = k_hi0 < 1 ? 1 : k_hi0, k_lo = (int)ceilf(ex + mg);
        unsigned lo = 1u, hi = 0xffffffffu;
        if (k_lo <= 64) { unsigned v = 0u;
#pragma unroll 1
            for (int bit = 31; bit >= 0; --bit) { const unsigned cand = v | (1u << bit); if (__popcll(__ballot(x[0] >= cand)) >= k_lo) v = cand; }
            int cc; SEL_COUNT(cc, v); if (cc >= 256) { lo = v; if (cc == 256) { T = v; exact = true; } } else hi = v; }
        if (!exact) { unsigned v = 0u;
#pragma unroll 1
            for (int bit = 31; bit >= 0; --bit) { const unsigned cand = v | (1u << bit); if (__popcll(__ballot(x[0] >= cand)) >= k_hi) v = cand; }
            int cc; SEL_COUNT(cc, v);
            if (cc == 256) { T = v; exact = true; } else if (cc < 256) { if (v < hi) hi = v; } else if (v > lo) lo = v; }
        if (!exact) {
#pragma unroll 1
            while (hi - lo > 1u) { const unsigned mid = lo + ((hi - lo) >> 1); int cc; SEL_COUNT(cc, mid);
                if (cc == 256) { T = mid; exact = true; break; }
                if (cc > 256) lo = mid; else hi = mid; }
            if (!exact) T = lo;
        }
#undef SEL_COUNT
    }
    if (exact) {
#pragma unroll
        for (int j = 0; j < NJ; ++j) { const unsigned long long bal = __ballot(x[j] >= T); if (lane == 0) { mrow[2 * j] = (unsigned)bal; mrow[2 * j + 1] = (unsigned)(bal >> 32); } }
    } else {
        int gt = 0;
#pragma unroll
        for (int j = 0; j < NJ; ++j) gt += __popcll(__ballot(x[j] > T));
        int need = 256 - gt, run = 0;
#pragma unroll
        for (int j = 0; j < NJ; ++j) { const bool eq = x[j] == T; const unsigned long long be = __ballot(eq); const int below = __popcll(be & ((1ull << lane) - 1ull));
            const bool sel = (x[j] > T) || (eq && (run + below < need)); run += __popcll(be);
            const unsigned long long bal = __ballot(sel); if (lane == 0) { mrow[2 * j] = (unsigned)bal; mrow[2 * j + 1] = (unsigned)(bal >> 32); } }
    }
    if (lane < 2 * (32 - NJ)) mrow[2 * NJ + lane] = 0u;
}
DI void sel_unit(const Params& p0, const Ctx& c0, int u) {
    const Ctx c = fresh(c0); const Params p = freshp(p0);
    const int qb = 127 - (u >> 2), b = u & 3, t0 = 16 * qb;
    const float* scores = wsf(p, WS_SCORES); unsigned* msk = (unsigned*)(p.ws + WS_MSK);
    const int grp = (t0 + 15) >> 9;
    const int ta = t0 + 2 * c.wave, tb = ta + 1; const float* rowa = scores + (size_t)(b * SEQ + ta) * SEQ; const float* rowb = rowa + SEQ;
    unsigned* mra = msk + (size_t)(b * SEQ + ta) * 64; unsigned* mrb = mra + 64;
#define SEL_PAIR(NJ_) do { unsigned ra_[NJ_], rb_[NJ_]; sel_load<NJ_>(rowa, c.lane, ra_); sel_load<NJ_>(rowb, c.lane, rb_); sel_select<NJ_>(ra_, mra, ta, c.lane); sel_select<NJ_>(rb_, mrb, tb, c.lane); } while (0)
    if (grp == 0) SEL_PAIR(8); else if (grp == 1) SEL_PAIR(16); else if (grp == 2) SEL_PAIR(24); else SEL_PAIR(32);
#undef SEL_PAIR
}
DI void knorm_unit(const Params& p0, const Ctx& c0, int layer, int u) {
    const Ctx c = fresh(c0); const Params p = freshp(p0);
    const bf16_t* mix = wsb(p, WS_MIX); bf16_t* fk = wsb(p, WS_FOXKN); bf16_t* dk = wsb(p, WS_DSAKN);
    const int ch = c.tid & 15, tok = 32 * u + (c.tid >> 4);
    u32x4 raw[5];
#pragma unroll
    for (int hh = 0; hh < 5; ++hh) raw[hh] = *(const u32x4*)(mix + (size_t)tok * NMIX + (hh < 4 ? C_FK + hh * 128 : C_DK) + 8 * ch);
    const f32x4 f0 = *(const f32x4*)(p.fox_kn_g + layer * 128 + 8 * ch), f1 = *(const f32x4*)(p.fox_kn_g + layer * 128 + 8 * ch + 4);
    const f32x4 d0 = *(const f32x4*)(p.dsa_kn_g + layer * 128 + 8 * ch), d1 = *(const f32x4*)(p.dsa_kn_g + layer * 128 + 8 * ch + 4);
#pragma unroll
    for (int hh = 0; hh < 5; ++hh) {
        float a[8]; unpack8(raw[hh], a); float ss = 0.f;
#pragma unroll
        for (int e = 0; e < 8; ++e) ss += a[e] * a[e];
        ss += shx(ss, 1, c.lane); ss += shx(ss, 2, c.lane); ss += shx(ss, 4, c.lane); ss += shx(ss, 8, c.lane);
        const float rstd = __builtin_amdgcn_rsqf(ss * (1.f / 128.f) + EPS); const f32x4 g0 = hh < 4 ? f0 : d0, g1 = hh < 4 ? f1 : d1;
        const bf16x8 o = pack8(a[0] * rstd * g0[0], a[1] * rstd * g0[1], a[2] * rstd * g0[2], a[3] * rstd * g0[3], a[4] * rstd * g1[0], a[5] * rstd * g1[1], a[6] * rstd * g1[2], a[7] * rstd * g1[3]);
        if (hh < 4) *(bf16x8*)(fk + (size_t)tok * 512 + hh * 128 + 8 * ch) = o; else *(bf16x8*)(dk + (size_t)tok * 128 + 8 * ch) = o; }
}
DI void dsa_unit(const Params& p0, const Ctx& c0, int layer, int u) {
    const Ctx c = fresh(c0); const Params p = freshp(p0);
    const int qb = 31 - (u >> 2), b = u & 3, t0 = 64 * qb;
    const bf16_t* mix = wsb(p, WS_MIX); const bf16_t* qup = wsb(p, WS_QUP); bf16_t* oall = wsb(p, WS_OALL); const unsigned* msk = (const unsigned*)(p.ws + WS_MSK);
    LAS unsigned* Msk = (LAS unsigned*)c.lds; LAS float* Bl = (LAS float*)(c.lds + 16640); ldsp KV = c.lds + 16640 + 2048;
    const LaneIds L = lane_ids(c.lane);
    const int hd = c.wave >> 1, qg = c.wave & 1, ql = 32 * qg + L.r, tq = t0 + ql; const size_t tok = (size_t)(b * SEQ + tq);
    const float b31 = p.rel_bias[31 * 4 + hd] * LOG2E;
    if (c.tid < 128) {
        const int d = c.tid; int bk = d;
        if (d >= 16) { bk = 16 + (int)(__logf((float)d * (1.f / 16.f)) * (16.f / 2.0794415416798357f)); bk = bk > 31 ? 31 : bk; }
#pragma unroll
        for (int hh = 0; hh < 4; ++hh) Bl[d * 4 + hh] = (p.rel_bias[bk * 4 + hh] - p.rel_bias[31 * 4 + hh]) * LOG2E;
    }
#pragma unroll
    for (int i = 0; i < 8; ++i) { const int it = c.tid + 512 * i, q = it >> 6, w = it & 63; Msk[q * 65 + w] = msk[(size_t)(b * SEQ + t0 + q) * 64 + w]; }
    (void)b31;
    float rc;
    { float ss = 0.f; const bf16_t* cr = mix + tok * NMIX + C_DCQ + 256 * L.h;
#pragma unroll 4
      for (int i = 0; i < 32; ++i) { float f[8]; unpack8(*(const u32x4*)(cr + 8 * i), f);
#pragma unroll
          for (int e = 0; e < 8; ++e) ss += f[e] * f[e]; }
      ss += shx(ss, 32, L.r + 32 * L.h); rc = __builtin_amdgcn_rsqf(ss * (1.f / 512.f) + EPS); }
    bf16x8 Qf[8];
    attn_load_q(Qf, qup + tok * NUP + hd * 128, p.dsa_qn_g + layer * 128, rc, 0.08838834764831845f * LOG2E, L);
    AttnState A; for (int i = 0; i < 4; ++i) A.O[i] = zero16(); A.m = -1e30f; A.l = 0.f;
    const bf16_t* kbase = wsb(p, WS_DSAKN); const bf16_t* vbase = mix + C_DV;
    const int nt = qb + 1;
    KvStage sg; kv_load(sg, kbase, 128, vbase, NMIX, b * SEQ, c.tid); kv_write(sg, KV, KV + KT_BYTES, c.tid);
    __syncthreads();
#pragma unroll 1
    for (int j = 0; j < nt; ++j) {
        const int kb = 64 * j; ldsp Kt = KV + (j & 1) * (KT_BYTES + VT_BYTES), Vt = Kt + KT_BYTES;
        if (j + 1 < nt) kv_load(sg, kbase, 128, vbase, NMIX, b * SEQ + kb + 64, c.tid);
        {
            f32x16 st[2]; attn_qk(st, Kt, Qf, L);
            const unsigned mw0 = Msk[ql * 65 + 2 * j] >> (4 * L.h), mw1 = Msk[ql * 65 + 2 * j + 1] >> (4 * L.h);
            if (kb + 63 + 128 > t0 + 32 * qg) {
#pragma unroll
                for (int rt = 0; rt < 2; ++rt)
#pragma unroll
                    for (int i = 0; i < 16; ++i) { const int cr_ = (i & 3) + 8 * (i >> 2); const int d = tq - (kb + 32 * rt + cr_ + 4 * L.h);
                        if (d < 128) st[rt][i] += Bl[(d < 0 ? 0 : d) * 4 + hd]; }
            }
            attn_softmax_pv<true>(A, st, Vt, L, mw0, mw1);
        }
        if (j + 1 < nt) { ldsp Kn = KV + ((j + 1) & 1) * (KT_BYTES + VT_BYTES); kv_write(sg, Kn, Kn + KT_BYTES, c.tid); }
        __syncthreads();
    }
    attn_store(A, oall + tok * KBR + O_DSA + hd * 128, L);
}

constexpr int NPH = 9, NPHASES = 1 + DEPTH * NPH;
enum { Q_IDX = 0, Q_SSDST = 1, Q_RETKV = 2, Q_FOX = 3, Q_DSA = 4, Q_SSDO = 5, Q_RETO = 6, Q_SEL = 7 };
#ifndef LB2
#define LB2 2
#endif
__global__ void __launch_bounds__(512, LB2) fwd(Params pk) {
    extern __shared__ __attribute__((aligned(16))) unsigned char lds_raw[];
    Ctx c; c.lds = (ldsp)lds_raw; c.tid = threadIdx.x; c.lane = c.tid & 63; c.wave = __builtin_amdgcn_readfirstlane(c.tid >> 6); c.G = gridDim.x; c.bid = blockIdx.x;
    c.ctl = (gu32*)(pk.ws + WS_CTL);
    if (c.tid < 64) ((LAS unsigned*)(c.lds + LDS_MISC))[c.tid] = 0u;
    __syncthreads();
#if MK_PER_PHASE
#define GRID_BAR() do { } while (0)
#else
    XcdBarrier bar = xcd_barrier_post((unsigned*)(c.ctl + CW_BAR), (volatile LAS unsigned*)(c.lds + LDS_MISC) + 8);
#define GRID_BAR() xcd_barrier(bar)
#endif
    const int lo = pk.ph_lo, hi = pk.ph_hi, rep = pk.rep;
#define IN(k) (lo <= (k) && (k) < hi)
#define SEAM(k) do { if (IN((k) + 1)) GRID_BAR(); } while (0)
#define PHASE(k, ...) if (PH_ON((k) + 1) && IN(pb + (k))) { const Params p = loadp(); unsigned char* wl = p.ws + WS_W + (size_t)l * WL_SIZE; (void)wl; __VA_ARGS__ SEAM(pb + (k)); }
    if (PH_ON(0) && IN(0)) { const Params p = loadp(); p0_prologue(p, c); xprep_phase(c, p.x, wsb(p, WS_HN), wsf(p, WS_SSP)); SEAM(0); }
#pragma unroll 1
    for (int l = 0; l < DEPTH; ++l) {
        const int pb = 1 + l * NPH;
        PHASE(0, {
            pg8::Gemm g{wsb(p, WS_HN), (const bf16_t*)(wl + WL_IN), MTOK, NIN, DM, DM, DM}; pg8::StaticOrder S; S.init(MTOK, NIN, c.G, c.bid);
            pg8::EpiIn E{wsb(p, WS_MIX), wsb(p, WS_GATES), p.gate_b + (size_t)l * NGATE, wsf(p, WS_SSP)};
            pg8::gemm_phase(c.lds, g, S, E);
            convert_on_idle(p, c, l, I_IN, PER_LAYER, (MTOK / 256) * (NIN / 256)); })
        PHASE(1, {
            pg8::Gemm g{wsb(p, WS_MIX) + C_DCQ, (const bf16_t*)(wl + WL_UP), MTOK, NUP, KUP, NMIX, KUP}; pg8::StaticOrder S; S.init(MTOK, NUP, c.G, c.bid);
            pg8::EpiBf16<0> E{wsb(p, WS_QUP), NUP, nullptr};
            pg8::gemm_phase(c.lds, g, S, E);
            if (l + 1 < DEPTH) convert_on_idle(p, c, l + 1, 0, CV_B, (MTOK / 256) * (NUP / 256)); })
        PHASE(2, {
            if (rep == 0 || ((REP_UM >> Q_IDX) & 1)) for (int u; (u = next_unit(c, l, Q_IDX + 8 * rep)) < 256;) idx_unit(p, c, u);
            if (rep == 0 || ((REP_UM >> Q_SSDST) & 1)) for (int u; (u = next_unit(c, l, Q_SSDST + 8 * rep)) < 256;) ssdst_unit(p, c, l, u);
            if (rep == 0 || ((REP_UM >> Q_RETKV) & 1)) for (int u; (u = next_unit(c, l, Q_RETKV + 8 * rep)) < 256;) retkv_unit(p, c, u);
            for (int u = c.bid; u < 256; u += c.G) { knorm_unit(p, c, l, u); } })
        PHASE(3, {
            for (int u; (u = next_unit(c, l, Q_SEL + 8 * rep)) < 512;) sel_unit(p, c, u);
            scan_phase(p, c); })
        PHASE(4, {
            if (rep == 0 || ((REP_UM >> Q_DSA) & 1)) for (int u; (u = next_unit(c, l, Q_DSA + 8 * rep)) < 128;) dsa_unit(p, c, l, u);
            if (rep == 0 || ((REP_UM >> Q_FOX) & 1)) for (int u; (u = next_unit(c, l, Q_FOX + 8 * rep)) < 128;) fox_unit(p, c, l, u);
            if (rep == 0 || ((REP_UM >> Q_SSDO) & 1)) for (int u; (u = next_unit(c, l, Q_SSDO + 8 * rep)) < 256;) ssdo_unit(p, c, l, u);
            if (rep == 0 || ((REP_UM >> Q_RETO) & 1)) for (int u; (u = next_unit(c, l, Q_RETO + 8 * rep)) < 256;) reto_unit(p, c, u);
            if (l + 1 < DEPTH) { __syncthreads(); convert_items(p, c, l + 1, CV_B, I_IN, c.bid * 8 + c.wave, c.G * 8); } })
        PHASE(5, {
            pg8::Gemm g{wsb(p, WS_OALL), (const bf16_t*)(wl + WL_BR), MTOK, DM, KBR, KBR, KBR}; pg8::StaticOrder S; S.init(MTOK, DM, c.G, c.bid);
            pg8::EpiMerge E{wsb(p, WS_MERGED), wsb(p, WS_GATES), wsf(p, WS_SSQH), wsb(p, WS_ONES)};
            pg8::gemm_phase(c.lds, g, S, E); })
        PHASE(6, {
            pg8::Gemm g{wsb(p, WS_MERGED), (const bf16_t*)(wl + WL_OUT), MTOK, DM, DM, DM, DM}; pg8::StaticOrder S; S.init(MTOK, DM, c.G, c.bid);
            pg8::EpiResid<1, 0> E{wsb(p, WS_HN), nullptr, wsb(p, WS_XRES), wsf(p, WS_SSP), DM};
            pg8::gemm_phase(c.lds, g, S, E); })
        PHASE(7, {
            pg8::Gemm g{wsb(p, WS_XRES), (const bf16_t*)(wl + WL_FF1), MTOK, DFF, DM, DM, DM}; pg8::StaticOrder S; S.init(MTOK, DFF, c.G, c.bid);
            pg8::EpiBf16<1> E{wsb(p, WS_FFH), DFF, wsf(p, WS_SSP)};
            pg8::gemm_phase(c.lds, g, S, E); })
        if (l < DEPTH - 1) {
            PHASE(8, {
                pg8::Gemm g{wsb(p, WS_FFH), (const bf16_t*)(wl + WL_FF2), MTOK, DM, DFF, DFF, DFF}; pg8::StaticOrder S; S.init(MTOK, DM, c.G, c.bid);
                pg8::EpiResid<1, 0> E{wsb(p, WS_XRES), nullptr, wsb(p, WS_HN), wsf(p, WS_SSP), DM};
                pg8::gemm_phase(c.lds, g, S, E); })
        } else {
            PHASE(8, {
                pg8::Gemm g{wsb(p, WS_FFH), (const bf16_t*)(wl + WL_FF2), MTOK, DM, DFF, DFF, DFF}; pg8::StaticOrder S; S.init(MTOK, DM, c.G, c.bid);
                pg8::EpiResid<1, 1> E{wsb(p, WS_XRES), p.out, nullptr, nullptr, DM};
                pg8::gemm_phase(c.lds, g, S, E); })
        }
    }
#undef PHASE
#undef IN
#undef SEAM
}

extern "C" void kernel_launch(void* const* d_in, const int* in_sizes, int n_in, void* d_out, int out_size, void* d_ws, size_t ws_size, hipStream_t stream) {
    static int grid = 0;
    if (grid == 0) {
        if (n_in != 24 || in_sizes[0] != MTOK * DM || out_size != MTOK * DM || ws_size < WS_END) {
            fprintf(stderr, "kernel_launch: unexpected problem (n_in %d, in0 %d, out %d, ws %zu < %zu?); nothing launched\n", n_in, n_in > 0 ? in_sizes[0] : -1, out_size, ws_size, (size_t)WS_END); grid = -1; return; }
        int dev = 0, cus = 0;
        if (hipGetDevice(&dev) != hipSuccess || hipDeviceGetAttribute(&cus, hipDeviceAttributeMultiprocessorCount, dev) != hipSuccess) { grid = -1; return; }
        if (hipFuncSetAttribute((const void*)fwd, hipFuncAttributeMaxDynamicSharedMemorySize, LDS_BYTES) != hipSuccess) { fprintf(stderr, "kernel_launch: hipFuncSetAttribute failed\n"); grid = -1; return; }
        int per_cu = 0;
        if (hipOccupancyMaxActiveBlocksPerMultiprocessor(&per_cu, (const void*)fwd, 512, LDS_BYTES) != hipSuccess || per_cu < 1) { fprintf(stderr, "kernel_launch: occupancy query says %d blocks per CU\n", per_cu); }
        (void)hipGetLastError();
        grid = cus;
    }
    if (grid < 0) return;
    (void)hipMemsetAsync((char*)d_ws + WS_CTL, 0, CTL_ZERO_BYTES, stream);
    Params p{};
    const float** pin = (const float**)&p;
    for (int i = 0; i < 24; ++i) pin[i] = (const float*)d_in[i];
    p.out = (float*)d_out; p.ws = (unsigned char*)d_ws;
#if MK_PER_PHASE
    for (int ph = 0; ph < NPHASES; ++ph) { p.ph_lo = ph; p.ph_hi = ph + 1; p.rep = 0; hipLaunchKernelGGL(fwd, dim3(grid), dim3(512), LDS_BYTES, stream, p);
        if ((ph >= 1 && (ph - 1) % NPH == REPEAT_PH) || (ph == 0 && REPEAT_PH == 100)) { p.rep = 1; hipLaunchKernelGGL(fwd, dim3(grid), dim3(512), LDS_BYTES, stream, p); } }
#else
    p.ph_lo = 0; p.ph_hi = NPHASES; hipLaunchKernelGGL(fwd, dim3(grid), dim3(512), LDS_BYTES, stream, p);
#endif
    const hipError_t le = hipPeekAtLastError();
    if (le != hipSuccess) fprintf(stderr, "kernel_launch: launch failed: %s\n", hipGetErrorName(le));
}
```

```cpp
#include <hip/hip_runtime.h>
#include <cstdio>
#include <cstdint>

#ifndef MK_PER_PHASE
#define MK_PER_PHASE 0
#endif
#ifndef REPEAT_PH
#define REPEAT_PH -1
#endif
#ifndef REP_UM
#define REP_UM 0xFF
#endif
#ifndef PHMASK
#define PHMASK 0xFFFFu
#endif
#define PH_ON(k) ((PHMASK >> (k)) & 1u)
#ifndef UM
#define UM 0xFF
#endif

#define DI __device__ __forceinline__
#define LAS __attribute__((address_space(3)))
#define GAS __attribute__((address_space(1)))
typedef unsigned short bf16_t;
typedef short bf16x8 __attribute__((ext_vector_type(8)));
typedef short s16x4 __attribute__((ext_vector_type(4)));
typedef float f32x2 __attribute__((ext_vector_type(2)));
typedef float f32x4 __attribute__((ext_vector_type(4)));
typedef float f32x16 __attribute__((ext_vector_type(16)));
typedef unsigned u32x2 __attribute__((ext_vector_type(2)));
typedef unsigned u32x4 __attribute__((ext_vector_type(4)));
typedef __bf16 bf16x2_t __attribute__((ext_vector_type(2)));
typedef GAS unsigned gu32;
typedef LAS unsigned char* ldsp;

constexpr int NB = 4, SEQ = 2048, DM = 2048, DEPTH = 4, MTOK = NB * SEQ;
constexpr int DFF = 8192, IN_TOTAL = 15204;
constexpr int NMIX = 7168, NGATE = 8192, NIN = NMIX + NGATE;
constexpr int NUP = 1536, KUP = 512, KBR = 2560;
constexpr float EPS = 1e-6f;
constexpr float LOG2E = 1.4426950408889634f;
constexpr int C_RQ = 0, C_RK = 512, C_RV = 1024, C_RG = 1536, C_FQ = 2048, C_FK = 2560, C_FV = 3072, C_DCQ = 3584, C_DK = 4096, C_DV = 4224,
              C_IK = 4352, C_SZ = 4416, C_SX = 5440, C_SB = 6464, C_SC = 6720, C_IW = 6976, C_SDT = 6992, C_FF = 7008, C_MIXEND = 7012;
constexpr int O_RET = 0, O_FOX = 512, O_DSA = 1024, O_SSD = 1536;

constexpr size_t MiB = 1u << 20;
constexpr size_t WS_CTL = 0, CTL_ZERO_BYTES = 1 * MiB;
constexpr size_t WL_IN = 0, WL_UP = WL_IN + (size_t)NIN * DM * 2, WL_BR = WL_UP + (size_t)NUP * KUP * 2, WL_OUT = WL_BR + (size_t)DM * KBR * 2,
                 WL_FF1 = WL_OUT + (size_t)DM * DM * 2, WL_FF2 = WL_FF1 + (size_t)DFF * DM * 2, WL_SIZE = WL_FF2 + (size_t)DM * DFF * 2;
constexpr size_t WS_W = 2 * MiB;
constexpr size_t WS_ACT = ((WS_W + DEPTH * WL_SIZE + MiB - 1) / MiB) * MiB;
constexpr size_t WS_XRES = WS_ACT, WS_X1 = WS_XRES + 64 * MiB, WS_HN = WS_X1 + 64 * MiB, WS_MIX = WS_HN + 32 * MiB, WS_GATES = WS_MIX + 112 * MiB,
                 WS_QUP = WS_GATES + 128 * MiB, WS_OALL = WS_QUP + 24 * MiB, WS_MERGED = WS_OALL + 40 * MiB, WS_FFH = WS_MERGED + 32 * MiB,
                 WS_SCORES = WS_FFH + 128 * MiB, WS_KVS = WS_SCORES + 64 * MiB, WS_PREVR = WS_KVS + 16 * MiB, WS_ST = WS_PREVR + 8 * MiB,
                 WS_PREVS = WS_ST + 32 * MiB, WS_XBCC = WS_PREVS + 16 * MiB, WS_ACS = WS_XBCC + 24 * MiB, WS_BS = WS_ACS + 1 * MiB, WS_SSQH = WS_BS + 1 * MiB, WS_SSP = WS_SSQH + 1 * MiB, WS_FOXKN = WS_SSP + 1 * MiB, WS_DSAKN = WS_FOXKN + 8 * MiB, WS_MSK = WS_DSAKN + 2 * MiB,
                 WS_ONES = WS_MSK + 2 * MiB, WS_END = WS_ONES + 1 * MiB;
constexpr int CW_BAR = 4096;
constexpr int CW_QUEUE = 16384;
constexpr int NQUEUE = 16;

constexpr int LDS_BYTES = 147456;
constexpr int LDS_WORK = 143360;
constexpr int LDS_MISC = LDS_WORK;

DI float bf2f(unsigned short b) { return __uint_as_float(((unsigned)b) << 16); }
DI float bflo(unsigned u) { return __uint_as_float(u << 16); }
DI float bfhi(unsigned u) { return __uint_as_float(u & 0xffff0000u); }
DI unsigned pk2(float lo, float hi) { f32x2 v = {lo, hi}; bf16x2_t b = __builtin_convertvector(v, bf16x2_t); return __builtin_bit_cast(unsigned, b); }
DI unsigned short f2bf(float f) { return (unsigned short)(pk2(f, 0.f) & 0xffffu); }
DI bf16x8 pack8(float a0, float a1, float a2, float a3, float a4, float a5, float a6, float a7) {
    u32x4 p; p.x = pk2(a0, a1); p.y = pk2(a2, a3); p.z = pk2(a4, a5); p.w = pk2(a6, a7); return __builtin_bit_cast(bf16x8, p); }
DI void unpack8(const u32x4 v, float (&f)[8]) { f[0] = bflo(v.x); f[1] = bfhi(v.x); f[2] = bflo(v.y); f[3] = bfhi(v.y); f[4] = bflo(v.z); f[5] = bfhi(v.z); f[6] = bflo(v.w); f[7] = bfhi(v.w); }
DI float sigmoidf_(float x) { return __builtin_amdgcn_rcpf(1.f + __builtin_amdgcn_exp2f(-LOG2E * x)); }
DI float siluf_(float x) { return x * __builtin_amdgcn_rcpf(1.f + __builtin_amdgcn_exp2f(-LOG2E * x)); }
#define MFMA32(a, b, c) __builtin_amdgcn_mfma_f32_32x32x16_bf16((a), (b), (c), 0, 0, 0)
DI int crow(int i, int h) { return (i & 3) + 8 * (i >> 2) + 4 * h; }
DI s16x4 trrd(ldsp p) { return __builtin_bit_cast(s16x4, __builtin_amdgcn_ds_read_tr16_b64_v4i16((LAS s16x4*)p)); }
DI bf16x8 tr_pair(ldsp p, int off2) { s16x4 lo = trrd(p), hi = trrd(p + off2); return __builtin_shufflevector(lo, hi, 0, 1, 2, 3, 4, 5, 6, 7); }
DI float shidx(float v, int src) { return __int_as_float(__builtin_amdgcn_ds_bpermute(src << 2, __float_as_int(v))); }
DI float shx(float v, int m, int lane) { return shidx(v, lane ^ m); }
DI void store_pair_t21(bf16_t* rowp, int k, u32x2 a, u32x2 b, int h) {
    const auto rx = __builtin_amdgcn_permlane32_swap(a.x, b.x, false, false), ry = __builtin_amdgcn_permlane32_swap(a.y, b.y, false, false);
    u32x4 w; w.x = rx[0]; w.y = ry[0]; w.z = rx[1]; w.w = ry[1];
    *(u32x4*)(rowp + 8 * k + (h ? 8 : 0)) = w;
}
DI f32x16 zero16() { f32x16 z; for (int i = 0; i < 16; ++i) z[i] = 0.f; return z; }

#define XB_TMO      128
#define XB_XCNT(j)  (256  + 64 * (j))
#define XB_XSUB(j)  (1280 + 64 * (j))
#define XB_XGEN(j)  (2304 + 64 * (j))
#define XB_TOP      3328
#define XB_TOPGEN   3392
#define XCD_BAR_WORDS 3456
#define XB_SPIN_CAP (1u << 18)
DI unsigned xb_ld(unsigned* p)              { return __hip_atomic_load(p, __ATOMIC_RELAXED, __HIP_MEMORY_SCOPE_AGENT); }
DI unsigned xb_add(unsigned* p, unsigned v) { return __hip_atomic_fetch_add(p, v, __ATOMIC_RELAXED, __HIP_MEMORY_SCOPE_AGENT); }
DI unsigned xb_xcc_id() { return (unsigned)__builtin_amdgcn_s_getreg((3 << 11) | 20) & 0xFu; }
#define XB_SPIN(cond, bar) do { unsigned _sp = 0; while (cond) { __builtin_amdgcn_s_sleep(1); \
    if ((++_sp & 255u) == 0u) { if (xb_ld(&(bar)[XB_TMO])) break; if (_sp > XB_SPIN_CAP) { atomicAdd(&(bar)[XB_TMO], 1u); break; } } } } while (0)
struct XcdBarrier { unsigned* bar; unsigned x; volatile LAS unsigned* st; };
DI XcdBarrier xcd_barrier_post(unsigned* bar, volatile LAS unsigned* st) {
    XcdBarrier b; b.bar = bar; b.x = xb_xcc_id(); b.st = st;
    if (threadIdx.x == 0) (void)xb_add(&bar[XB_XCNT(b.x)], 1u);
    return b;
}
DI void xcd_barrier_complete(unsigned* bar, unsigned x, unsigned& nloc, unsigned& nx) {
    const unsigned G = gridDim.x * gridDim.y * gridDim.z;
    unsigned sum, cnt, mine, sp = 0u;
    for (;;) {
        sum = 0u; cnt = 0u; mine = 0u;
#pragma unroll
        for (unsigned j = 0; j < 16; ++j) { const unsigned c = xb_ld(&bar[XB_XCNT(j)]); sum += c; cnt += (c > 0u) ? 1u : 0u; mine = (j == x) ? c : mine; }
        if (sum == G) break;
        __builtin_amdgcn_s_sleep(1);
        if ((++sp & 255u) == 0u) { if (xb_ld(&bar[XB_TMO])) break; if (sp > XB_SPIN_CAP) { atomicAdd(&bar[XB_TMO], 1u); break; } }
    }
    nloc = mine > 0u ? mine : 1u; nx = cnt > 0u ? cnt : 1u;
}
DI void xcd_barrier(const XcdBarrier& b) {
    asm volatile("s_waitcnt vmcnt(0)" ::: "memory");
    __syncthreads();
    if (threadIdx.x == 0) {
        unsigned* bar = b.bar; { GAS unsigned* w = (GAS unsigned*)bar; asm volatile("" : "+s"(w)); bar = (unsigned*)w; }
        __builtin_amdgcn_s_waitcnt(0);
        unsigned nloc = b.st[0], nx = b.st[1];
        if (nloc == 0u) { xcd_barrier_complete(bar, b.x, nloc, nx); b.st[0] = nloc; b.st[1] = nx; }
        const unsigned old = xb_add(&bar[XB_XSUB(b.x)], 1u);
        const unsigned gen = old / nloc;
        if (old + 1u == (gen + 1u) * nloc) {
            __builtin_amdgcn_fence(__ATOMIC_RELEASE, "agent");
            asm volatile("s_waitcnt vmcnt(0)" ::: "memory");
            const unsigned og = xb_add(&bar[XB_TOP], 1u);
            const unsigned tg = og / nx;
            if (og + 1u == (tg + 1u) * nx) xb_add(&bar[XB_TOPGEN], 1u);
            else XB_SPIN(xb_ld(&bar[XB_TOPGEN]) == tg, bar);
            __builtin_amdgcn_fence(__ATOMIC_ACQUIRE, "agent");
            xb_add(&bar[XB_XGEN(b.x)], 1u);
            asm volatile("s_waitcnt vmcnt(0)" ::: "memory");
        } else {
            XB_SPIN(xb_ld(&bar[XB_XGEN(b.x)]) == gen, bar);
            __builtin_amdgcn_fence(__ATOMIC_ACQUIRE, "agent");
            asm volatile("s_waitcnt vmcnt(0)" ::: "memory");
        }
    }
    __syncthreads();
}

namespace pg8 {
constexpr int BM = 256, BK = 64, HALF = 128, HTB = HALF * BK * 2, STAGE_BYTES = 8 * HTB, NXCD = 8, WGM = 8;
__host__ __device__ __forceinline__ int lds_byte(int r, int c) { const int st = (r >> 4) * 2 + (c >> 5), rr = r & 15, cc = c & 31, ob = rr * 64 + cc * 2; return st * 1024 + (ob ^ (((ob >> 9) & 1) << 5)); }
__host__ __device__ __forceinline__ void stage_rc(int b, int& R, int& C) { const int st = b / 1024, sb = b % 1024, swz = sb ^ (((sb >> 9) & 1) << 5); R = (st >> 1) * 16 + swz / 64; C = (st & 1) * 32 + (swz % 64) / 2; }
__host__ __device__ __forceinline__ int perm32(int rho) { const int n = rho >> 4, i = rho & 15; return 8 * (i >> 2) + 4 * n + (i & 3); }
struct Unit { int pm, pn; };
struct Gemm { const bf16_t* A; const bf16_t* Bt; int M, N, K, lda, ldb; };
struct StaticOrder {
    int nM, nN, nwg, G, c;
    __host__ __device__ void init(int M, int N, int G_, int c_) { nM = M / BM; nN = N / BM; nwg = nM * nN; G = G_; c = c_; }
    __host__ __device__ bool next(int i, Unit& u) const {
        const long L = (long)i * G + c; if (L >= nwg) return false;
        int wgid = (int)L; { const int q = nwg / NXCD, r = nwg % NXCD, xcd = wgid % NXCD, off = wgid / NXCD; wgid = (xcd < r ? xcd * (q + 1) : r * (q + 1) + (xcd - r) * q) + off; }
        const int nig = WGM * nN, gid = wgid / nig, fm = gid * WGM, gsz = (nM - fm) < WGM ? (nM - fm) : WGM;
        u.pm = fm + ((wgid % nig) % gsz); u.pn = (wgid % nig) / gsz; return true;
    }
};
typedef f32x4 Acc[2][2][4][2];

template <class Epi>
DI void gemm_phase(ldsp lds, const Gemm g, const StaticOrder& S, const Epi& E) {
    int tid = threadIdx.x; asm volatile("" : "+v"(tid));
    const int wid = __builtin_amdgcn_readfirstlane(tid >> 6), lane = tid & 63, wr = wid >> 2, wc = wid & 3, fr = lane & 15, fq = lane >> 4;
    const int K = g.K, nt = K / BK;
    unsigned voffA[2], voffB[2];
#pragma unroll
    for (int i = 0; i < 2; ++i) { int R, C; stage_rc(tid * 16 + i * 8192, R, C); const int Rb = Epi::PERM ? ((R & ~31) + perm32(R & 31)) : R;
        voffA[i] = (unsigned)(R * g.lda + C) * 2u; voffB[i] = (unsigned)(Rb * g.ldb + C) * 2u; }
    const size_t kstep = (size_t)(BK * 2);
    const size_t hstepA = (size_t)HALF * g.lda * 2, hstepB = (size_t)HALF * g.ldb * 2;
    const size_t tstepA = 2 * hstepA, tstepB = 2 * hstepB;
    const unsigned ldsw = (unsigned)wid * 1024u;
    const int aoff = lds_byte(wr * 64 + fr, fq * 8), boff = lds_byte(wc * 32 + fr, fq * 8);
#define PG8_SA(b, h) (((b) * 2 + (h)) * HTB)
#define PG8_SB(b, h) ((4 + (b) * 2 + (h)) * HTB)
#define PG8_STAGE(bufoff, gbase, voff) do { _Pragma("unroll") for (int _i = 0; _i < 2; ++_i) \
        __builtin_amdgcn_global_load_lds((const unsigned*)((const char*)(gbase) + (voff)[_i]), (LAS unsigned*)(lds + (bufoff) + ldsw + _i * 8192), 16, 0, 0); } while (0)
#define PG8_LDA(dst, b, h) do { _Pragma("unroll") for (int m = 0; m < 4; ++m) _Pragma("unroll") for (int k = 0; k < 2; ++k) dst[m][k] = *(const LAS bf16x8*)(lds + PG8_SA(b, h) + aoff + m * 2048 + k * 1024); } while (0)
#define PG8_LDB(dst, b, h) do { _Pragma("unroll") for (int n = 0; n < 2; ++n) _Pragma("unroll") for (int k = 0; k < 2; ++k) dst[n][k] = *(const LAS bf16x8*)(lds + PG8_SB(b, h) + boff + n * 2048 + k * 1024); } while (0)
#define PG8_MMA(ai, bj, At, Bt) do { __builtin_amdgcn_s_setprio(1); _Pragma("unroll") for (int m = 0; m < 4; ++m) _Pragma("unroll") for (int n = 0; n < 2; ++n) _Pragma("unroll") for (int k = 0; k < 2; ++k) \
        acc[ai][bj][m][n] = __builtin_amdgcn_mfma_f32_16x16x32_bf16(Bt[n][k], At[m][k], acc[ai][bj][m][n], 0, 0, 0); __builtin_amdgcn_s_setprio(0); } while (0)
#define PG8_WAIT_V(n) asm volatile("s_waitcnt vmcnt(" #n ")" ::: "memory")
#define PG8_WAIT_L(n) asm volatile("s_waitcnt lgkmcnt(" #n ")" ::: "memory")
#define PG8_BAR __builtin_amdgcn_s_barrier()
#define PG8_SCHED __builtin_amdgcn_sched_barrier(0)
    Unit cur, nxt; int ui = 0;
    if (!S.next(0, cur)) return;
    if constexpr (Epi::HAS_MID) { E.prep(lds, cur, tid); __syncthreads(); }
    Acc acc;
#pragma unroll
    for (int a = 0; a < 2; ++a)
#pragma unroll
        for (int b = 0; b < 2; ++b)
#pragma unroll
            for (int m = 0; m < 4; ++m)
#pragma unroll
                for (int n = 0; n < 2; ++n) acc[a][b][m][n] = (f32x4){0.f, 0.f, 0.f, 0.f};
    bf16x8 At[4][2], B0[2][2], B1[2][2];
    f32x4 rsA = {0.f, 0.f, 0.f, 0.f}, rsB = rsA;
    const char* cA = (const char*)g.A + (size_t)cur.pm * tstepA; const char* cB = (const char*)g.Bt + (size_t)cur.pn * tstepB;
    PG8_STAGE(PG8_SB(0, 0), cB, voffB); PG8_STAGE(PG8_SB(0, 1), cB + hstepB, voffB); PG8_STAGE(PG8_SA(0, 0), cA, voffA); PG8_STAGE(PG8_SA(0, 1), cA + hstepA, voffA);
    if (wr == 1) PG8_BAR;
    PG8_WAIT_V(2); PG8_BAR;
    PG8_STAGE(PG8_SB(1, 0), cB + kstep, voffB); PG8_STAGE(PG8_SA(1, 0), cA + kstep, voffA); PG8_STAGE(PG8_SB(1, 1), cB + hstepB + kstep, voffB);
    PG8_WAIT_V(6); PG8_BAR;
    for (;;) {
        const bool has_next = S.next(ui + 1, nxt);
        const char* nA = has_next ? (const char*)g.A + (size_t)nxt.pm * tstepA : cA; const char* nB = has_next ? (const char*)g.Bt + (size_t)nxt.pn * tstepB : cB;
        for (int t = 0; t < nt; t += 2) {
            const bool last = (t == nt - 2);
            const char* a1 = cA + (size_t)(t + 1) * kstep;
            const char* a2 = last ? nA : cA + (size_t)(t + 2) * kstep; const char* b2 = last ? nB : cB + (size_t)(t + 2) * kstep;
            const char* a3 = a2 + kstep; const char* b3 = b2 + kstep;
            if constexpr (Epi::HAS_MID) { if (E.is_mid(t)) { E.mid(acc, cur, t, wr, wc, fr, fq, lds); PG8_SCHED; } }
            if constexpr (Epi::ROWSCALE) { if (last && tid < 256) { const f32x4* sp = (const f32x4*)(E.ssp + (size_t)(cur.pm * BM + tid) * 8); rsA = sp[0]; rsB = sp[1]; } }
            PG8_LDB(B0, 0, 0); PG8_LDB(B1, 0, 1); PG8_SCHED; PG8_LDA(At, 0, 0); PG8_STAGE(PG8_SA(1, 1), a1 + hstepA, voffA);
            PG8_WAIT_V(8); PG8_WAIT_L(0); PG8_BAR; PG8_MMA(0, 0, At, B0); PG8_MMA(0, 1, At, B1); PG8_BAR; PG8_SCHED;
            PG8_LDA(At, 0, 1); PG8_STAGE(PG8_SB(0, 0), b2, voffB); PG8_STAGE(PG8_SB(0, 1), b2 + hstepB, voffB); PG8_STAGE(PG8_SA(0, 0), a2, voffA);
            PG8_WAIT_V(8); PG8_WAIT_L(0); PG8_BAR; PG8_MMA(1, 0, At, B0); PG8_MMA(1, 1, At, B1); PG8_BAR; PG8_SCHED;
            PG8_LDB(B0, 1, 0); PG8_LDB(B1, 1, 1); PG8_SCHED; PG8_LDA(At, 1, 0); PG8_STAGE(PG8_SA(0, 1), a2 + hstepA, voffA);
            PG8_WAIT_V(8); PG8_WAIT_L(0); PG8_BAR; PG8_MMA(0, 0, At, B0); PG8_MMA(0, 1, At, B1); PG8_BAR; PG8_SCHED;
            PG8_LDA(At, 1, 1); PG8_STAGE(PG8_SB(1, 0), b3, voffB); PG8_STAGE(PG8_SB(1, 1), b3 + hstepB, voffB); PG8_STAGE(PG8_SA(1, 0), a3, voffA);
            PG8_WAIT_V(8); PG8_WAIT_L(0); PG8_BAR; PG8_MMA(1, 0, At, B0); PG8_MMA(1, 1, At, B1); PG8_BAR; PG8_SCHED;
        }
        if (wr == 0) PG8_BAR;
        if constexpr (Epi::ROWSCALE) {
            LAS float* tab = (LAS float*)(lds + STAGE_BYTES);
            if (tid < 256) { const float t = ((rsA[0] + rsA[1]) + (rsA[2] + rsA[3])) + ((rsB[0] + rsB[1]) + (rsB[2] + rsB[3])); tab[tid] = __builtin_amdgcn_rsqf(t * (1.f / (float)DM) + EPS); }
            PG8_WAIT_L(0); PG8_BAR; asm volatile("" ::: "memory");
        }
        E(acc, cur, wr, wc, fr, fq, lds);
        if (!has_next) break;
#pragma unroll
        for (int a = 0; a < 2; ++a)
#pragma unroll
            for (int b = 0; b < 2; ++b)
#pragma unroll
                for (int m = 0; m < 4; ++m)
#pragma unroll
                    for (int n = 0; n < 2; ++n) acc[a][b][m][n] = (f32x4){0.f, 0.f, 0.f, 0.f};
        cur = nxt; cA = nA; cB = nB; ++ui;
        if constexpr (Epi::HAS_MID) { PG8_BAR; E.prep(lds, cur, tid); PG8_WAIT_L(0); PG8_BAR; }
        if (wr == 1) PG8_BAR;
    }
    PG8_WAIT_V(0);
    PG8_BAR;
#undef PG8_SA
#undef PG8_SB
#undef PG8_STAGE
#undef PG8_LDA
#undef PG8_LDB
#undef PG8_MMA
#undef PG8_WAIT_V
#undef PG8_WAIT_L
#undef PG8_BAR
#undef PG8_SCHED
}

DI void store8(bf16_t* p, const f32x4 v0, const f32x4 v1) { u32x4 w; w.x = pk2(v0[0], v0[1]); w.y = pk2(v0[2], v0[3]); w.z = pk2(v1[0], v1[1]); w.w = pk2(v1[2], v1[3]); *(u32x4*)p = w; }
struct EpiIn {
    static constexpr bool PERM = true, HAS_MID = false, ROWSCALE = true;
    bf16_t* mix; bf16_t* gates; const float* gate_b; const float* ssp;
    DI void operator()(const Acc& acc, const Unit& u, int wr, int wc, int fr, int fq, ldsp lds) const {
        const int row0 = u.pm * BM + wr * 64 + fr; const LAS float* tab = (const LAS float*)(lds + STAGE_BYTES);
        if (u.pn < NMIX / BM) {
            const int col0 = u.pn * BM + wc * 32 + 8 * fq;
#pragma unroll
            for (int ai = 0; ai < 2; ++ai)
#pragma unroll
                for (int m = 0; m < 4; ++m) { const float rs = tab[wr * 64 + fr + ai * HALF + m * 16]; bf16_t* rowp = mix + (size_t)(row0 + ai * HALF + m * 16) * NMIX + col0;
#pragma unroll
                    for (int bj = 0; bj < 2; ++bj) store8(rowp + bj * HALF, acc[ai][bj][m][0] * rs, acc[ai][bj][m][1] * rs); }
        } else {
            const int ch8 = (u.pn - NMIX / BM) * 64 + wc * 16 + 8 * (fq & 1), ch0 = ch8 + 4 * (fq >> 1), h = fq >> 1;
            f32x4 bv[4];
#pragma unroll
            for (int i = 0; i < 4; ++i) bv[i] = *(const f32x4*)(gate_b + i * DM + ch0);
#pragma unroll
            for (int ai = 0; ai < 2; ++ai)
#pragma unroll
                for (int m = 0; m < 4; ++m) { const float rs = tab[wr * 64 + fr + ai * HALF + m * 16]; bf16_t* rowp = gates + (size_t)(row0 + ai * HALF + m * 16) * NGATE + ch8;
                    f32x4 d[4], e[4];
#pragma unroll
                    for (int i = 0; i < 4; ++i) { const f32x4 x = acc[ai][i >> 1][m][i & 1] * rs + bv[i];
#pragma unroll
                        for (int j = 0; j < 4; ++j) { d[i][j] = fminf(1.f + __builtin_amdgcn_exp2f(-LOG2E * x[j]), 1e20f); e[i][j] = __builtin_amdgcn_rcpf(d[i][j]); } }
#pragma unroll
                    for (int k = 0; k < 4; k += 2) { const f32x4 ra = e[k] * d[k + 1], rb = (k + 1 < 3) ? e[k + 1] * d[k + 1 < 3 ? k + 2 : 3] : e[3];
                        const auto rx = __builtin_amdgcn_permlane32_swap(pk2(ra[0], ra[1]), pk2(rb[0], rb[1]), false, false), ry = __builtin_amdgcn_permlane32_swap(pk2(ra[2], ra[3]), pk2(rb[2], rb[3]), false, false);
                        u32x4 w; w.x = rx[0]; w.y = ry[0]; w.z = rx[1]; w.w = ry[1];
                        *(u32x4*)(rowp + (k + h) * DM) = w; } }
        }
    }
};
template <int ACT  > struct EpiBf16 {
    static constexpr bool PERM = true, HAS_MID = false, ROWSCALE = (ACT == 1);
    bf16_t* O; int ldc; const float* ssp;
    DI void operator()(const Acc& acc, const Unit& u, int wr, int wc, int fr, int fq, ldsp lds) const {
        const int row0 = u.pm * BM + wr * 64 + fr, col0 = u.pn * BM + wc * 32 + 8 * fq; const LAS float* tab = (const LAS float*)(lds + STAGE_BYTES);
#pragma unroll
        for (int ai = 0; ai < 2; ++ai)
#pragma unroll
            for (int m = 0; m < 4; ++m) { bf16_t* rowp = O + (size_t)(row0 + ai * HALF + m * 16) * ldc + col0;
                float rs2 = 1.f; if (ACT == 1) { const float rs = tab[wr * 64 + fr + ai * HALF + m * 16]; rs2 = rs * rs; }
#pragma unroll
                for (int bj = 0; bj < 2; ++bj) { f32x4 v0 = acc[ai][bj][m][0], v1 = acc[ai][bj][m][1];
                    if (ACT == 1) {
#pragma unroll
                        for (int j = 0; j < 4; ++j) { const float a = fmaxf(v0[j], 0.f), b = fmaxf(v1[j], 0.f); v0[j] = a * a * rs2; v1[j] = b * b * rs2; } }
                    store8(rowp + bj * HALF, v0, v1); } }
    }
};
template <int RES, int OUTF> struct EpiResid {
    static constexpr bool PERM = true, HAS_MID = false, ROWSCALE = false;
    const void* resid; float* out; bf16_t* xb; float* ssp; int ldc;
    DI void operator()(const Acc& acc, const Unit& u, int wr, int wc, int fr, int fq, ldsp lds) const {
        const int row0 = u.pm * BM + wr * 64 + fr, col0 = u.pn * BM + wc * 32 + 8 * fq;
#pragma unroll
        for (int ai = 0; ai < 2; ++ai) {
            f32x4 rf[RES == 0 ? 4 : 1][2][2]; u32x4 rw[RES == 1 ? 4 : 1][2];
#pragma unroll
            for (int m = 0; m < 4; ++m) { const size_t off = (size_t)(row0 + ai * HALF + m * 16) * ldc + col0;
#pragma unroll
                for (int bj = 0; bj < 2; ++bj) {
                    if (RES == 0) { rf[RES == 0 ? m : 0][bj][0] = *(const f32x4*)((const float*)resid + off + bj * HALF); rf[RES == 0 ? m : 0][bj][1] = *(const f32x4*)((const float*)resid + off + bj * HALF + 4); }
                    else rw[RES == 1 ? m : 0][bj] = *(const u32x4*)((const bf16_t*)resid + off + bj * HALF); } }
#pragma unroll
            for (int m = 0; m < 4; ++m) { const int row = row0 + ai * HALF + m * 16; const size_t off = (size_t)row * ldc + col0; float ss = 0.f;
#pragma unroll
                for (int bj = 0; bj < 2; ++bj) { f32x4 r0, r1;
                    if (RES == 0) { r0 = rf[RES == 0 ? m : 0][bj][0]; r1 = rf[RES == 0 ? m : 0][bj][1]; }
                    else { float f[8]; unpack8(rw[RES == 1 ? m : 0][bj], f); r0 = (f32x4){f[0], f[1], f[2], f[3]}; r1 = (f32x4){f[4], f[5], f[6], f[7]}; }
                    const f32x4 o0 = r0 + acc[ai][bj][m][0], o1 = r1 + acc[ai][bj][m][1];
                    if (OUTF) { *(f32x4*)(out + off + bj * HALF) = o0; *(f32x4*)(out + off + bj * HALF + 4) = o1; }
                    else { ss += ((o0[0] * o0[0] + o0[1] * o0[1]) + (o0[2] * o0[2] + o0[3] * o0[3])) + ((o1[0] * o1[0] + o1[1] * o1[1]) + (o1[2] * o1[2] + o1[3] * o1[3])); store8(xb + off + bj * HALF, o0, o1); } }
                if (!OUTF) { ss += shx(ss, 16, fr + 16 * fq); ss += shx(ss, 32, fr + 16 * fq); if (fq == 0) ((LAS float*)(lds + STAGE_BYTES))[(wr * 64 + fr + ai * HALF + m * 16) * 4 + wc] = ss; } } }
        if (!OUTF) {
            asm volatile("s_waitcnt lgkmcnt(0)" ::: "memory"); __builtin_amdgcn_s_barrier(); asm volatile("" ::: "memory");
            const int t = 64 * (4 * wr + wc) + fr + 16 * fq;
            if (t < 256) { const f32x4 q = *(const LAS f32x4*)(lds + STAGE_BYTES + t * 16); ssp[(size_t)(u.pm * BM + t) * 8 + u.pn] = (q[0] + q[1]) + (q[2] + q[3]); }
        }
    }
};
struct EpiMerge {
    static constexpr bool PERM = true, HAS_MID = true, ROWSCALE = false;
    bf16_t* O; const bf16_t* gates; const float* ssqh; const bf16_t* ones;
    DI bool is_mid(int t) const { return t == 8 || t == 16 || t == 24 || t == 32; }
    DI void prep(ldsp lds, const Unit& u, int tid) const {
        if (tid < 256) { const f32x4* p = (const f32x4*)(ssqh + (size_t)(u.pm * BM + tid) * 16); const f32x4 a = p[0], b = p[1], c = p[2], d = p[3];
            const float s0 = ((a[0] + a[1]) + (a[2] + a[3])) + ((b[0] + b[1]) + (b[2] + b[3])), s1 = ((c[0] + c[1]) + (c[2] + c[3])) + ((d[0] + d[1]) + (d[2] + d[3]));
            LAS float* tab = (LAS float*)(lds + STAGE_BYTES) + 2 * tid; tab[0] = __builtin_amdgcn_rsqf(s0 * (1.f / 512.f) + EPS); tab[1] = __builtin_amdgcn_rsqf(s1 * (1.f / 512.f) + EPS); }
    }
    DI void ld8(const bf16_t* p, float (&f)[8]) const { unpack8(*(const u32x4*)p, f); }
    DI void ldb(u32x4 (&g)[2][2], const bf16_t* pl, size_t pitch, int row0, int b) const {
#pragma unroll
        for (int m2 = 0; m2 < 2; ++m2)
#pragma unroll
            for (int bj = 0; bj < 2; ++bj) g[m2][bj] = *(const u32x4*)(pl + (size_t)(row0 + (b >> 1) * HALF + (2 * (b & 1) + m2) * 16) * pitch + bj * HALF);
    }
    DI void mid(Acc& acc, const Unit& u, int t, int wr, int wc, int fr, int fq, ldsp lds) const {
        int row0 = u.pm * BM + wr * 64 + fr; asm volatile("" : "+v"(row0));
        const int col0 = u.pn * BM + wc * 32 + 8 * fq;
        const int seg = t >> 3;
        const bf16_t* pl = (seg < 4 ? gates + (seg - 1) * DM : ones) + col0; const size_t pitch = seg < 4 ? (size_t)NGATE : (size_t)0;
        const unsigned m3 = (seg == 3) ? 0xffffffffu : 0u, m4 = (seg == 4) ? 0xffffffffu : 0u, one = 0x3f800000u;
        const LAS f32x2* tab = (const LAS f32x2*)(lds + STAGE_BYTES);
        u32x4 gb[2][2][2];
        ldb(gb[0], pl, pitch, row0, 0);
#pragma unroll
        for (int b = 0; b < 4; ++b) { const int ai = b >> 1, mh = b & 1;
            if (b + 1 < 4) ldb(gb[(b + 1) & 1], pl, pitch, row0, b + 1);
#pragma unroll
            for (int m2 = 0; m2 < 2; ++m2) { const int m = 2 * mh + m2; const f32x2 r = tab[wr * 64 + fr + ai * HALF + m * 16];
                const unsigned u0 = __float_as_uint(r[0]), u1 = __float_as_uint(r[1]);
                const float sa = __uint_as_float((u0 & m4) | (one & ~m4)), sb = __uint_as_float((u0 & m3) | (u1 & m4) | (one & ~(m3 | m4)));
                const float rr = sa * __builtin_amdgcn_rcpf(sb);
#pragma unroll
                for (int bj = 0; bj < 2; ++bj) { float q[8]; unpack8(gb[b & 1][m2][bj], q);
#pragma unroll
                    for (int j = 0; j < 4; ++j) { acc[ai][bj][m][0][j] *= q[j] * rr; acc[ai][bj][m][1][j] *= q[4 + j] * rr; } } }
            asm volatile("" ::: "memory"); }
    }
    DI void operator()(const Acc& acc, const Unit& u, int wr, int wc, int fr, int fq, ldsp lds) const {
        const int row0 = u.pm * BM + wr * 64 + fr, col0 = u.pn * BM + wc * 32 + 8 * fq;
        const LAS f32x2* tab = (const LAS f32x2*)(lds + STAGE_BYTES);
#pragma unroll
        for (int ai = 0; ai < 2; ++ai) {
            u32x4 gg[4][2];
#pragma unroll
            for (int m = 0; m < 4; ++m)
#pragma unroll
                for (int bj = 0; bj < 2; ++bj) gg[m][bj] = *(const u32x4*)(gates + (size_t)(row0 + ai * HALF + m * 16) * NGATE + 3 * DM + col0 + bj * HALF);
#pragma unroll
            for (int m = 0; m < 4; ++m) { const int row = row0 + ai * HALF + m * 16; const float r1 = tab[wr * 64 + fr + ai * HALF + m * 16][1];
#pragma unroll
                for (int bj = 0; bj < 2; ++bj) { float g[8]; unpack8(gg[m][bj], g); f32x4 v0 = acc[ai][bj][m][0], v1 = acc[ai][bj][m][1];
#pragma unroll
                    for (int j = 0; j < 4; ++j) { v0[j] *= g[j] * r1; v1[j] *= g[4 + j] * r1; }
                    store8(O + (size_t)row * DM + col0 + bj * HALF, v0, v1); } }
            asm volatile("" ::: "memory"); }
    }
};
}

struct Params {
    const float* x; const float* norm1_g; const float* w_in; const float* gate_b; const float* fox_f_b; const float* fox_qn_g; const float* fox_kn_g;
    const float* dsa_cq_g; const float* dsa_w_uq; const float* dsa_w_qidx; const float* dsa_qn_g; const float* dsa_kn_g; const float* rel_bias;
    const float* ssd_conv_w; const float* ssd_conv_b; const float* ssd_dt_bias; const float* ssd_a_log; const float* ssd_d; const float* ssd_norm_g;
    const float* w_br; const float* w_out; const float* norm2_g; const float* w_ff1; const float* w_ff2;
    float* out; unsigned char* ws;
    int ph_lo, ph_hi, rep, pad;
};
struct Ctx {
    ldsp lds; int tid, lane, wave, G, bid;
    gu32* ctl;
};
DI Ctx fresh(const Ctx& c0) { Ctx c = c0; int t = c0.tid; asm volatile("" : "+v"(t)); c.tid = t; c.lane = t & 63; c.wave = __builtin_amdgcn_readfirstlane(t >> 6); return c; }
DI Params freshp(const Params& p0) { Params p = p0; GAS unsigned char* w = (GAS unsigned char*)p0.ws; asm volatile("" : "+s"(w)); p.ws = (unsigned char*)w; return p; }
typedef __attribute__((address_space(4))) const Params* kargp;
DI Params loadp() {
#if defined(__HIP_DEVICE_COMPILE__)
    kargp k = (kargp)__builtin_amdgcn_kernarg_segment_ptr(); asm volatile("" : "+s"(k)); Params p = *k;
    GAS unsigned char* w = (GAS unsigned char*)p.ws; asm volatile("" : "+s"(w)); p.ws = (unsigned char*)w; return p;
#else
    return Params{};
#endif
}
DI bf16_t* wsb(const Params& p, size_t off) { return (bf16_t*)(p.ws + off); }
DI float*  wsf(const Params& p, size_t off) { return (float*)(p.ws + off); }

DI int next_unit(const Ctx& c, int layer, int q) {
    volatile LAS int* slot = (volatile LAS int*)(c.lds + LDS_MISC);
    __syncthreads();
    int qi = (layer * NQUEUE + q) * 64; asm volatile("" : "+s"(qi));
    if (c.tid == 0) *slot = (int)__hip_atomic_fetch_add((unsigned*)(c.ctl + CW_QUEUE + qi), 1u, __ATOMIC_RELAXED, __HIP_MEMORY_SCOPE_AGENT);
    __syncthreads();
    return *slot;
}

DI int in_dest_row(int n) {
    if (n < 3584) return n;
    if (n < 3588) return C_FF + (n - 3584);
    if (n < 4420) return n - 4;
    if (n < 4436) return C_IW + (n - 4420);
    if (n < 6996) return n - 20;
    if (n < 7012) return n - 4;
    const int g = n - 7012, i = g >> 11, ch = g & 2047, tp = ch >> 6, cl = ch & 63;
    return NMIX + 256 * tp + 128 * (i >> 1) + 32 * (cl >> 4) + 8 * (((cl >> 3) & 1) + 2 * ((cl >> 2) & 1)) + 4 * (i & 1) + (cl & 3);
}
template <int MAP>
DI void transpose_item(const float* W, int K, int N, bf16_t* WT, int ldk, int row_off, const float* kscale, LAS float* scr, int item, int lane) {
    const int nblk = (N + 63) / 64, kb = item / nblk, nb = item % nblk, k0 = 64 * kb, n0 = 64 * nb;
    const int nq = n0 + 4 * (lane & 15); const bool nok = nq < N;
    f32x4 v[16];
#pragma unroll
    for (int i = 0; i < 16; ++i) { const int kk = 4 * i + (lane >> 4); v[i] = nok ? *(const f32x4*)(W + (size_t)(k0 + kk) * N + nq) : (f32x4){0.f, 0.f, 0.f, 0.f}; }
    const int c = lane & 7;
    f32x4 s0 = {1.f, 1.f, 1.f, 1.f}, s1 = s0; if (kscale) { s0 = *(const f32x4*)(kscale + k0 + 8 * c); s1 = *(const f32x4*)(kscale + k0 + 8 * c + 4); }
#pragma unroll
    for (int i = 0; i < 16; ++i) { const int kk = 4 * i + (lane >> 4); LAS float* d = scr + kk * 65 + 4 * (lane & 15); d[0] = v[i][0]; d[1] = v[i][1]; d[2] = v[i][2]; d[3] = v[i][3]; }
    asm volatile("s_waitcnt lgkmcnt(0)" ::: "memory");
#pragma unroll
    for (int j = 0; j < 8; ++j) { const int n = (lane >> 3) + 8 * j; const LAS float* s = scr + (8 * c) * 65 + n;
        u32x4 o; o.x = pk2(s[0 * 65] * s0[0], s[1 * 65] * s0[1]); o.y = pk2(s[2 * 65] * s0[2], s[3 * 65] * s0[3]); o.z = pk2(s[4 * 65] * s1[0], s[5 * 65] * s1[1]); o.w = pk2(s[6 * 65] * s1[2], s[7 * 65] * s1[3]);
        if (n0 + n < N) { const int dr = MAP ? in_dest_row(n0 + n) : row_off + n0 + n; *(u32x4*)(WT + (size_t)dr * ldk + k0 + 8 * c) = o; } }
    asm volatile("s_waitcnt lgkmcnt(0)" ::: "memory");
}
constexpr int I_IN = (DM / 64) * ((IN_TOTAL + 63) / 64), I_UQ = (KUP / 64) * (512 / 64), I_QI = (KUP / 64) * (1024 / 64), I_BR = (KBR / 64) * (DM / 64),
              I_OUT = (DM / 64) * (DM / 64), I_F1 = (DM / 64) * (DFF / 64), I_F2 = (DFF / 64) * (DM / 64), PER_LAYER = I_IN + I_UQ + I_QI + I_BR + I_OUT + I_F1 + I_F2;
DI void convert_items(const Params& p0, const Ctx& c0, int l, int lo, int hi, int wv, int nw) {
    const Ctx c = fresh(c0); const Params p = freshp(p0);
    LAS float* scr = (LAS float*)(c.lds + c.wave * 16640);
    unsigned char* wl = p.ws + WS_W + (size_t)l * WL_SIZE;
    for (int it = lo + wv; it < hi; it += nw) {
        int r = it;
        if (r < I_IN) { transpose_item<1>(p.w_in + (size_t)l * DM * IN_TOTAL, DM, IN_TOTAL, (bf16_t*)(wl + WL_IN), DM, 0, p.norm1_g + l * DM, scr, r, c.lane); continue; } r -= I_IN;
        if (r < I_UQ) { transpose_item<0>(p.dsa_w_uq + (size_t)l * KUP * 512, KUP, 512, (bf16_t*)(wl + WL_UP), KUP, 0, p.dsa_cq_g + l * KUP, scr, r, c.lane); continue; } r -= I_UQ;
        if (r < I_QI) { transpose_item<0>(p.dsa_w_qidx + (size_t)l * KUP * 1024, KUP, 1024, (bf16_t*)(wl + WL_UP), KUP, 512, p.dsa_cq_g + l * KUP, scr, r, c.lane); continue; } r -= I_QI;
        if (r < I_BR) { transpose_item<0>(p.w_br + (size_t)l * KBR * DM, KBR, DM, (bf16_t*)(wl + WL_BR), KBR, 0, nullptr, scr, r, c.lane); continue; } r -= I_BR;
        if (r < I_OUT) { transpose_item<0>(p.w_out + (size_t)l * DM * DM, DM, DM, (bf16_t*)(wl + WL_OUT), DM, 0, nullptr, scr, r, c.lane); continue; } r -= I_OUT;
        if (r < I_F1) { transpose_item<0>(p.w_ff1 + (size_t)l * DM * DFF, DM, DFF, (bf16_t*)(wl + WL_FF1), DM, 0, p.norm2_g + l * DM, scr, r, c.lane); continue; } r -= I_F1;
        transpose_item<0>(p.w_ff2 + (size_t)l * DFF * DM, DFF, DM, (bf16_t*)(wl + WL_FF2), DFF, 0, nullptr, scr, r, c.lane);
    }
}
constexpr int CV_B = 1472;
DI void convert_on_idle(const Params& p, const Ctx& c, int l, int lo, int hi, int nunits) {
    const int first_idle = nunits % c.G;
    if (first_idle == 0) convert_items(p, c, l, lo, hi, c.bid * 8 + c.wave, c.G * 8);
    else if (c.bid >= first_idle) convert_items(p, c, l, lo, hi, (c.bid - first_idle) * 8 + c.wave, (c.G - first_idle) * 8);
}
DI void p0_prologue(const Params& p0, const Ctx& c0) {
    const Ctx c = fresh(c0); const Params p = freshp(p0);
    convert_items(p, c, 0, 0, I_IN, c.bid * 8 + c.wave, c.G * 8);
    if (c.bid == 0 && c.tid < 256) *(u32x4*)(wsb(p, WS_ONES) + 8 * c.tid) = (u32x4){0x3f803f80u, 0x3f803f80u, 0x3f803f80u, 0x3f803f80u};
    constexpr int PADROWS = NMIX - C_MIXEND, CH = DM / 8;
    for (int i = (c.bid * 512 + c.tid); i < DEPTH * PADROWS * CH; i += c.G * 512) { const int l = i / (PADROWS * CH), r = (i / CH) % PADROWS, ch = i % CH;
        *(u32x4*)((bf16_t*)(p.ws + WS_W + (size_t)l * WL_SIZE + WL_IN) + (size_t)(C_MIXEND + r) * DM + ch * 8) = (u32x4){0u, 0u, 0u, 0u}; }
}

DI float wave_sum(float v, int lane) {
#pragma unroll
    for (int o = 1; o < 64; o <<= 1) v += shx(v, o, lane);
    return v;
}
DI void xprep_phase(const Ctx& c0, const float* x, bf16_t* xb, float* ssp) {
    const Ctx c = fresh(c0);
    const int gw = c.bid * 8 + c.wave, NGW = c.G * 8;
    for (int m = gw; m < MTOK; m += NGW) {
        const f32x4* xr = (const f32x4*)(x + (size_t)m * DM) + c.lane;
        f32x4 v[8]; float s = 0.f;
#pragma unroll
        for (int j = 0; j < 8; ++j) { v[j] = xr[64 * j]; s += (v[j][0] * v[j][0] + v[j][1] * v[j][1]) + (v[j][2] * v[j][2] + v[j][3] * v[j][3]); }
        s = wave_sum(s, c.lane);
        u32x2* o = (u32x2*)(xb + (size_t)m * DM) + c.lane;
#pragma unroll
        for (int j = 0; j < 8; ++j) { u32x2 w; w.x = pk2(v[j][0], v[j][1]); w.y = pk2(v[j][2], v[j][3]); o[64 * j] = w; }
        if (c.lane < 8) ssp[(size_t)m * 8 + c.lane] = (c.lane == 0) ? s : 0.f;
    }
}

DI void scan_phase(const Params& p0, const Ctx& c0) {
    const Ctx c = fresh(c0); const Params p = freshp(p0);
    const float* kvs = wsf(p, WS_KVS); bf16_t* prevr = wsb(p, WS_PREVR); const float* st = wsf(p, WS_ST); bf16_t* prevs = wsb(p, WS_PREVS); const float* acs = wsf(p, WS_ACS);
    const int gt = c.bid * 512 + c.tid, NT = c.G * 512;
    for (int e = gt; e < 16 * 4096; e += NT) {
        const int bh = e / 4096, q = e % 4096, h = bh & 3;
        const float cd = __expf(128.f * log1pf(-exp2f(-5.f - (float)h)));
        f32x4 kv[16];
#pragma unroll
        for (int n = 0; n < 16; ++n) kv[n] = *(const f32x4*)(kvs + ((size_t)(bh * 16 + n) * 16384) + (size_t)q * 4);
        f32x4 s = {0.f, 0.f, 0.f, 0.f};
#pragma unroll
        for (int n = 0; n < 16; ++n) { const size_t o = ((size_t)(bh * 16 + n) * 16384) + (size_t)q * 4;
            u32x2 w; w.x = pk2(s[0], s[1]); w.y = pk2(s[2], s[3]); *(u32x2*)(prevr + o) = w; s = s * cd + kv[n]; }
    }
    for (int e = gt; e < 64 * 2048; e += NT) {
        const int bhd = e / 2048, q = e % 2048, b = bhd >> 4, hd = bhd & 15;
        f32x4 v[16]; float cd[16];
#pragma unroll
        for (int n = 0; n < 16; ++n) { v[n] = *(const f32x4*)(st + ((size_t)((b * 16 + n) * 16 + hd) * 8192) + (size_t)q * 4); cd[n] = acs[(size_t)(b * SEQ + 128 * n + 127) * 16 + hd]; }
        f32x4 s = {0.f, 0.f, 0.f, 0.f};
#pragma unroll
        for (int n = 0; n < 16; ++n) { const size_t o = ((size_t)((b * 16 + n) * 16 + hd) * 8192) + (size_t)q * 4;
            u32x2 w; w.x = pk2(s[0], s[1]); w.y = pk2(s[2], s[3]); *(u32x2*)(prevs + o) = w; s = s * __expf(cd[n]) + v[n]; }
    }
}

struct LaneIds { int r, h, blk, q, pp; };
DI LaneIds lane_ids(int lane) { LaneIds L; L.r = lane & 31; L.h = lane >> 5; L.blk = (lane >> 4) & 1; L.q = (lane & 15) >> 2; L.pp = lane & 3; return L; }
DI int tr_nat_off(const LaneIds& L, int st) { return (8 * L.h + L.q) * st + 32 * L.blk + 8 * L.pp; }
DI int tr_krow_off(const LaneIds& L, int st) { return (4 * L.h + L.q) * st + 32 * L.blk + 8 * L.pp; }
DI bf16x8 pack_half(const f32x16& x, int s) { return pack8(x[8 * s], x[8 * s + 1], x[8 * s + 2], x[8 * s + 3], x[8 * s + 4], x[8 * s + 5], x[8 * s + 6], x[8 * s + 7]); }
DI float softplusf_(float x) { return x > 20.f ? x : log1pf(__expf(x)); }

DI void ssdst_unit(const Params& p0, const Ctx& c0, int layer, int u) {
    const Ctx c = fresh(c0); const Params p = freshp(p0);
    const int b = u >> 6, n = (u >> 2) & 15, g = (u >> 1) & 1, half = u & 1, T0 = b * SEQ + 128 * n;
    const bf16_t* mix = wsb(p, WS_MIX); bf16_t* xbcc = wsb(p, WS_XBCC); float* acsg = wsf(p, WS_ACS); float* bsg = wsf(p, WS_BS); float* stg = wsf(p, WS_ST);
    ldsp Xt = c.lds, Bt = c.lds + 73728; LAS float* sdec = (LAS float*)(c.lds + 73728 + 40960);
    const LaneIds L = lane_ids(c.lane);
    if (c.wave < 4) {
        const int hd = g * 8 + half * 4 + c.wave; const float dtb = p.ssd_dt_bias[layer * 16 + hd], A = -__expf(p.ssd_a_log[layer * 16 + hd]);
        const int l0 = 2 * c.lane;
        const float dt0 = softplusf_(bf2f(mix[(size_t)(T0 + l0) * NMIX + C_SDT + hd]) + dtb), dt1 = softplusf_(bf2f(mix[(size_t)(T0 + l0 + 1) * NMIX + C_SDT + hd]) + dtb);
        const float a0 = dt0 * A, a1 = dt1 * A; float s = a0 + a1;
#pragma unroll
        for (int o = 1; o < 64; o <<= 1) { const float t = shidx(s, c.lane - o); if (c.lane >= o) s += t; }
        const float c1 = s, c0 = s - a1, last = shidx(s, 63);
        acsg[(size_t)(T0 + l0) * 16 + hd] = c0; acsg[(size_t)(T0 + l0 + 1) * 16 + hd] = c1;
        bsg[(size_t)(T0 + l0) * 16 + hd] = -c0 + __logf(dt0); bsg[(size_t)(T0 + l0 + 1) * 16 + hd] = -c1 + __logf(dt1);
        sdec[c.wave * 128 + l0] = dt0 * __expf(last - c0); sdec[c.wave * 128 + l0 + 1] = dt1 * __expf(last - c1);
    }
    __syncthreads();
    const int NCH = half ? 64 : 48;
    const float* cw = p.ssd_conv_w + (size_t)layer * 4 * 1536; const float* cb = p.ssd_conv_b + (size_t)layer * 1536;
    {
        const int cc = c.lane, l0 = 16 * c.wave;
        if (cc < NCH) {
            int ch; if (cc < 32) ch = g * 512 + half * 256 + 8 * cc; else if (cc < 48) ch = 1024 + g * 128 + 8 * (cc - 32); else ch = 1280 + g * 128 + 8 * (cc - 48);
            const int mcol = C_SX + ch;
            u32x4 xr[19];
#pragma unroll
            for (int i = 0; i < 19; ++i) { const int tl = 128 * n + l0 - 3 + i; xr[i] = (tl >= 0) ? *(const u32x4*)(mix + (size_t)(b * SEQ + tl) * NMIX + mcol) : (u32x4){0u, 0u, 0u, 0u}; }
            float w[4][8], bs8[8];
#pragma unroll
            for (int j = 0; j < 4; ++j) { const f32x4 w0 = *(const f32x4*)(cw + j * 1536 + ch), w1 = *(const f32x4*)(cw + j * 1536 + ch + 4);
                w[j][0] = w0[0]; w[j][1] = w0[1]; w[j][2] = w0[2]; w[j][3] = w0[3]; w[j][4] = w1[0]; w[j][5] = w1[1]; w[j][6] = w1[2]; w[j][7] = w1[3]; }
            { const f32x4 b0 = *(const f32x4*)(cb + ch), b1 = *(const f32x4*)(cb + ch + 4); bs8[0] = b0[0]; bs8[1] = b0[1]; bs8[2] = b0[2]; bs8[3] = b0[3]; bs8[4] = b1[0]; bs8[5] = b1[1]; bs8[6] = b1[2]; bs8[7] = b1[3]; }
#pragma unroll
            for (int i = 0; i < 16; ++i) { const int l = l0 + i; float a[8];
#pragma unroll
                for (int e = 0; e < 8; ++e) a[e] = bs8[e];
#pragma unroll
                for (int j = 0; j < 4; ++j) { float xv[8]; unpack8(xr[i + j], xv);
#pragma unroll
                    for (int e = 0; e < 8; ++e) a[e] += w[j][e] * xv[e]; }
#pragma unroll
                for (int e = 0; e < 8; ++e) a[e] = siluf_(a[e]);
                const bf16x8 v = pack8(a[0], a[1], a[2], a[3], a[4], a[5], a[6], a[7]);
                if (cc < 32) { *(bf16x8*)(xbcc + (size_t)(T0 + l) * 1536 + ch) = v; const float sc = sdec[(cc >> 3) * 128 + l];
                    *(LAS bf16x8*)(Xt + l * 576 + cc * 16) = pack8(a[0] * sc, a[1] * sc, a[2] * sc, a[3] * sc, a[4] * sc, a[5] * sc, a[6] * sc, a[7] * sc); }
                else if (cc < 48) { if (half == 0) *(bf16x8*)(xbcc + (size_t)(T0 + l) * 1536 + ch) = v; *(LAS bf16x8*)(Bt + l * 320 + (cc - 32) * 16) = v; }
                else *(bf16x8*)(xbcc + (size_t)(T0 + l) * 1536 + ch) = v;
            }
        }
    }
    __syncthreads();
    {
        const int hq = c.wave & 3, kh = c.wave >> 2, hd = g * 8 + half * 4 + hq;
        f32x16 acc[2][2]; for (int i = 0; i < 2; ++i) for (int j = 0; j < 2; ++j) acc[i][j] = zero16();
        ldsp xa = Xt + tr_nat_off(L, 576) + hq * 128, ba = Bt + tr_nat_off(L, 320) + kh * 128;
#pragma unroll
        for (int ks = 0; ks < 8; ++ks) {
            bf16x8 A[2], Bf[2];
#pragma unroll
            for (int t = 0; t < 2; ++t) { A[t] = tr_pair(xa + ks * 16 * 576 + t * 64, 4 * 576); Bf[t] = tr_pair(ba + ks * 16 * 320 + t * 64, 4 * 320); }
#pragma unroll
            for (int pt = 0; pt < 2; ++pt)
#pragma unroll
                for (int kt = 0; kt < 2; ++kt) acc[pt][kt] = MFMA32(A[pt], Bf[kt], acc[pt][kt]);
        }
        float* o = stg + (size_t)((b * 16 + n) * 16 + hd) * 8192;
#pragma unroll
        for (int pt = 0; pt < 2; ++pt)
#pragma unroll
            for (int kt = 0; kt < 2; ++kt)
#pragma unroll
                for (int i = 0; i < 16; ++i) o[(32 * pt + crow(i, L.h)) * 128 + kh * 64 + 32 * kt + L.r] = acc[pt][kt][i];
    }
}
DI void ssdo_unit(const Params& p0, const Ctx& c0, int layer, int u) {
    const Ctx c = fresh(c0); const Params p = freshp(p0);
    const int b = u >> 6, n = (u >> 2) & 15, g = (u >> 1) & 1, half = u & 1, T0 = b * SEQ + 128 * n;
    const bf16_t* mix = wsb(p, WS_MIX); const bf16_t* xbcc = wsb(p, WS_XBCC); const float* acsg = wsf(p, WS_ACS); const float* bsg = wsf(p, WS_BS);
    const bf16_t* prevs = wsb(p, WS_PREVS); bf16_t* oall = wsb(p, WS_OALL); float* ssqh = wsf(p, WS_SSQH);
    ldsp XS = c.lds, BC = c.lds + 73728; LAS float* tacs = (LAS float*)(c.lds + 73728 + 34816); LAS float* tbs = tacs + 512;
    const LaneIds L = lane_ids(c.lane);
    const int hq = c.wave & 3, pr = c.wave >> 2, hd = g * 8 + half * 4 + hq;
    const bf16_t* prv = prevs + (size_t)((b * 16 + n) * 16 + hd) * 8192;
    u32x4 xs8[8], bc4[4];
#pragma unroll
    for (int i = 0; i < 8; ++i) { const int it = c.tid + 512 * i, l = it >> 5, cc = it & 31; xs8[i] = *(const u32x4*)(xbcc + (size_t)(T0 + l) * 1536 + g * 512 + half * 256 + 8 * cc); }
#pragma unroll
    for (int i = 0; i < 4; ++i) { const int it = c.tid + 512 * i, l = it >> 4, cc = it & 15; bc4[i] = *(const u32x4*)(xbcc + (size_t)(T0 + l) * 1536 + 1024 + g * 128 + 8 * cc); }
    const float ta = acsg[(size_t)(T0 + (c.tid & 127)) * 16 + g * 8 + half * 4 + (c.tid >> 7)], tb = bsg[(size_t)(T0 + (c.tid & 127)) * 16 + g * 8 + half * 4 + (c.tid >> 7)];
    bf16x8 Ap[2][8];
#pragma unroll
    for (int pt = 0; pt < 2; ++pt)
#pragma unroll
        for (int ks = 0; ks < 8; ++ks) Ap[pt][ks] = *(const bf16x8*)(prv + (32 * pt + L.r) * 128 + 16 * ks + 8 * L.h);
#pragma unroll
    for (int i = 0; i < 8; ++i) { const int it = c.tid + 512 * i, l = it >> 5, cc = it & 31; *(LAS u32x4*)(XS + l * 576 + cc * 16) = xs8[i]; }
#pragma unroll
    for (int i = 0; i < 4; ++i) { const int it = c.tid + 512 * i, l = it >> 4, cc = it & 15; *(LAS u32x4*)(BC + l * 272 + cc * 16) = bc4[i]; }
    tacs[c.tid] = ta; tbs[c.tid] = tb;
    __syncthreads();
    const float Dsk = p.ssd_d[layer * 16 + hd];
    const float* ng = p.ssd_norm_g + (size_t)layer * 1024 + g * 512 + half * 256 + hq * 64;
#pragma unroll
    for (int li = 0; li < 2; ++li) {
        const int lt = pr == 0 ? (li == 0 ? 0 : 3) : (li == 0 ? 1 : 2);
        const int l = 32 * lt + L.r; const size_t tok = (size_t)(T0 + l);
        bf16x8 Cf[8];
#pragma unroll
        for (int ks = 0; ks < 8; ++ks) Cf[ks] = *(const bf16x8*)(xbcc + tok * 1536 + 1280 + g * 128 + 16 * ks + 8 * L.h);
        u32x2 zw8[2][4];
#pragma unroll
        for (int pt = 0; pt < 2; ++pt)
#pragma unroll
            for (int gq = 0; gq < 4; ++gq) zw8[pt][gq] = *(const u32x2*)(mix + tok * NMIX + C_SZ + g * 512 + half * 256 + hq * 64 + 32 * pt + 8 * gq + 4 * L.h);
        f32x16 O[2]; O[0] = zero16(); O[1] = zero16();
#pragma unroll
        for (int pt = 0; pt < 2; ++pt)
#pragma unroll
            for (int ks = 0; ks < 8; ++ks) { O[pt] = MFMA32(Ap[pt][ks], Cf[ks], O[pt]); }

        const float acl = tacs[hq * 128 + l], eA = __expf(acl);
#pragma unroll
        for (int pt = 0; pt < 2; ++pt)
#pragma unroll
            for (int i = 0; i < 16; ++i) O[pt][i] *= eA;
#pragma unroll 1
        for (int st = 0; st <= lt; ++st) {
            f32x16 mt = zero16();
#pragma unroll
            for (int ks = 0; ks < 8; ++ks) { const bf16x8 A = *(const LAS bf16x8*)(BC + (32 * st + L.r) * 272 + (16 * ks + 8 * L.h) * 2); mt = MFMA32(A, Cf[ks], mt); }
#pragma unroll
            for (int gq = 0; gq < 4; ++gq) { const f32x4 bv = *(const LAS f32x4*)(tbs + hq * 128 + 32 * st + 8 * gq + 4 * L.h);
#pragma unroll
                for (int e = 0; e < 4; ++e) { const int s = 32 * st + 8 * gq + 4 * L.h + e; const float w = __expf(acl + bv[e]); mt[4 * gq + e] = (l >= s) ? mt[4 * gq + e] * w : 0.f; } }
            const bf16x8 pk0 = pack_half(mt, 0), pk1 = pack_half(mt, 1);
            ldsp xa = XS + tr_krow_off(L, 576) + (32 * st) * 576 + hq * 128;
#pragma unroll
            for (int pt = 0; pt < 2; ++pt) { O[pt] = MFMA32(tr_pair(xa + pt * 64, 8 * 576), pk0, O[pt]); O[pt] = MFMA32(tr_pair(xa + 16 * 576 + pt * 64, 8 * 576), pk1, O[pt]); }
        }
        float ssq = 0.f;
#pragma unroll
        for (int pt = 0; pt < 2; ++pt) { u32x2 w4[4];
#pragma unroll
            for (int gq = 0; gq < 4; ++gq) { const int pch = 32 * pt + 8 * gq + 4 * L.h;
                const u32x2 xw = *(const LAS u32x2*)(XS + l * 576 + (hq * 64 + pch) * 2);
                const u32x2 zw = zw8[pt][gq];
                const f32x4 gn = *(const f32x4*)(ng + pch);
                const float xv[4] = {bflo(xw.x), bfhi(xw.x), bflo(xw.y), bfhi(xw.y)}, zv[4] = {bflo(zw.x), bfhi(zw.x), bflo(zw.y), bfhi(zw.y)};
                float o[4];
#pragma unroll
                for (int e = 0; e < 4; ++e) { const float y = O[pt][4 * gq + e] + Dsk * xv[e]; const float gt = y * siluf_(zv[e]); ssq += gt * gt; o[e] = gt * gn[e]; }
                w4[gq].x = pk2(o[0], o[1]); w4[gq].y = pk2(o[2], o[3]); }
            bf16_t* rowp = oall + tok * KBR + O_SSD + g * 512 + half * 256 + hq * 64 + 32 * pt;
            store_pair_t21(rowp, 0, w4[0], w4[1], L.h); store_pair_t21(rowp, 2, w4[2], w4[3], L.h); }
        ssq += shx(ssq, 32, c.lane);
        if (L.h == 0) ssqh[tok * 16 + hd] = ssq;
    }
}

DI float ret_loggamma(int h) { return log1pf(-exp2f(-5.f - (float)h)); }
struct RetKV { u32x4 ka[2], kb[2], v[4]; };
DI void ret_load_kv(RetKV& r, const Ctx& c, const bf16_t* mix, int T0, int h) {
#pragma unroll
    for (int i = 0; i < 2; ++i) { const int it = c.tid + 512 * i, j = it >> 3, cc = it & 7; const bf16_t* row = mix + (size_t)(T0 + j) * NMIX + C_RK + h * 128;
        r.ka[i] = *(const u32x4*)(row + 8 * cc); r.kb[i] = *(const u32x4*)(row + 64 + 8 * cc); }
#pragma unroll
    for (int i = 0; i < 4; ++i) { const int it = c.tid + 512 * i, j = it >> 4, cc = it & 15; r.v[i] = *(const u32x4*)(mix + (size_t)(T0 + j) * NMIX + C_RV + h * 128 + 8 * cc); }
}
DI void ret_write_kv(const RetKV& r, const Ctx& c, int n, int h, ldsp Kt, int st, bool with_decay, ldsp Vt) {
    const float lg = ret_loggamma(h);
#pragma unroll
    for (int i = 0; i < 2; ++i) {
        const int it = c.tid + 512 * i, j = it >> 3, cc = it & 7; float x1[8], x2[8]; unpack8(r.ka[i], x1); unpack8(r.kb[i], x2);
        const float sc = 0.08838834764831845f * (with_decay ? __expf(lg * (float)(127 - j)) : 1.f), pos = (float)(128 * n + j);
        float o1[8], o2[8];
#pragma unroll
        for (int e = 0; e < 8; ++e) { const float inv = __builtin_amdgcn_exp2f(-(float)(8 * cc + e) * 0.20762050593046014f); const float ang = __fmul_rn(pos, inv); float rev = ang * 0.15915494309189535f; rev = __builtin_amdgcn_fractf(rev);
            const float sn = __builtin_amdgcn_sinf(rev), cs = __builtin_amdgcn_cosf(rev); o1[e] = (x1[e] * cs - x2[e] * sn) * sc; o2[e] = (x1[e] * sn + x2[e] * cs) * sc; }
        *(LAS bf16x8*)(Kt + j * st + cc * 16) = pack8(o1[0], o1[1], o1[2], o1[3], o1[4], o1[5], o1[6], o1[7]);
        *(LAS bf16x8*)(Kt + j * st + 128 + cc * 16) = pack8(o2[0], o2[1], o2[2], o2[3], o2[4], o2[5], o2[6], o2[7]);
    }
#pragma unroll
    for (int i = 0; i < 4; ++i) { const int it = c.tid + 512 * i, j = it >> 4, cc = it & 15; *(LAS u32x4*)(Vt + j * 320 + cc * 16) = r.v[i]; }
}
DI void retkv_unit(const Params& p0, const Ctx& c0, int u) {
    const Ctx c = fresh(c0); const Params p = freshp(p0);
    const int b = u >> 6, h = (u >> 4) & 3, n = u & 15, T0 = b * SEQ + 128 * n;
    const bf16_t* mix = wsb(p, WS_MIX); float* kvs = wsf(p, WS_KVS) + (size_t)u * 16384;
    ldsp Kt = c.lds, Vt = c.lds + 40960; const LaneIds L = lane_ids(c.lane);
    { RetKV r; ret_load_kv(r, c, mix, T0, h); ret_write_kv(r, c, n, h, Kt, 320, true, Vt); }
    __syncthreads();
    const int rt = c.wave >> 1, chh = c.wave & 1;
    f32x16 acc[2]; acc[0] = zero16(); acc[1] = zero16();
    ldsp va = Vt + tr_nat_off(L, 320) + rt * 64, ka = Kt + tr_nat_off(L, 320) + chh * 128;
#pragma unroll
    for (int ks = 0; ks < 8; ++ks) { const bf16x8 A = tr_pair(va + ks * 16 * 320, 4 * 320);
#pragma unroll
        for (int t = 0; t < 2; ++t) acc[t] = MFMA32(A, tr_pair(ka + ks * 16 * 320 + t * 64, 4 * 320), acc[t]); }
#pragma unroll
    for (int t = 0; t < 2; ++t)
#pragma unroll
        for (int i = 0; i < 16; ++i) kvs[(32 * rt + crow(i, L.h)) * 128 + chh * 64 + 32 * t + L.r] = acc[t][i];
}
DI void reto_unit(const Params& p0, const Ctx& c0, int u) {
    const Ctx c = fresh(c0); const Params p = freshp(p0);
    const int b = u >> 6, h = (u >> 4) & 3, n = u & 15, T0 = b * SEQ + 128 * n;
    const bf16_t* mix = wsb(p, WS_MIX); const bf16_t* prv = wsb(p, WS_PREVR) + (size_t)u * 16384; bf16_t* oall = wsb(p, WS_OALL);
    ldsp Kt = c.lds, Vt = c.lds + 34816; LAS float* exch = (LAS float*)(c.lds + 34816 + 40960); const LaneIds L = lane_ids(c.lane);
    const int qg = c.wave & 3, dvh = c.wave >> 2, il = 32 * qg + L.r; const size_t tok = (size_t)(T0 + il);
    const float lg = ret_loggamma(h);
    RetKV rkv; ret_load_kv(rkv, c, mix, T0, h);
    u32x4 qraw[8]; { const bf16_t* row = mix + tok * NMIX + C_RQ + h * 128;
#pragma unroll
      for (int s = 0; s < 4; ++s) { qraw[s] = *(const u32x4*)(row + 16 * s + 8 * L.h); qraw[s + 4] = *(const u32x4*)(row + 64 + 16 * s + 8 * L.h); } }
    bf16x8 Ap[2][8];
#pragma unroll
    for (int dl = 0; dl < 2; ++dl)
#pragma unroll
        for (int s = 0; s < 8; ++s) Ap[dl][s] = *(const bf16x8*)(prv + (32 * (2 * dvh + dl) + L.r) * 128 + 16 * s + 8 * L.h);
    u32x2 gwv[2][4];
#pragma unroll
    for (int dl = 0; dl < 2; ++dl)
#pragma unroll
        for (int gq = 0; gq < 4; ++gq) gwv[dl][gq] = *(const u32x2*)(mix + tok * NMIX + C_RG + h * 128 + 32 * (2 * dvh + dl) + 8 * gq + 4 * L.h);
    ret_write_kv(rkv, c, n, h, Kt, 272, false, Vt);
    bf16x8 Qf[8];
    { const float pos = (float)(128 * n + il);
#pragma unroll
      for (int s = 0; s < 4; ++s) { float x1[8], x2[8], o1[8], o2[8]; unpack8(qraw[s], x1); unpack8(qraw[s + 4], x2);
#pragma unroll
          for (int e = 0; e < 8; ++e) { const float inv = __builtin_amdgcn_exp2f(-(float)(16 * s + 8 * L.h + e) * 0.20762050593046014f); const float ang = __fmul_rn(pos, inv); float rev = ang * 0.15915494309189535f; rev = __builtin_amdgcn_fractf(rev);
              const float sn = __builtin_amdgcn_sinf(rev), cs = __builtin_amdgcn_cosf(rev); o1[e] = x1[e] * cs - x2[e] * sn; o2[e] = x1[e] * sn + x2[e] * cs; }
          Qf[s] = pack8(o1[0], o1[1], o1[2], o1[3], o1[4], o1[5], o1[6], o1[7]); Qf[s + 4] = pack8(o2[0], o2[1], o2[2], o2[3], o2[4], o2[5], o2[6], o2[7]); } }
    f32x16 O[2]; O[0] = zero16(); O[1] = zero16();
#pragma unroll
    for (int dl = 0; dl < 2; ++dl)
#pragma unroll
        for (int s = 0; s < 8; ++s) { O[dl] = MFMA32(Ap[dl][s], Qf[s], O[dl]); }

    { const float qd = __expf(lg * (float)(il + 1));
#pragma unroll
      for (int dl = 0; dl < 2; ++dl)
#pragma unroll
          for (int i = 0; i < 16; ++i) O[dl][i] *= qd; }
    __syncthreads();
#pragma unroll 1
    for (int rt = 0; rt <= qg; ++rt) {
        f32x16 st = zero16();
#pragma unroll
        for (int s = 0; s < 8; ++s) { const bf16x8 A = *(const LAS bf16x8*)(Kt + (32 * rt + L.r) * 272 + (16 * s + 8 * L.h) * 2); st = MFMA32(A, Qf[s], st); }
#pragma unroll
        for (int i = 0; i < 16; ++i) { const int j = 32 * rt + crow(i, L.h); st[i] = (il >= j) ? st[i] * __expf(lg * (float)(il - j)) : 0.f; }
        const bf16x8 pk0 = pack_half(st, 0), pk1 = pack_half(st, 1);
        ldsp va = Vt + tr_krow_off(L, 320) + (32 * rt) * 320 + dvh * 128;
#pragma unroll
        for (int dl = 0; dl < 2; ++dl) { O[dl] = MFMA32(tr_pair(va + dl * 64, 8 * 320), pk0, O[dl]); O[dl] = MFMA32(tr_pair(va + 16 * 320 + dl * 64, 8 * 320), pk1, O[dl]); }
    }
    float s1 = 0.f, s2 = 0.f;
#pragma unroll
    for (int dl = 0; dl < 2; ++dl)
#pragma unroll
        for (int i = 0; i < 16; ++i) { s1 += O[dl][i]; s2 += O[dl][i] * O[dl][i]; }
    s1 += shx(s1, 32, c.lane); s2 += shx(s2, 32, c.lane);
    if (L.h == 0) { exch[(dvh * 128 + il) * 2] = s1; exch[(dvh * 128 + il) * 2 + 1] = s2; }
    __syncthreads();
    const float t1 = exch[il * 2] + exch[(128 + il) * 2], t2 = exch[il * 2 + 1] + exch[(128 + il) * 2 + 1];
    const float mean = t1 * (1.f / 128.f), var = fmaxf(t2 * (1.f / 128.f) - mean * mean, 0.f), rstd = __builtin_amdgcn_rsqf(var + EPS);
#pragma unroll
    for (int dl = 0; dl < 2; ++dl) { u32x2 w4[4];
#pragma unroll
        for (int gq = 0; gq < 4; ++gq) { const u32x2 gw = gwv[dl][gq]; const float gv[4] = {bflo(gw.x), bfhi(gw.x), bflo(gw.y), bfhi(gw.y)}; float o[4];
#pragma unroll
            for (int e = 0; e < 4; ++e) o[e] = siluf_(gv[e]) * (O[dl][4 * gq + e] - mean) * rstd;
            w4[gq].x = pk2(o[0], o[1]); w4[gq].y = pk2(o[2], o[3]); }
        bf16_t* rowp = oall + tok * KBR + O_RET + h * 128 + 32 * (2 * dvh + dl);
        store_pair_t21(rowp, 0, w4[0], w4[1], L.h); store_pair_t21(rowp, 2, w4[2], w4[3], L.h); }
}

constexpr int KT_PITCH = 272, VT_PITCH = 320, KT_BYTES = 64 * KT_PITCH, VT_BYTES = 64 * VT_PITCH;
struct KvStage { u32x4 k[2], v[2]; };
DI void kv_load(KvStage& s, const bf16_t* kbase, int kp, const bf16_t* vbase, int vp, int row0, int tid) {
    const int key = tid >> 3, cp = tid & 7; const size_t rk = (size_t)(row0 + key) * kp, rv = (size_t)(row0 + key) * vp;
    s.k[0] = *(const u32x4*)(kbase + rk + 8 * cp); s.k[1] = *(const u32x4*)(kbase + rk + 64 + 8 * cp);
    s.v[0] = *(const u32x4*)(vbase + rv + 8 * cp); s.v[1] = *(const u32x4*)(vbase + rv + 64 + 8 * cp);
}
DI void kv_write(const KvStage& s, ldsp Kt, ldsp Vt, int tid) {
    const int key = tid >> 3, cp = tid & 7;
    *(LAS u32x4*)(Kt + key * KT_PITCH + cp * 16) = s.k[0]; *(LAS u32x4*)(Kt + key * KT_PITCH + 128 + cp * 16) = s.k[1];
    *(LAS u32x4*)(Vt + key * VT_PITCH + cp * 16) = s.v[0]; *(LAS u32x4*)(Vt + key * VT_PITCH + 128 + cp * 16) = s.v[1];
}
struct AttnState { f32x16 O[4]; float m, l; };
DI void attn_qk(f32x16 (&st)[2], ldsp Kt, const bf16x8 (&Qf)[8], const LaneIds& L) {
    st[0] = zero16(); st[1] = zero16();
#pragma unroll
    for (int rt = 0; rt < 2; ++rt)
#pragma unroll
        for (int s = 0; s < 8; ++s) st[rt] = MFMA32(*(const LAS bf16x8*)(Kt + (32 * rt + L.r) * KT_PITCH + (16 * s + 8 * L.h) * 2), Qf[s], st[rt]);
}
template <bool MASKW>
DI void attn_softmax_pv(AttnState& A, f32x16 (&st)[2], ldsp Vt, const LaneIds& L, unsigned mw0 = 0u, unsigned mw1 = 0u) {
    float mx = st[0][0];
#pragma unroll
    for (int rt = 0; rt < 2; ++rt)
#pragma unroll
        for (int i = 0; i < 16; ++i) mx = fmaxf(mx, st[rt][i]);
    mx = fmaxf(mx, shx(mx, 32, L.r + 32 * L.h));
    const float mn = fmaxf(A.m, mx);
    float rs = 0.f;
#pragma unroll
    for (int rt = 0; rt < 2; ++rt)
#pragma unroll
        for (int i = 0; i < 16; ++i) { float pv = __builtin_amdgcn_exp2f(st[rt][i] - mn);
            if (MASKW) { const int cr_ = (i & 3) + 8 * (i >> 2); pv = __uint_as_float(__float_as_uint(pv) & (unsigned)__builtin_amdgcn_sbfe((int)(rt ? mw1 : mw0), cr_, 1)); }
            st[rt][i] = pv; rs += pv; }
    rs += shx(rs, 32, L.r + 32 * L.h);
    if (__builtin_amdgcn_ballot_w64(mn > A.m) != 0ull) {
        const float alpha = __builtin_amdgcn_exp2f(A.m - mn);
        A.l *= alpha; A.m = mn;
#pragma unroll
        for (int dt = 0; dt < 4; ++dt)
#pragma unroll
            for (int i = 0; i < 16; ++i) A.O[dt][i] *= alpha;
    }
    A.l += rs;
    ldsp va = Vt + tr_krow_off(L, VT_PITCH);
#pragma unroll
    for (int rt = 0; rt < 2; ++rt)
#pragma unroll
        for (int s2 = 0; s2 < 2; ++s2) { const bf16x8 pk = pack_half(st[rt], s2);
#pragma unroll
            for (int dt = 0; dt < 4; ++dt) A.O[dt] = MFMA32(tr_pair(va + (32 * rt + 16 * s2) * VT_PITCH + dt * 64, 8 * VT_PITCH), pk, A.O[dt]); }
}
DI void attn_store(const AttnState& A, bf16_t* orow, const LaneIds& L) {
    const float inv = 1.f / A.l;
#pragma unroll
    for (int dt = 0; dt < 4; ++dt)
#pragma unroll
        for (int gq = 0; gq < 4; gq += 2) { u32x2 a, b;
            a.x = pk2(A.O[dt][4 * gq] * inv, A.O[dt][4 * gq + 1] * inv); a.y = pk2(A.O[dt][4 * gq + 2] * inv, A.O[dt][4 * gq + 3] * inv);
            b.x = pk2(A.O[dt][4 * gq + 4] * inv, A.O[dt][4 * gq + 5] * inv); b.y = pk2(A.O[dt][4 * gq + 6] * inv, A.O[dt][4 * gq + 7] * inv);
            store_pair_t21(orow, 4 * dt + gq, a, b, L.h); }
}
DI void attn_load_q(bf16x8 (&Qf)[8], const bf16_t* qrow, const float* g, float pre, float scale, const LaneIds& L) {
    float x[8][8]; float ss = 0.f;
#pragma unroll
    for (int s = 0; s < 8; ++s) { unpack8(*(const u32x4*)(qrow + 16 * s + 8 * L.h), x[s]);
#pragma unroll
        for (int e = 0; e < 8; ++e) { x[s][e] *= pre; ss += x[s][e] * x[s][e]; } }
    ss += shx(ss, 32, L.r + 32 * L.h);
    const float f = scale * __builtin_amdgcn_rsqf(ss * (1.f / 128.f) + EPS);
#pragma unroll
    for (int s = 0; s < 8; ++s) { const f32x4 g0 = *(const f32x4*)(g + 16 * s + 8 * L.h), g1 = *(const f32x4*)(g + 16 * s + 8 * L.h + 4);
        Qf[s] = pack8(x[s][0] * f * g0[0], x[s][1] * f * g0[1], x[s][2] * f * g0[2], x[s][3] * f * g0[3], x[s][4] * f * g1[0], x[s][5] * f * g1[1], x[s][6] * f * g1[2], x[s][7] * f * g1[3]); }
}

DI void fox_unit(const Params& p0, const Ctx& c0, int layer, int u) {
    const Ctx c = fresh(c0); const Params p = freshp(p0);
    const int qb = 7 - (u >> 4), bh = u & 15, b = bh >> 2, hd = bh & 3, t0 = 256 * qb;
    const bf16_t* mix = wsb(p, WS_MIX); bf16_t* oall = wsb(p, WS_OALL);
    LAS float* Fs = (LAS float*)c.lds; LAS float* wtot = Fs + 2048; ldsp KV = c.lds + 8192 + 64;
    const LaneIds L = lane_ids(c.lane);
    {
        const float fb = p.fox_f_b[layer * 4 + hd]; float v[4];
#pragma unroll
        for (int e = 0; e < 4; ++e) { const float x = bf2f(mix[(size_t)(b * SEQ + 4 * c.tid + e) * NMIX + C_FF + hd]) + fb; v[e] = (fminf(x, 0.f) - log1pf(__expf(-fabsf(x)))) * LOG2E; }
        v[1] += v[0]; v[2] += v[1]; v[3] += v[2];
        float s = v[3];
#pragma unroll
        for (int o = 1; o < 64; o <<= 1) { const float t = shidx(s, c.lane - o); if (c.lane >= o) s += t; }
        if (c.lane == 63) wtot[c.wave] = s;
        __syncthreads();
        float base = s - v[3];
        for (int w = 0; w < c.wave; ++w) base += wtot[w];
        *(LAS f32x4*)(Fs + 4 * c.tid) = (f32x4){base + v[0], base + v[1], base + v[2], base + v[3]};
    }
    const int tq = t0 + 32 * c.wave + L.r;
    bf16x8 Qf[8];
    attn_load_q(Qf, mix + (size_t)(b * SEQ + tq) * NMIX + C_FQ + hd * 128, p.fox_qn_g + layer * 128, 1.f, 0.08838834764831845f * LOG2E, L);
    AttnState A; for (int i = 0; i < 4; ++i) A.O[i] = zero16(); A.m = -1e30f; A.l = 0.f;
    const bf16_t* kbase = wsb(p, WS_FOXKN) + hd * 128; const bf16_t* vbase = mix + C_FV + hd * 128;
    const int nt = (t0 + 256) / 64;
    KvStage sg; kv_load(sg, kbase, 512, vbase, NMIX, b * SEQ, c.tid); kv_write(sg, KV, KV + KT_BYTES, c.tid);
    __syncthreads();
#pragma unroll 1
    for (int j = 0; j < nt; ++j) {
        const int kb = 64 * j; ldsp Kt = KV + (j & 1) * (KT_BYTES + VT_BYTES), Vt = Kt + KT_BYTES;
        if (j + 1 < nt) kv_load(sg, kbase, 512, vbase, NMIX, b * SEQ + kb + 64, c.tid);
        if (kb <= t0 + 32 * c.wave + 31) {
            f32x16 st[2]; attn_qk(st, Kt, Qf, L);
            const bool diag = kb + 63 > t0 + 32 * c.wave;
#pragma unroll
            for (int rt = 0; rt < 2; ++rt)
#pragma unroll
                for (int gq = 0; gq < 4; ++gq) { const f32x4 fv = *(const LAS f32x4*)(Fs + kb + 32 * rt + 8 * gq + 4 * L.h);
#pragma unroll
                    for (int e = 0; e < 4; ++e) { float sv = st[rt][4 * gq + e] - fv[e]; if (diag && (kb + 32 * rt + 8 * gq + 4 * L.h + e > tq)) sv = -__builtin_inff(); st[rt][4 * gq + e] = sv; } }
            attn_softmax_pv<false>(A, st, Vt, L);
        }
        if (j + 1 < nt) { ldsp Kn = KV + ((j + 1) & 1) * (KT_BYTES + VT_BYTES); kv_write(sg, Kn, Kn + KT_BYTES, c.tid); }
        __syncthreads();
    }
    attn_store(A, oall + (size_t)(b * SEQ + tq) * KBR + O_FOX + hd * 128, L);
}

DI void idx_unit(const Params& p0, const Ctx& c0, int u) {
    const Ctx c = fresh(c0); const Params p = freshp(p0);
    const int qb = 63 - (u >> 2), b = u & 3, t0 = 32 * qb;
    const bf16_t* mix = wsb(p, WS_MIX); const bf16_t* qup = wsb(p, WS_QUP); float* scores = wsf(p, WS_SCORES);
    ldsp KI = c.lds; const LaneIds L = lane_ids(c.lane);
    bf16x8 Af[2][4]; float Wr[2][16];
#pragma unroll
    for (int pp = 0; pp < 2; ++pp) {
        const int tqa = t0 + 4 * c.wave + 2 * pp + ((L.r >> 2) & 1), head = 4 * (L.r >> 3) + (L.r & 3);
#pragma unroll
        for (int s = 0; s < 4; ++s) Af[pp][s] = *(const bf16x8*)(qup + (size_t)(b * SEQ + tqa) * NUP + 512 + head * 64 + 16 * s + 8 * L.h);
        const bf16_t* wrow = mix + (size_t)(b * SEQ + t0 + 4 * c.wave + 2 * pp + L.h) * NMIX + C_IW; float w0[8], w1[8]; unpack8(*(const u32x4*)wrow, w0); unpack8(*(const u32x4*)(wrow + 8), w1);
#pragma unroll
        for (int i = 0; i < 8; ++i) { Wr[pp][i] = w0[i]; Wr[pp][8 + i] = w1[i]; }
    }
    const int nsup = (t0 + 31) / 256 + 1;
    u32x4 sg[4];
#pragma unroll
    for (int i = 0; i < 4; ++i) { const int it = c.tid + 512 * i; sg[i] = *(const u32x4*)(mix + (size_t)(b * SEQ + (it >> 3)) * NMIX + C_IK + 8 * (it & 7)); }
#pragma unroll
    for (int i = 0; i < 4; ++i) { const int it = c.tid + 512 * i; *(LAS u32x4*)(KI + (it >> 3) * 144 + (it & 7) * 16) = sg[i]; }
    __syncthreads();
#pragma unroll 1
    for (int js = 0; js < nsup; ++js) {
        ldsp Kc = KI + (js & 1) * 36864;
        if (js + 1 < nsup) {
#pragma unroll
            for (int i = 0; i < 4; ++i) { const int it = c.tid + 512 * i; sg[i] = *(const u32x4*)(mix + (size_t)(b * SEQ + 256 * (js + 1) + (it >> 3)) * NMIX + C_IK + 8 * (it & 7)); } }
#pragma unroll 1
        for (int kt = 0; kt < 8; ++kt) {
            const int kb = 256 * js + 32 * kt; if (kb > t0 + 31) break;
            bf16x8 Bf[4];
#pragma unroll
            for (int s = 0; s < 4; ++s) Bf[s] = *(const LAS bf16x8*)(Kc + (32 * kt + L.r) * 144 + (16 * s + 8 * L.h) * 2);
#pragma unroll
            for (int pp = 0; pp < 2; ++pp) { f32x16 acc = zero16();
#pragma unroll
                for (int s = 0; s < 4; ++s) acc = MFMA32(Af[pp][s], Bf[s], acc);
                float sc = 0.f;
#pragma unroll
                for (int i = 0; i < 16; ++i) sc += Wr[pp][i] * fmaxf(acc[i], 0.f);
                scores[(size_t)(b * SEQ + t0 + 4 * c.wave + 2 * pp + L.h) * SEQ + kb + L.r] = sc; }
        }
        if (js + 1 < nsup) { ldsp Kn = KI + ((js + 1) & 1) * 36864;
#pragma unroll
            for (int i = 0; i < 4; ++i) { const int it = c.tid + 512 * i; *(LAS u32x4*)(Kn + (it >> 3) * 144 + (it & 7) * 16) = sg[i]; } }
        __syncthreads();
    }
}

template <int NJ>
DI void sel_load(const float* row, int lane, unsigned (&raw)[NJ]) {
#pragma unroll
    for (int j = 0; j < NJ; ++j) raw[j] = __float_as_uint(row[64 * j + lane]);
}
template <int NJ>
DI void sel_select(const unsigned (&raw)[NJ], unsigned* mrow, int t, int lane) {
    unsigned x[NJ];
#pragma unroll
    for (int j = 0; j < NJ; ++j) { const int key = 64 * j + lane; const unsigned bits = raw[j];
        const unsigned uu = (bits & 0x80000000u) ? ~bits : (bits | 0x80000000u); x[j] = (key <= t) ? uu : 0u; }
    unsigned T = 1u; bool exact = (t + 1 <= 256);
    if (!exact) {
#define SEL_COUNT(dst, thr) do { int _c = 0; _Pragma("unroll") for (int j = 0; j < NJ; ++j) _c += __popcll(__ballot(x[j] >= (thr))); dst = _c; } while (0)
        const float ex = 16384.f / (float)(t + 1), mg = 3.f * sqrtf(ex) + 2.f; const int k_hi0 = (int)floorf(ex - mg), k_hi = k_hi0 < 1 ? 1 : k_hi0, k_lo = (int)ceilf(ex + mg);
        unsigned lo = 1u, hi = 0xffffffffu;
        if (k_lo <= 64) { unsigned v = 0u;
#pragma unroll 1
            for (int bit = 31; bit >= 0; --bit) { const unsigned cand = v | (1u << bit); if (__popcll(__ballot(x[0] >= cand)) >= k_lo) v = cand; }
            int cc; SEL_COUNT(cc, v); if (cc >= 256) { lo = v; if (cc == 256) { T = v; exact = true; } } else hi = v; }
        if (!exact) { unsigned v = 0u;
#pragma unroll 1
            for (int bit = 31; bit >= 0; --bit) { const unsigned cand = v | (1u << bit); if (__popcll(__ballot(x[0] >= cand)) >= k_hi) v = cand; }
            int cc; SEL_COUNT(cc, v);
            if (cc == 256) { T = v; exact = true; } else if (cc < 256) { if (v < hi) hi = v; } else if (v > lo) lo = v; }
        if (!exact) {
#pragma unroll 1
            while (hi - lo > 1u) { const unsigned mid = lo + ((hi - lo) >> 1); int cc; SEL_COUNT(cc, mid);
                if (cc == 256) { T = mid; exact = true; break; }
                if (cc > 256) lo = mid; else hi = mid; }
            if (!exact) T = lo;
        }
#undef SEL_COUNT
    }
    if (exact) {
#pragma unroll
        for (int j = 0; j < NJ; ++j) { const unsigned long long bal = __ballot(x[j] >= T); if (lane == 0) { mrow[2 * j] = (unsigned)bal; mrow[2 * j + 1] = (unsigned)(bal >> 32); } }
    } else {
        int gt = 0;
#pragma unroll
        for (int j = 0; j < NJ; ++j) gt += __popcll(__ballot(x[j] > T));
        int need = 256 - gt, run = 0;
#pragma unroll
        for (int j = 0; j < NJ; ++j) { const bool eq = x[j] == T; const unsigned long long be = __ballot(eq); const int below = __popcll(be & ((1ull << lane) - 1ull));
            const bool sel = (x[j] > T) || (eq && (run + below < need)); run += __popcll(be);
            const unsigned long long bal = __ballot(sel); if (lane == 0) { mrow[2 * j] = (unsigned)bal; mrow[2 * j + 1] = (unsigned)(bal >> 32); } }
    }
    if (lane < 2 * (32 - NJ)) mrow[2 * NJ + lane] = 0u;
}
DI void sel_unit(const Params& p0, const Ctx& c0, int u) {
    const Ctx c = fresh(c0); const Params p = freshp(p0);
    const int qb = 127 - (u >> 2), b = u & 3, t0 = 16 * qb;
    const float* scores = wsf(p, WS_SCORES); unsigned* msk = (unsigned*)(p.ws + WS_MSK);
    const int grp = (t0 + 15) >> 9;
    const int ta = t0 + 2 * c.wave, tb = ta + 1; const float* rowa = scores + (size_t)(b * SEQ + ta) * SEQ; const float* rowb = rowa + SEQ;
    unsigned* mra = msk + (size_t)(b * SEQ + ta) * 64; unsigned* mrb = mra + 64;
#define SEL_PAIR(NJ_) do { unsigned ra_[NJ_], rb_[NJ_]; sel_load<NJ_>(rowa, c.lane, ra_); sel_load<NJ_>(rowb, c.lane, rb_); sel_select<NJ_>(ra_, mra, ta, c.lane); sel_select<NJ_>(rb_, mrb, tb, c.lane); } while (0)
    if (grp == 0) SEL_PAIR(8); else if (grp == 1) SEL_PAIR(16); else if (grp == 2) SEL_PAIR(24); else SEL_PAIR(32);
#undef SEL_PAIR
}
DI void knorm_unit(const Params& p0, const Ctx& c0, int layer, int u) {
    const Ctx c = fresh(c0); const Params p = freshp(p0);
    const bf16_t* mix = wsb(p, WS_MIX); bf16_t* fk = wsb(p, WS_FOXKN); bf16_t* dk = wsb(p, WS_DSAKN);
    const int ch = c.tid & 15, tok = 32 * u + (c.tid >> 4);
    u32x4 raw[5];
#pragma unroll
    for (int hh = 0; hh < 5; ++hh) raw[hh] = *(const u32x4*)(mix + (size_t)tok * NMIX + (hh < 4 ? C_FK + hh * 128 : C_DK) + 8 * ch);
    const f32x4 f0 = *(const f32x4*)(p.fox_kn_g + layer * 128 + 8 * ch), f1 = *(const f32x4*)(p.fox_kn_g + layer * 128 + 8 * ch + 4);
    const f32x4 d0 = *(const f32x4*)(p.dsa_kn_g + layer * 128 + 8 * ch), d1 = *(const f32x4*)(p.dsa_kn_g + layer * 128 + 8 * ch + 4);
#pragma unroll
    for (int hh = 0; hh < 5; ++hh) {
        float a[8]; unpack8(raw[hh], a); float ss = 0.f;
#pragma unroll
        for (int e = 0; e < 8; ++e) ss += a[e] * a[e];
        ss += shx(ss, 1, c.lane); ss += shx(ss, 2, c.lane); ss += shx(ss, 4, c.lane); ss += shx(ss, 8, c.lane);
        const float rstd = __builtin_amdgcn_rsqf(ss * (1.f / 128.f) + EPS); const f32x4 g0 = hh < 4 ? f0 : d0, g1 = hh < 4 ? f1 : d1;
        const bf16x8 o = pack8(a[0] * rstd * g0[0], a[1] * rstd * g0[1], a[2] * rstd * g0[2], a[3] * rstd * g0[3], a[4] * rstd * g1[0], a[5] * rstd * g1[1], a[6] * rstd * g1[2], a[7] * rstd * g1[3]);
        if (hh < 4) *(bf16x8*)(fk + (size_t)tok * 512 + hh * 128 + 8 * ch) = o; else *(bf16x8*)(dk + (size_t)tok * 128 + 8 * ch) = o; }
}
DI void dsa_unit(const Params& p0, const Ctx& c0, int layer, int u) {
    const Ctx c = fresh(c0); const Params p = freshp(p0);
    const int qb = 31 - (u >> 2), b = u & 3, t0 = 64 * qb;
    const bf16_t* mix = wsb(p, WS_MIX); const bf16_t* qup = wsb(p, WS_QUP); bf16_t* oall = wsb(p, WS_OALL); const unsigned* msk = (const unsigned*)(p.ws + WS_MSK);
    LAS unsigned* Msk = (LAS unsigned*)c.lds; LAS float* Bl = (LAS float*)(c.lds + 16640); ldsp KV = c.lds + 16640 + 2048;
    const LaneIds L = lane_ids(c.lane);
    const int hd = c.wave >> 1, qg = c.wave & 1, ql = 32 * qg + L.r, tq = t0 + ql; const size_t tok = (size_t)(b * SEQ + tq);
    const float b31 = p.rel_bias[31 * 4 + hd] * LOG2E;
    if (c.tid < 128) {
        const int d = c.tid; int bk = d;
        if (d >= 16) { bk = 16 + (int)(__logf((float)d * (1.f / 16.f)) * (16.f / 2.0794415416798357f)); bk = bk > 31 ? 31 : bk; }
#pragma unroll
        for (int hh = 0; hh < 4; ++hh) Bl[d * 4 + hh] = (p.rel_bias[bk * 4 + hh] - p.rel_bias[31 * 4 + hh]) * LOG2E;
    }
#pragma unroll
    for (int i = 0; i < 8; ++i) { const int it = c.tid + 512 * i, q = it >> 6, w = it & 63; Msk[q * 65 + w] = msk[(size_t)(b * SEQ + t0 + q) * 64 + w]; }
    (void)b31;
    float rc;
    { float ss = 0.f; const bf16_t* cr = mix + tok * NMIX + C_DCQ + 256 * L.h;
#pragma unroll 4
      for (int i = 0; i < 32; ++i) { float f[8]; unpack8(*(const u32x4*)(cr + 8 * i), f);
#pragma unroll
          for (int e = 0; e < 8; ++e) ss += f[e] * f[e]; }
      ss += shx(ss, 32, L.r + 32 * L.h); rc = __builtin_amdgcn_rsqf(ss * (1.f / 512.f) + EPS); }
    bf16x8 Qf[8];
    attn_load_q(Qf, qup + tok * NUP + hd * 128, p.dsa_qn_g + layer * 128, rc, 0.08838834764831845f * LOG2E, L);
    AttnState A; for (int i = 0; i < 4; ++i) A.O[i] = zero16(); A.m = -1e30f; A.l = 0.f;
    const bf16_t* kbase = wsb(p, WS_DSAKN); const bf16_t* vbase = mix + C_DV;
    const int nt = qb + 1;
    KvStage sg; kv_load(sg, kbase, 128, vbase, NMIX, b * SEQ, c.tid); kv_write(sg, KV, KV + KT_BYTES, c.tid);
    __syncthreads();
#pragma unroll 1
    for (int j = 0; j < nt; ++j) {
        const int kb = 64 * j; ldsp Kt = KV + (j & 1) * (KT_BYTES + VT_BYTES), Vt = Kt + KT_BYTES;
        if (j + 1 < nt) kv_load(sg, kbase, 128, vbase, NMIX, b * SEQ + kb + 64, c.tid);
        {
            f32x16 st[2]; attn_qk(st, Kt, Qf, L);
            const unsigned mw0 = Msk[ql * 65 + 2 * j] >> (4 * L.h), mw1 = Msk[ql * 65 + 2 * j + 1] >> (4 * L.h);
            if (kb + 63 + 128 > t0 + 32 * qg) {
#pragma unroll
                for (int rt = 0; rt < 2; ++rt)
#pragma unroll
                    for (int i = 0; i < 16; ++i) { const int cr_ = (i & 3) + 8 * (i >> 2); const int d = tq - (kb + 32 * rt + cr_ + 4 * L.h);
                        if (d < 128) st[rt][i] += Bl[(d < 0 ? 0 : d) * 4 + hd]; }
            }
            attn_softmax_pv<true>(A, st, Vt, L, mw0, mw1);
        }
        if (j + 1 < nt) { ldsp Kn = KV + ((j + 1) & 1) * (KT_BYTES + VT_BYTES); kv_write(sg, Kn, Kn + KT_BYTES, c.tid); }
        __syncthreads();
    }
    attn_store(A, oall + tok * KBR + O_DSA + hd * 128, L);
}

constexpr int NPH = 9, NPHASES = 1 + DEPTH * NPH;
enum { Q_IDX = 0, Q_SSDST = 1, Q_RETKV = 2, Q_FOX = 3, Q_DSA = 4, Q_SSDO = 5, Q_RETO = 6, Q_SEL = 7 };
#ifndef LB2
#define LB2 2
#endif
__global__ void __launch_bounds__(512, LB2) fwd(Params pk) {
    extern __shared__ __attribute__((aligned(16))) unsigned char lds_raw[];
    Ctx c; c.lds = (ldsp)lds_raw; c.tid = threadIdx.x; c.lane = c.tid & 63; c.wave = __builtin_amdgcn_readfirstlane(c.tid >> 6); c.G = gridDim.x; c.bid = blockIdx.x;
    c.ctl = (gu32*)(pk.ws + WS_CTL);
    if (c.tid < 64) ((LAS unsigned*)(c.lds + LDS_MISC))[c.tid] = 0u;
    __syncthreads();
#if MK_PER_PHASE
#define GRID_BAR() do { } while (0)
#else
    XcdBarrier bar = xcd_barrier_post((unsigned*)(c.ctl + CW_BAR), (volatile LAS unsigned*)(c.lds + LDS_MISC) + 8);
#define GRID_BAR() xcd_barrier(bar)
#endif
    const int lo = pk.ph_lo, hi = pk.ph_hi, rep = pk.rep;
#define IN(k) (lo <= (k) && (k) < hi)
#define SEAM(k) do { if (IN((k) + 1)) GRID_BAR(); } while (0)
#define PHASE(k, ...) if (PH_ON((k) + 1) && IN(pb + (k))) { const Params p = loadp(); unsigned char* wl = p.ws + WS_W + (size_t)l * WL_SIZE; (void)wl; __VA_ARGS__ SEAM(pb + (k)); }
    if (PH_ON(0) && IN(0)) { const Params p = loadp(); p0_prologue(p, c); xprep_phase(c, p.x, wsb(p, WS_HN), wsf(p, WS_SSP)); SEAM(0); }
#pragma unroll 1
    for (int l = 0; l < DEPTH; ++l) {
        const int pb = 1 + l * NPH;
        PHASE(0, {
            pg8::Gemm g{wsb(p, WS_HN), (const bf16_t*)(wl + WL_IN), MTOK, NIN, DM, DM, DM}; pg8::StaticOrder S; S.init(MTOK, NIN, c.G, c.bid);
            pg8::EpiIn E{wsb(p, WS_MIX), wsb(p, WS_GATES), p.gate_b + (size_t)l * NGATE, wsf(p, WS_SSP)};
            pg8::gemm_phase(c.lds, g, S, E);
            convert_on_idle(p, c, l, I_IN, PER_LAYER, (MTOK / 256) * (NIN / 256)); })
        PHASE(1, {
            pg8::Gemm g{wsb(p, WS_MIX) + C_DCQ, (const bf16_t*)(wl + WL_UP), MTOK, NUP, KUP, NMIX, KUP}; pg8::StaticOrder S; S.init(MTOK, NUP, c.G, c.bid);
            pg8::EpiBf16<0> E{wsb(p, WS_QUP), NUP, nullptr};
            pg8::gemm_phase(c.lds, g, S, E);
            if (l + 1 < DEPTH) convert_on_idle(p, c, l + 1, 0, CV_B, (MTOK / 256) * (NUP / 256)); })
        PHASE(2, {
            if (rep == 0 || ((REP_UM >> Q_IDX) & 1)) for (int u; (u = next_unit(c, l, Q_IDX + 8 * rep)) < 256;) idx_unit(p, c, u);
            if (rep == 0 || ((REP_UM >> Q_SSDST) & 1)) for (int u; (u = next_unit(c, l, Q_SSDST + 8 * rep)) < 256;) ssdst_unit(p, c, l, u);
            if (rep == 0 || ((REP_UM >> Q_RETKV) & 1)) for (int u; (u = next_unit(c, l, Q_RETKV + 8 * rep)) < 256;) retkv_unit(p, c, u);
            for (int u = c.bid; u < 256; u += c.G) { knorm_unit(p, c, l, u); } })
        PHASE(3, {
            for (int u; (u = next_unit(c, l, Q_SEL + 8 * rep)) < 512;) sel_unit(p, c, u);
            scan_phase(p, c); })
        PHASE(4, {
            if (rep == 0 || ((REP_UM >> Q_DSA) & 1)) for (int u; (u = next_unit(c, l, Q_DSA + 8 * rep)) < 128;) dsa_unit(p, c, l, u);
            if (rep == 0 || ((REP_UM >> Q_FOX) & 1)) for (int u; (u = next_unit(c, l, Q_FOX + 8 * rep)) < 128;) fox_unit(p, c, l, u);
            if (rep == 0 || ((REP_UM >> Q_SSDO) & 1)) for (int u; (u = next_unit(c, l, Q_SSDO + 8 * rep)) < 256;) ssdo_unit(p, c, l, u);
            if (rep == 0 || ((REP_UM >> Q_RETO) & 1)) for (int u; (u = next_unit(c, l, Q_RETO + 8 * rep)) < 256;) reto_unit(p, c, u);
            if (l + 1 < DEPTH) { __syncthreads(); convert_items(p, c, l + 1, CV_B, I_IN, c.bid * 8 + c.wave, c.G * 8); } })
        PHASE(5, {
            pg8::Gemm g{wsb(p, WS_OALL), (const bf16_t*)(wl + WL_BR), MTOK, DM, KBR, KBR, KBR}; pg8::StaticOrder S; S.init(MTOK, DM, c.G, c.bid);
            pg8::EpiMerge E{wsb(p, WS_MERGED), wsb(p, WS_GATES), wsf(p, WS_SSQH), wsb(p, WS_ONES)};
            pg8::gemm_phase(c.lds, g, S, E); })
        PHASE(6, {
            pg8::Gemm g{wsb(p, WS_MERGED), (const bf16_t*)(wl + WL_OUT), MTOK, DM, DM, DM, DM}; pg8::StaticOrder S; S.init(MTOK, DM, c.G, c.bid);
            pg8::EpiResid<1, 0> E{wsb(p, WS_HN), nullptr, wsb(p, WS_XRES), wsf(p, WS_SSP), DM};
            pg8::gemm_phase(c.lds, g, S, E); })
        PHASE(7, {
            pg8::Gemm g{wsb(p, WS_XRES), (const bf16_t*)(wl + WL_FF1), MTOK, DFF, DM, DM, DM}; pg8::StaticOrder S; S.init(MTOK, DFF, c.G, c.bid);
            pg8::EpiBf16<1> E{wsb(p, WS_FFH), DFF, wsf(p, WS_SSP)};
            pg8::gemm_phase(c.lds, g, S, E); })
        if (l < DEPTH - 1) {
            PHASE(8, {
                pg8::Gemm g{wsb(p, WS_FFH), (const bf16_t*)(wl + WL_FF2), MTOK, DM, DFF, DFF, DFF}; pg8::StaticOrder S; S.init(MTOK, DM, c.G, c.bid);
                pg8::EpiResid<1, 0> E{wsb(p, WS_XRES), nullptr, wsb(p, WS_HN), wsf(p, WS_SSP), DM};
                pg8::gemm_phase(c.lds, g, S, E); })
        } else {
            PHASE(8, {
                pg8::Gemm g{wsb(p, WS_FFH), (const bf16_t*)(wl + WL_FF2), MTOK, DM, DFF, DFF, DFF}; pg8::StaticOrder S; S.init(MTOK, DM, c.G, c.bid);
                pg8::EpiResid<1, 1> E{wsb(p, WS_XRES), p.out, nullptr, nullptr, DM};
                pg8::gemm_phase(c.lds, g, S, E); })
        }
    }
#undef PHASE
#undef IN
#undef SEAM
}

extern "C" void kernel_launch(void* const* d_in, const int* in_sizes, int n_in, void* d_out, int out_size, void* d_ws, size_t ws_size, hipStream_t stream) {
    static int grid = 0;
    if (grid == 0) {
        if (n_in != 24 || in_sizes[0] != MTOK * DM || out_size != MTOK * DM || ws_size < WS_END) {
            fprintf(stderr, "kernel_launch: unexpected problem (n_in %d, in0 %d, out %d, ws %zu < %zu?); nothing launched\n", n_in, n_in > 0 ? in_sizes[0] : -1, out_size, ws_size, (size_t)WS_END); grid = -1; return; }
        int dev = 0, cus = 0;
        if (hipGetDevice(&dev) != hipSuccess || hipDeviceGetAttribute(&cus, hipDeviceAttributeMultiprocessorCount, dev) != hipSuccess) { grid = -1; return; }
        if (hipFuncSetAttribute((const void*)fwd, hipFuncAttributeMaxDynamicSharedMemorySize, LDS_BYTES) != hipSuccess) { fprintf(stderr, "kernel_launch: hipFuncSetAttribute failed\n"); grid = -1; return; }
        int per_cu = 0;
        if (hipOccupancyMaxActiveBlocksPerMultiprocessor(&per_cu, (const void*)fwd, 512, LDS_BYTES) != hipSuccess || per_cu < 1) { fprintf(stderr, "kernel_launch: occupancy query says %d blocks per CU\n", per_cu); }
        (void)hipGetLastError();
        grid = cus;
    }
    if (grid < 0) return;
    (void)hipMemsetAsync((char*)d_ws + WS_CTL, 0, CTL_ZERO_BYTES, stream);
    Params p{};
    const float** pin = (const float**)&p;
    for (int i = 0; i < 24; ++i) pin[i] = (const float*)d_in[i];
    p.out = (float*)d_out; p.ws = (unsigned char*)d_ws;
#if MK_PER_PHASE
    for (int ph = 0; ph < NPHASES; ++ph) { p.ph_lo = ph; p.ph_hi = ph + 1; p.rep = 0; hipLaunchKernelGGL(fwd, dim3(grid), dim3(512), LDS_BYTES, stream, p);
        if ((ph >= 1 && (ph - 1) % NPH == REPEAT_PH) || (ph == 0 && REPEAT_PH == 100)) { p.rep = 1; hipLaunchKernelGGL(fwd, dim3(grid), dim3(512), LDS_BYTES, stream, p); } }
#else
    p.ph_lo = 0; p.ph_hi = NPHASES; hipLaunchKernelGGL(fwd, dim3(grid), dim3(512), LDS_BYTES, stream, p);
#endif
    const hipError_t le = hipPeekAtLastError();
    if (le != hipSuccess) fprintf(stderr, "kernel_launch: launch failed: %s\n", hipGetErrorName(le));
}
```
